# Optimizing an MI355X kernel written in HIP

```python
import jax
import jax.numpy as jnp
from jax import lax
import numpy as np


D_MODEL = 2048
BATCH = 2
SEQ = 8192
DEPTH = 1

MIX_WIDTH = D_MODEL
SSD_WIDTH = MIX_WIDTH // 2
ATTN_WIDTH = MIX_WIDTH - SSD_WIDTH
SSD_HEAD_DIM = 64
SSD_HEADS = SSD_WIDTH // SSD_HEAD_DIM
SSD_GROUPS = 2
SSD_STATE = 128
SSD_CONV = 5
SSD_CHUNK = 128
XBC_WIDTH = SSD_WIDTH + 2 * SSD_GROUPS * SSD_STATE
ATTN_HEAD_DIM = 64
ATTN_HEADS = ATTN_WIDTH // ATTN_HEAD_DIM
DILATED_BRANCHES = ((128, 1), (512, 4), (2048, 16))
ATTN_BLOCK = 64
ROPE_THETA = 10000.0
MASK_VALUE = -1e30
IN_PROJ_WIDTH = 3 * ATTN_WIDTH + SSD_WIDTH + XBC_WIDTH + 2 * SSD_HEADS
MOE_GROUPS = 8
EXPERTS_PER_GROUP = 8
N_EXPERTS = MOE_GROUPS * EXPERTS_PER_GROUP
EXPERT_TOP_K = 2
EXPERT_HIDDEN = D_MODEL // 4
MOE_BLOCK = 128
RMS_EPS = 1e-6

kernel_name = 'hybrid_ssd_dilated_attn_hmoe_encoder'


def rms_norm(x, g):
    xf = x.astype(jnp.float32)
    y = xf * lax.rsqrt(jnp.mean(xf * xf, axis=-1, keepdims=True) + RMS_EPS)
    return (y * g.astype(jnp.float32)).astype(x.dtype)


def rotary(t, positions):
    half = t.shape[-1] // 2
    inv_freq = ROPE_THETA ** (-jnp.arange(half, dtype=jnp.float32) / half)
    ang = positions.astype(jnp.float32)[..., None] * inv_freq
    cos = jnp.cos(ang)[:, :, None, :]
    sin = jnp.sin(ang)[:, :, None, :]
    tf = t.astype(jnp.float32)
    t1, t2 = tf[..., :half], tf[..., half:]
    return jnp.concatenate([t1 * cos - t2 * sin, t1 * sin + t2 * cos], axis=-1).astype(t.dtype)


def dilated_branch(q, k, v, dilation, half):
    b, s, h, e = q.shape
    n = s // dilation
    nb = -(-n // ATTN_BLOCK)
    lp = nb * ATTN_BLOCK

    def split(t):
        return t.reshape(b, n, dilation, h, e).transpose(0, 2, 3, 1, 4)

    qs = jnp.pad(split(q), ((0, 0), (0, 0), (0, 0), (0, lp - n), (0, 0)))
    kv_pad = ((0, 0), (0, 0), (0, 0), (ATTN_BLOCK, lp - n + ATTN_BLOCK), (0, 0))
    ks = jnp.pad(split(k), kv_pad)
    vs = jnp.pad(split(v), kv_pad)
    qb = qs.reshape(b, dilation, h, nb, ATTN_BLOCK, e)

    def band(t):
        return jnp.concatenate(
            [t[:, :, :, o * ATTN_BLOCK:o * ATTN_BLOCK + lp].reshape(b, dilation, h, nb, ATTN_BLOCK, e)
             for o in range(3)], axis=4)

    kb, vb = band(ks), band(vs)
    scores = jnp.einsum('bdhnqe,bdhnke->bdhnqk', qb, kb, preferred_element_type=jnp.float32)
    qi = jnp.arange(ATTN_BLOCK)[:, None]
    kj = jnp.arange(3 * ATTN_BLOCK)[None, :]
    offset = kj - ATTN_BLOCK - qi
    key_idx = jnp.arange(nb)[:, None, None] * ATTN_BLOCK + kj[None] - ATTN_BLOCK
    valid = (jnp.abs(offset) <= half)[None] & (key_idx >= 0) & (key_idx < n)
    scores = jnp.where(valid, scores, MASK_VALUE)
    m = jnp.max(scores, axis=-1)
    p = jnp.exp(scores - m[..., None])
    l = jnp.sum(p, axis=-1)
    o = jnp.einsum('bdhnqk,bdhnke->bdhnqe', p, vb.astype(jnp.float32)) / l[..., None]

    def merge(t):
        t = t.reshape((b, dilation, h, lp) + t.shape[5:])[:, :, :, :n]
        t = jnp.moveaxis(t, 3, 1)
        return t.reshape((b, s, h) + t.shape[4:])

    return merge(o), merge(m), merge(l)


def dilated_attention(q, k, v):
    outs, maxes, dens = zip(*[dilated_branch(q, k, v, d, w // (2 * d)) for (w, d) in DILATED_BRANCHES])
    o = jnp.stack(outs)
    m = jnp.stack(maxes)
    l = jnp.stack(dens)
    wgt = l * jnp.exp(m - jnp.max(m, axis=0, keepdims=True))
    wgt = wgt / jnp.sum(wgt, axis=0, keepdims=True)
    return jnp.einsum('rbsh,rbshe->bshe', wgt, o)


def attention_mixer(q, k, v, positions, q_norm_g, k_norm_g):
    b, s, _ = q.shape

    def heads(t):
        return t.reshape(b, s, ATTN_HEADS, ATTN_HEAD_DIM)

    qh = rotary(rms_norm(heads(q), q_norm_g), positions) * (ATTN_HEAD_DIM ** -0.5)
    kh = rotary(rms_norm(heads(k), k_norm_g), positions)
    o = dilated_attention(qh, kh, heads(v))
    return o.reshape(b, s, ATTN_WIDTH).astype(v.dtype)


def depthwise_conv(t, w, bias):
    width = w.shape[0]
    y = lax.conv_general_dilated(
        t, w[:, None, :].astype(t.dtype), window_strides=(1,),
        padding=((width // 2, width // 2),),
        dimension_numbers=('NWC', 'WIO', 'NWC'),
        feature_group_count=t.shape[-1])
    return y + bias


def segsum(a):
    t = a.shape[-1]
    a_rep = jnp.repeat(a[..., None], t, axis=-1)
    a_rep = jnp.where(jnp.tril(jnp.ones((t, t), dtype=bool), -1), a_rep, 0.0)
    ss = jnp.cumsum(a_rep, axis=-2)
    return jnp.where(jnp.tril(jnp.ones((t, t), dtype=bool)), ss, -jnp.inf)


def ssd_scan(x, dt, a_neg, bmat, cmat):
    f32 = jnp.float32
    b, s, nh, p = x.shape
    g, n = bmat.shape[-2:]
    r = nh // g
    c = s // SSD_CHUNK
    l = SSD_CHUNK
    x = x.astype(f32).reshape(b, c, l, g, r, p)
    dt = dt.astype(f32).reshape(b, c, l, g, r)
    bc = bmat.astype(f32).reshape(b, c, l, g, n)
    cc = cmat.astype(f32).reshape(b, c, l, g, n)
    a = jnp.transpose(dt * a_neg.astype(f32).reshape(g, r), (0, 3, 4, 1, 2))
    a_cs = jnp.cumsum(a, axis=-1)
    xdt = x * dt[..., None]
    decay = jnp.exp(segsum(a))
    cb = jnp.einsum('bclgn,bcsgn->bgcls', cc, bc)
    y_diag = jnp.einsum('bgcls,bgrcls,bcsgrp->bclgrp', cb, decay, xdt)
    to_end = jnp.exp(a_cs[..., -1:] - a_cs)
    chunk_states = jnp.einsum('bclgn,bgrcl,bclgrp->cbgrpn', bc, to_end, xdt)
    chunk_decay = jnp.moveaxis(jnp.exp(a_cs[..., -1]), -1, 0)

    def carry_state(h_prev, inp):
        st, dec = inp
        return h_prev * dec[..., None, None] + st, h_prev

    _, h_in = lax.scan(carry_state, jnp.zeros(chunk_states.shape[1:], f32), (chunk_states, chunk_decay))
    y_off = jnp.einsum('bclgn,cbgrpn,bgrcl->bclgrp', cc, h_in, jnp.exp(a_cs))
    return (y_diag + y_off).reshape(b, s, nh, p)


def ssd_mixer(z, xbc, dt_raw, conv_w, conv_b, dt_bias, a_log, d_skip, norm_g):
    b, s, _ = z.shape
    xbc = jax.nn.silu(depthwise_conv(xbc, conv_w, conv_b))
    xs, bm, cm = jnp.split(xbc, [SSD_WIDTH, SSD_WIDTH + SSD_GROUPS * SSD_STATE], axis=-1)
    xs = xs.reshape(b, s, SSD_HEADS, SSD_HEAD_DIM)
    bm = bm.reshape(b, s, SSD_GROUPS, SSD_STATE)
    cm = cm.reshape(b, s, SSD_GROUPS, SSD_STATE)
    dt = jax.nn.softplus(dt_raw.reshape(b, s, 2, SSD_HEADS) + dt_bias)
    a_neg = -jnp.exp(a_log)
    y_fwd = ssd_scan(xs, dt[:, :, 0], a_neg[0], bm, cm)

    def flip(t):
        return jnp.flip(t, axis=1)

    y_bwd = flip(ssd_scan(flip(xs), flip(dt[:, :, 1]), a_neg[1], flip(bm), flip(cm)))
    y = (y_fwd + y_bwd).astype(xs.dtype) + d_skip[:, None] * xs
    y = y.reshape(b, s, SSD_WIDTH)
    return rms_norm(y * jax.nn.silu(z), norm_g)


def expert_dispatch(h, expert_ids, gates, w_gate, w_up, w_down):
    t, d = h.shape
    k = expert_ids.shape[1]
    m = t * k
    n_exp = w_gate.shape[0]
    flat_e = expert_ids.reshape(m).astype(jnp.int32)
    flat_tok = jnp.repeat(jnp.arange(t, dtype=jnp.int32), k)
    flat_g = gates.reshape(m)
    order = jnp.argsort(flat_e)
    sorted_e = flat_e[order]
    counts = jnp.zeros((n_exp,), jnp.int32).at[flat_e].add(1)
    padded = (counts + MOE_BLOCK - 1) // MOE_BLOCK * MOE_BLOCK
    starts = jnp.cumsum(counts) - counts
    padded_ends = jnp.cumsum(padded)
    padded_starts = padded_ends - padded
    dest = padded_starts[sorted_e] + jnp.arange(m, dtype=jnp.int32) - starts[sorted_e]
    n_blocks = -(-m // MOE_BLOCK) + n_exp
    slots = n_blocks * MOE_BLOCK
    slot_tok = jnp.full((slots,), t, jnp.int32).at[dest].set(flat_tok[order])
    slot_gate = jnp.zeros((slots,), h.dtype).at[dest].set(flat_g[order])
    block_start = jnp.arange(n_blocks, dtype=jnp.int32) * MOE_BLOCK
    block_expert = jnp.minimum(jnp.searchsorted(padded_ends, block_start, side='right'), n_exp - 1)
    h_pad = jnp.concatenate([h, jnp.zeros((1, d), h.dtype)], axis=0)

    def expert_block(args):
        tok, e = args
        xb = h_pad[tok]
        return (jax.nn.silu(xb @ w_gate[e]) * (xb @ w_up[e])) @ w_down[e]

    y = lax.map(expert_block, (slot_tok.reshape(n_blocks, MOE_BLOCK), block_expert))
    y = y.reshape(slots, d) * slot_gate[:, None]
    return jax.ops.segment_sum(y, slot_tok, num_segments=t + 1)[:t]


def hierarchical_moe(h, w_rg, b_rg, w_re, b_re, w_gate, w_up, w_down):
    t = h.shape[0]
    group_logits = (h @ w_rg).astype(jnp.float32) + b_rg
    p_group, group_idx = lax.top_k(jax.nn.softmax(group_logits, axis=-1), 1)
    expert_logits = ((h @ w_re).astype(jnp.float32) + b_re).reshape(t, MOE_GROUPS, EXPERTS_PER_GROUP)
    in_group = jnp.take_along_axis(expert_logits, group_idx[:, :, None], axis=1)[:, 0]
    p_exp, local_idx = lax.top_k(jax.nn.softmax(in_group, axis=-1), EXPERT_TOP_K)
    gates = p_group * p_exp / jnp.sum(p_exp, axis=-1, keepdims=True)
    expert_ids = group_idx * EXPERTS_PER_GROUP + local_idx
    return expert_dispatch(h, expert_ids, gates.astype(h.dtype), w_gate, w_up, w_down)


def setup_inputs(seed: int = 0) -> dict:
    key = jax.random.key(seed)
    ks = jax.random.split(key, 26)
    f32 = jnp.float32
    nl = DEPTH

    def dense(k, shape, fan_in):
        return jax.random.normal(k, shape, f32) * fan_in ** -0.5

    def gain(k, shape):
        return 1.0 + 0.02 * jax.random.normal(k, shape, f32)

    x = jax.random.normal(ks[0], (BATCH, SEQ, D_MODEL), f32)
    c = jax.random.normal(ks[1], (BATCH, D_MODEL), f32)
    offsets = jax.random.randint(ks[2], (BATCH, 1), 0, SEQ, dtype=jnp.int32)
    positions = (jnp.arange(SEQ, dtype=jnp.int32)[None, :] + offsets).astype(jnp.int32)
    dt0 = jnp.exp(jax.random.uniform(ks[9], (nl, 2, SSD_HEADS), f32, np.log(1e-3), np.log(1e-1)))
    return {
        'x': x,
        'c': c,
        'positions': positions,
        'w_ada': 0.5 * dense(ks[3], (nl, D_MODEL, 6 * D_MODEL), D_MODEL),
        'b_ada': 0.02 * jax.random.normal(ks[4], (nl, 6 * D_MODEL), f32),
        'norm1_g': gain(ks[5], (nl, D_MODEL)),
        'w_in': dense(ks[6], (nl, D_MODEL, IN_PROJ_WIDTH), D_MODEL),
        'conv_w': dense(ks[7], (nl, SSD_CONV, XBC_WIDTH), SSD_CONV),
        'conv_b': 0.02 * jax.random.normal(ks[8], (nl, XBC_WIDTH), f32),
        'dt_bias': dt0 + jnp.log(-jnp.expm1(-dt0)),
        'a_log': jnp.log(jax.random.uniform(ks[10], (nl, 2, SSD_HEADS), f32, 1.0, 16.0)),
        'd_skip': gain(ks[11], (nl, SSD_HEADS)),
        'ssd_norm_g': gain(ks[12], (nl, SSD_WIDTH)),
        'q_norm_g': gain(ks[13], (nl, ATTN_HEAD_DIM)),
        'k_norm_g': gain(ks[14], (nl, ATTN_HEAD_DIM)),
        'w_out': dense(ks[15], (nl, MIX_WIDTH, D_MODEL), MIX_WIDTH),
        'norm2_g': gain(ks[16], (nl, D_MODEL)),
        'w_router_group': dense(ks[17], (nl, D_MODEL, MOE_GROUPS), D_MODEL),
        'b_router_group': 0.01 * jax.random.normal(ks[18], (nl, MOE_GROUPS), f32),
        'w_router_expert': dense(ks[19], (nl, D_MODEL, N_EXPERTS), D_MODEL),
        'b_router_expert': 0.01 * jax.random.normal(ks[20], (nl, N_EXPERTS), f32),
        'w_gate': dense(ks[21], (nl, N_EXPERTS, D_MODEL, EXPERT_HIDDEN), D_MODEL),
        'w_up': dense(ks[22], (nl, N_EXPERTS, D_MODEL, EXPERT_HIDDEN), D_MODEL),
        'w_down': dense(ks[23], (nl, N_EXPERTS, EXPERT_HIDDEN, D_MODEL), EXPERT_HIDDEN),
    }


def reference(x, c, positions, w_ada, b_ada, norm1_g, w_in, conv_w, conv_b, dt_bias, a_log, d_skip,
              ssd_norm_g, q_norm_g, k_norm_g, w_out, norm2_g, w_router_group, b_router_group,
              w_router_expert, b_router_expert, w_gate, w_up, w_down):
    b, s, d = x.shape
    split_at = [ATTN_WIDTH, 2 * ATTN_WIDTH, 3 * ATTN_WIDTH, 3 * ATTN_WIDTH + SSD_WIDTH,
                3 * ATTN_WIDTH + SSD_WIDTH + XBC_WIDTH]
    for layer in range(DEPTH):
        mod = jax.nn.silu(c) @ w_ada[layer] + b_ada[layer]
        shift1, scale1, gate1, shift2, scale2, gate2 = [t[:, None, :] for t in jnp.split(mod, 6, axis=-1)]
        h = rms_norm(x, norm1_g[layer]) * (1.0 + scale1) + shift1
        proj = h @ w_in[layer]
        q, k, v, z, xbc, dt_raw = jnp.split(proj, split_at, axis=-1)
        y_ssd = ssd_mixer(z, xbc, dt_raw, conv_w[layer], conv_b[layer], dt_bias[layer], a_log[layer],
                          d_skip[layer], ssd_norm_g[layer])
        y_att = attention_mixer(q, k, v, positions, q_norm_g[layer], k_norm_g[layer])
        x = x + gate1 * (jnp.concatenate([y_ssd, y_att], axis=-1) @ w_out[layer])
        h = rms_norm(x, norm2_g[layer]) * (1.0 + scale2) + shift2
        y_moe = hierarchical_moe(h.reshape(b * s, d), w_router_group[layer], b_router_group[layer],
                                 w_router_expert[layer], b_router_expert[layer],
                                 w_gate[layer], w_up[layer], w_down[layer])
        x = x + gate2 * y_moe.reshape(b, s, d)
    return x
```

```cpp
#include <hip/hip_runtime.h>
#include <cstdio>
#include <cstdint>

#ifndef MK_ONE_LAUNCH
#define MK_ONE_LAUNCH 0
#endif

#define LAS __attribute__((address_space(3)))
#define GAS __attribute__((address_space(1)))
typedef unsigned short bf16_t;
typedef short bf16x8 __attribute__((ext_vector_type(8)));
typedef float f32x4 __attribute__((ext_vector_type(4)));
typedef float f32x2 __attribute__((ext_vector_type(2)));
typedef unsigned u32x4 __attribute__((ext_vector_type(4)));
typedef unsigned u32x2 __attribute__((ext_vector_type(2)));

constexpr int BATCH = 2, SEQ = 8192, T = BATCH * SEQ, D = 2048;
constexpr int NPROJ = 5664, NPROJ_PAD = 5888;
constexpr int OFF_Q = 0, OFF_K = 1024, OFF_V = 2048, OFF_Z = 3072, OFF_XBC = 4096, OFF_DT = 5632;
constexpr int XBCW = 1536, NHEAD = 16, CHUNK = 128, NCHUNK = SEQ / CHUNK;
constexpr int NEXP = 64, EH = 512;
constexpr int ECAP = T;
constexpr int NRT = 80;
constexpr float RMS_EPS = 1e-6f;
constexpr float LOG2E = 1.4426950408889634f;

constexpr size_t MiB = 1u << 20;
constexpr size_t WS_CTL = 0, CTL_BYTES = 1 * MiB;
constexpr size_t WS_MOD = 1 * MiB;
constexpr size_t WS_ROPE = 2 * MiB;
constexpr size_t WS_WRT = 6 * MiB;
constexpr size_t WS_SMALL = 7 * MiB;
constexpr size_t WS_DTRAW = WS_SMALL, WS_DTF = WS_SMALL + 2 * MiB, WS_DTB = WS_SMALL + 3 * MiB, WS_ACS = WS_SMALL + 4 * MiB, WS_RCS = WS_SMALL + 5 * MiB, WS_DEC = WS_SMALL + 6 * MiB;
constexpr size_t WS_ML = 14 * MiB;
constexpr size_t WS_ELIST = 20 * MiB;
constexpr size_t WS_GATES = 24 * MiB;
constexpr size_t WS_WINT = 25 * MiB;
constexpr size_t WS_WOUTT = 48 * MiB;
constexpr size_t WS_WGUT = 56 * MiB;
constexpr size_t WS_WDT = 312 * MiB;
constexpr size_t WS_HB = 440 * MiB;
constexpr size_t WS_PROJ = 504 * MiB;
constexpr size_t WS_YSLOT = WS_PROJ, WS_HMOE = WS_PROJ + 128 * MiB;
constexpr size_t WS_ST = 688 * MiB;
constexpr size_t WS_X1 = WS_ST;
constexpr size_t WS_YD = 816 * MiB;
constexpr size_t WS_AO = 880 * MiB;
constexpr size_t WS_MIX = 976 * MiB;
constexpr size_t WS_END = 1040 * MiB;

constexpr int CW_BAR = 4096;
constexpr int CW_CNT = 16384;
constexpr int CW_FLAG = 16384 + 256;

constexpr int RING_BYTES = 131072;
constexpr int MISC_OFF = RING_BYTES;
constexpr int TAB_OFF = RING_BYTES + 512;
constexpr int ETAB_OFF = TAB_OFF + 12288;
constexpr int LDS_BYTES = 147456;
static_assert(ETAB_OFF + 1024 <= LDS_BYTES, "LDS map");

__device__ __forceinline__ float bf2f(unsigned v) { return __uint_as_float(v << 16); }
__device__ __forceinline__ unsigned f2bf(float f) { unsigned u = __float_as_uint(f); return (u + 0x7fffu + ((u >> 16) & 1u)) >> 16; }
__device__ __forceinline__ unsigned pk2(float lo, float hi) { unsigned r; asm volatile("v_cvt_pk_bf16_f32 %0, %1, %2" : "=v"(r) : "v"(lo), "v"(hi)); return r; }
__device__ __forceinline__ float lo_f(unsigned w) { return __uint_as_float(w << 16); }
__device__ __forceinline__ float hi_f(unsigned w) { return __uint_as_float(w & 0xffff0000u); }
__device__ __forceinline__ float silu_f(float v) { return v / (1.f + __expf(-v)); }
#define LDS_WAIT() asm volatile("s_waitcnt lgkmcnt(0)" ::: "memory")
#define VM_WAIT() asm volatile("s_waitcnt vmcnt(0)" ::: "memory")

#define XB_TMO      128
#define XB_XCNT(j)  (256  + 64 * (j))
#define XB_XSUB(j)  (1280 + 64 * (j))
#define XB_XGEN(j)  (2304 + 64 * (j))
#define XB_TOP      3328
#define XB_TOPGEN   3392
#define XCD_BAR_WORDS 3456
#define XB_SPIN_CAP (1u << 18)
__device__ __forceinline__ unsigned xb_ld(unsigned* p)              { return __hip_atomic_load(p, __ATOMIC_RELAXED, __HIP_MEMORY_SCOPE_AGENT); }
__device__ __forceinline__ unsigned xb_add(unsigned* p, unsigned v) { return __hip_atomic_fetch_add(p, v, __ATOMIC_RELAXED, __HIP_MEMORY_SCOPE_AGENT); }
__device__ __forceinline__ unsigned xb_xcc_id() { return (unsigned)__builtin_amdgcn_s_getreg((3 << 11) | 20) & 0xFu; }
#define XB_SPIN(cond, bar) do { unsigned _sp = 0; while (cond) { __builtin_amdgcn_s_sleep(1); \
    if ((++_sp & 255u) == 0u) { if (xb_ld(&(bar)[XB_TMO])) break; if (_sp > XB_SPIN_CAP) { atomicAdd(&(bar)[XB_TMO], 1u); break; } } } } while (0)
struct XcdBarrier { unsigned* bar; unsigned x; volatile LAS unsigned* st; };
__device__ __forceinline__ XcdBarrier xcd_barrier_post(unsigned* bar, volatile LAS unsigned* st) {
    XcdBarrier b; b.bar = bar; b.x = xb_xcc_id(); b.st = st;
    if (threadIdx.x == 0) (void)xb_add(&bar[XB_XCNT(b.x)], 1u);
    return b;
}
__device__ __forceinline__ void xcd_barrier_complete(unsigned* bar, unsigned x, unsigned& nloc, unsigned& nx) {
    const unsigned G = gridDim.x * gridDim.y * gridDim.z;
    unsigned sum, cnt, mine, sp = 0u;
    for (;;) {
        sum = 0u; cnt = 0u; mine = 0u;
#pragma unroll
        for (unsigned j = 0; j < 16; ++j) { const unsigned c = xb_ld(&bar[XB_XCNT(j)]); sum += c; cnt += (c > 0u) ? 1u : 0u; mine = (j == x) ? c : mine; }
        if (sum == G) break;
        __builtin_amdgcn_s_sleep(1);
        if ((++sp & 255u) == 0u) { if (xb_ld(&bar[XB_TMO])) break; if (sp > XB_SPIN_CAP) { atomicAdd(&bar[XB_TMO], 1u); break; } }
    }
    nloc = mine > 0u ? mine : 1u; nx = cnt > 0u ? cnt : 1u;
}
__device__ __forceinline__ void xcd_barrier(const XcdBarrier& b) {
    asm volatile("s_waitcnt vmcnt(0)" ::: "memory");
    __syncthreads();
    if (threadIdx.x == 0) {
        unsigned* bar = b.bar;
        __builtin_amdgcn_s_waitcnt(0);
        unsigned nloc = b.st[0], nx = b.st[1];
        if (nloc == 0u) { xcd_barrier_complete(bar, b.x, nloc, nx); b.st[0] = nloc; b.st[1] = nx; }
        const unsigned old = xb_add(&bar[XB_XSUB(b.x)], 1u);
        const unsigned gen = old / nloc;
        if (old + 1u == (gen + 1u) * nloc) {
            __builtin_amdgcn_fence(__ATOMIC_RELEASE, "agent");
            asm volatile("s_waitcnt vmcnt(0)" ::: "memory");
            const unsigned og = xb_add(&bar[XB_TOP], 1u);
            const unsigned tg = og / nx;
            if (og + 1u == (tg + 1u) * nx) xb_add(&bar[XB_TOPGEN], 1u);
            else XB_SPIN(xb_ld(&bar[XB_TOPGEN]) == tg, bar);
            __builtin_amdgcn_fence(__ATOMIC_ACQUIRE, "agent");
            xb_add(&bar[XB_XGEN(b.x)], 1u);
            asm volatile("s_waitcnt vmcnt(0)" ::: "memory");
        } else {
            XB_SPIN(xb_ld(&bar[XB_XGEN(b.x)]) == gen, bar);
            __builtin_amdgcn_fence(__ATOMIC_ACQUIRE, "agent");
            asm volatile("s_waitcnt vmcnt(0)" ::: "memory");
        }
    }
    __syncthreads();
}

namespace pg8 {
constexpr int BM = 256, BK = 64, HALF = 128, HTB = HALF * BK * 2, STAGE_BYTES = 8 * HTB, NXCD = 8, WGM = 8;
__device__ __forceinline__ int lds_byte(int r, int c) { const int st = (r >> 4) * 2 + (c >> 5), rr = r & 15, cc = c & 31, ob = rr * 64 + cc * 2; return st * 1024 + (ob ^ (((ob >> 9) & 1) << 5)); }
__device__ __forceinline__ void stage_rc(int b, int& R, int& C) { const int st = b / 1024, sb = b % 1024, swz = sb ^ (((sb >> 9) & 1) << 5); R = (st >> 1) * 16 + swz / 64; C = (st & 1) * 32 + (swz % 64) / 2; }
__device__ __forceinline__ int perm32(int rho) { const int n = rho >> 4, i = rho & 15; return 8 * (i >> 2) + 4 * n + (i & 3); }

struct Unit { int pm, pn, e, li; };
struct Gemm { const bf16_t* A; const bf16_t* Bt; int K; size_t bstride; };

struct StaticOrder {
    int nM, nN, nwg, G, c;
    __device__ void init(int M, int N, int G_, int c_) { nM = M / BM; nN = N / BM; nwg = nM * nN; G = G_; c = c_; }
    __device__ bool next(int i, Unit& u) const {
        const long L = (long)i * G + c; if (L >= nwg) return false;
        int wgid = (int)L; { const int q = nwg / NXCD, r = nwg % NXCD, xcd = wgid % NXCD, off = wgid / NXCD; wgid = (xcd < r ? xcd * (q + 1) : r * (q + 1) + (xcd - r) * q) + off; }
        const int nig = WGM * nN, gid = wgid / nig, fm = gid * WGM, gsz = (nM - fm) < WGM ? (nM - fm) : WGM;
        u.pm = fm + ((wgid % nig) % gsz); u.pn = (wgid % nig) / gsz; u.e = 0; u.li = i; return true;
    }
    __device__ __forceinline__ void a_ready(const Unit&) const {}
    __device__ __forceinline__ void done(const Unit&) const {}
    __device__ __forceinline__ void load_goff(const Unit&, unsigned (&)[2][2], const int (&)[2], const int (&)[2]) const {}
};

template <class Epi, class Sched, bool ALIGN_EPI, bool GATHER>
__device__ __forceinline__ void gemm_phase(LAS unsigned char* lds, const Gemm g, const Sched& S, const Epi& E) {
    const int tid = threadIdx.x, wid = __builtin_amdgcn_readfirstlane(tid >> 6), lane = tid & 63, wr = wid >> 2, wc = wid & 3, fr = lane & 15, fq = lane >> 4;
    const int K = g.K, nt = K / BK;
    unsigned voffA[2], voffB[2]; int RA[2], CA[2];
#pragma unroll
    for (int i = 0; i < 2; ++i) { int R, C; stage_rc(tid * 16 + i * 8192, R, C); const int Rb = Epi::PERM ? ((R & ~31) + perm32(R & 31)) : R; RA[i] = R; CA[i] = C;
        voffA[i] = (unsigned)(R * K + C) * 2u; voffB[i] = (unsigned)(Rb * K + C) * 2u; }
    unsigned goff[2][2] = {{0u, 0u}, {0u, 0u}};
    const size_t kstep = (size_t)(BK * 2);
    const size_t hstep = (size_t)HALF * K * 2;
    const size_t tstep = 2 * hstep;
    const unsigned ldsw = (unsigned)wid * 1024u;
    const int aoff = lds_byte(wr * 64 + fr, fq * 8), boff = lds_byte(wc * 32 + fr, fq * 8);
#define PG8_SA(b, h) (((b) * 2 + (h)) * HTB)
#define PG8_SB(b, h) ((4 + (b) * 2 + (h)) * HTB)
#define PG8_STAGE(bufoff, gbase, voff) do { _Pragma("unroll") for (int _i = 0; _i < 2; ++_i) \
        __builtin_amdgcn_global_load_lds((const unsigned*)((const char*)(gbase) + (voff)[_i]), (LAS unsigned*)(lds + (bufoff) + ldsw + _i * 8192), 16, 0, 0); } while (0)
#define PG8_STAGE_A(bufoff, cptr, kb, h) do { if constexpr (GATHER) { PG8_STAGE(bufoff, (const char*)g.A + (kb), goff[h]); } else { PG8_STAGE(bufoff, (cptr) + (kb) + ((h) ? hstep : 0), voffA); } } while (0)
#define PG8_LDA(dst, b, h) do { _Pragma("unroll") for (int m = 0; m < 4; ++m) _Pragma("unroll") for (int k = 0; k < 2; ++k) dst[m][k] = *(const LAS bf16x8*)(lds + PG8_SA(b, h) + aoff + m * 2048 + k * 1024); } while (0)
#define PG8_LDB(dst, b, h) do { _Pragma("unroll") for (int n = 0; n < 2; ++n) _Pragma("unroll") for (int k = 0; k < 2; ++k) dst[n][k] = *(const LAS bf16x8*)(lds + PG8_SB(b, h) + boff + n * 2048 + k * 1024); } while (0)
#define PG8_MMA(ai, bj, At, Bt) do { __builtin_amdgcn_s_setprio(1); _Pragma("unroll") for (int m = 0; m < 4; ++m) _Pragma("unroll") for (int n = 0; n < 2; ++n) _Pragma("unroll") for (int k = 0; k < 2; ++k) \
        acc[ai][bj][m][n] = __builtin_amdgcn_mfma_f32_16x16x32_bf16(Bt[n][k], At[m][k], acc[ai][bj][m][n], 0, 0, 0); __builtin_amdgcn_s_setprio(0); } while (0)
#define PG8_WAIT_V(n) asm volatile("s_waitcnt vmcnt(" #n ")" ::: "memory")
#define PG8_WAIT_L(n) asm volatile("s_waitcnt lgkmcnt(" #n ")" ::: "memory")
#define PG8_BAR __builtin_amdgcn_s_barrier()
#define PG8_SCHED __builtin_amdgcn_sched_barrier(0)
    Unit cur, nxt; int ui = 0;
    if (!S.next(0, cur)) return;
    f32x4 acc[2][2][4][2];
#pragma unroll
    for (int a = 0; a < 2; ++a)
#pragma unroll
        for (int b = 0; b < 2; ++b)
#pragma unroll
            for (int m = 0; m < 4; ++m)
#pragma unroll
                for (int n = 0; n < 2; ++n) acc[a][b][m][n] = (f32x4){0.f, 0.f, 0.f, 0.f};
    bf16x8 At[4][2], B0[2][2], B1[2][2];
    const char* cA = GATHER ? (const char*)g.A : (const char*)g.A + (size_t)cur.pm * tstep;
    const char* cB = (const char*)g.Bt + (size_t)cur.e * g.bstride + (size_t)cur.pn * tstep;
    S.a_ready(cur);
    if constexpr (GATHER) { S.load_goff(cur, goff, RA, CA); }
    PG8_STAGE(PG8_SB(0, 0), cB, voffB); PG8_STAGE(PG8_SB(0, 1), cB + hstep, voffB); PG8_STAGE_A(PG8_SA(0, 0), cA, 0, 0); PG8_STAGE_A(PG8_SA(0, 1), cA, 0, 1);
    if (wr == 1) PG8_BAR;
    PG8_WAIT_V(2); PG8_BAR;
    PG8_STAGE(PG8_SB(1, 0), cB + kstep, voffB); PG8_STAGE_A(PG8_SA(1, 0), cA, kstep, 0); PG8_STAGE(PG8_SB(1, 1), cB + hstep + kstep, voffB);
    PG8_WAIT_V(6); PG8_BAR;
    for (;;) {
        const bool has_next = S.next(ui + 1, nxt);
        const char* nA = GATHER ? cA : (has_next ? (const char*)g.A + (size_t)nxt.pm * tstep : cA);
        const char* nB = has_next ? (const char*)g.Bt + (size_t)nxt.e * g.bstride + (size_t)nxt.pn * tstep : cB;
        for (int t = 0; t < nt; t += 2) {
            const bool last = (t == nt - 2);
            const size_t kb1 = (size_t)(t + 1) * kstep;
            const char* a2 = last ? nA : cA; const size_t kb2 = last ? 0 : (size_t)(t + 2) * kstep; const char* b2 = last ? nB : cB + (size_t)(t + 2) * kstep;
            const size_t kb3 = kb2 + kstep; const char* b3 = b2 + kstep;
            if (last && has_next) S.a_ready(nxt);
            PG8_LDB(B0, 0, 0); PG8_LDB(B1, 0, 1); PG8_SCHED; PG8_LDA(At, 0, 0); PG8_STAGE_A(PG8_SA(1, 1), cA, kb1, 1);
            PG8_WAIT_V(8); PG8_WAIT_L(0); PG8_BAR; PG8_MMA(0, 0, At, B0); PG8_MMA(0, 1, At, B1); PG8_BAR; PG8_SCHED;
            if constexpr (GATHER) { if (last && has_next) S.load_goff(nxt, goff, RA, CA); }
            PG8_LDA(At, 0, 1); PG8_STAGE(PG8_SB(0, 0), b2, voffB); PG8_STAGE(PG8_SB(0, 1), b2 + hstep, voffB); PG8_STAGE_A(PG8_SA(0, 0), a2, kb2, 0);
            PG8_WAIT_V(8); PG8_WAIT_L(0); PG8_BAR; PG8_MMA(1, 0, At, B0); PG8_MMA(1, 1, At, B1); PG8_BAR; PG8_SCHED;
            PG8_LDB(B0, 1, 0); PG8_LDB(B1, 1, 1); PG8_SCHED; PG8_LDA(At, 1, 0); PG8_STAGE_A(PG8_SA(0, 1), a2, kb2, 1);
            PG8_WAIT_V(8); PG8_WAIT_L(0); PG8_BAR; PG8_MMA(0, 0, At, B0); PG8_MMA(0, 1, At, B1); PG8_BAR; PG8_SCHED;
            PG8_LDA(At, 1, 1); PG8_STAGE(PG8_SB(1, 0), b3, voffB); PG8_STAGE(PG8_SB(1, 1), b3 + hstep, voffB); PG8_STAGE_A(PG8_SA(1, 0), a2, kb3, 0);
            PG8_WAIT_V(8); PG8_WAIT_L(0); PG8_BAR; PG8_MMA(1, 0, At, B0); PG8_MMA(1, 1, At, B1); PG8_BAR; PG8_SCHED;
        }
        if constexpr (ALIGN_EPI) { if (wr == 0) PG8_BAR; }
        E(acc, cur, wr, wc, fr, fq); S.done(cur);
        if (!has_next) break;
#pragma unroll
        for (int a = 0; a < 2; ++a)
#pragma unroll
            for (int b = 0; b < 2; ++b)
#pragma unroll
                for (int m = 0; m < 4; ++m)
#pragma unroll
                    for (int n = 0; n < 2; ++n) acc[a][b][m][n] = (f32x4){0.f, 0.f, 0.f, 0.f};
        cur = nxt; cA = nA; cB = nB; ++ui;
        if constexpr (ALIGN_EPI) { if (wr == 1) PG8_BAR; }
    }
    PG8_WAIT_V(0);
    if constexpr (!ALIGN_EPI) { if (wr == 0) PG8_BAR; }
    PG8_BAR;
#undef PG8_SA
#undef PG8_SB
#undef PG8_STAGE
#undef PG8_STAGE_A
#undef PG8_LDA
#undef PG8_LDB
#undef PG8_MMA
#undef PG8_WAIT_V
#undef PG8_WAIT_L
#undef PG8_BAR
#undef PG8_SCHED
}
}

struct EpiProj {
    static constexpr bool PERM = true;
    bf16_t* O; float* dtraw;
    __device__ __forceinline__ void operator()(const f32x4 (&acc)[2][2][4][2], const pg8::Unit& u, int wr, int wc, int fr, int fq) const {
        const int row0 = u.pm * 256 + wr * 64 + fr, col0 = u.pn * 256 + wc * 32 + 8 * fq;
#pragma unroll
        for (int ai = 0; ai < 2; ++ai)
#pragma unroll
            for (int m = 0; m < 4; ++m) { bf16_t* rowp = O + (size_t)(row0 + ai * 128 + m * 16) * NPROJ_PAD + col0;
#pragma unroll
                for (int bj = 0; bj < 2; ++bj) { const f32x4 v0 = acc[ai][bj][m][0], v1 = acc[ai][bj][m][1];
                    u32x4 w; w.x = pk2(v0[0], v0[1]); w.y = pk2(v0[2], v0[3]); w.z = pk2(v1[0], v1[1]); w.w = pk2(v1[2], v1[3]);
                    *(u32x4*)(rowp + bj * 128) = w; } }
        if (u.pn == 22 && wc == 0) {
#pragma unroll
            for (int ai = 0; ai < 2; ++ai)
#pragma unroll
                for (int m = 0; m < 4; ++m) { float* p = dtraw + (size_t)(row0 + ai * 128 + m * 16) * 32 + 8 * fq;
                    *(f32x4*)p = acc[ai][0][m][0]; *(f32x4*)(p + 4) = acc[ai][0][m][1]; }
        }
    }
};
struct EpiOut {
    static constexpr bool PERM = false;
    const float* x; const float* mod; float* x1;
    __device__ __forceinline__ void operator()(const f32x4 (&acc)[2][2][4][2], const pg8::Unit& u, int wr, int wc, int fr, int fq) const {
        const int row0 = u.pm * 256 + wr * 64 + fr, col0 = u.pn * 256 + wc * 32 + 4 * fq;
        const float* gp = mod + (size_t)(u.pm >= 32 ? 1 : 0) * 12288 + 2 * D + col0;
        f32x4 gv[2][2];
#pragma unroll
        for (int bj = 0; bj < 2; ++bj)
#pragma unroll
            for (int n = 0; n < 2; ++n) gv[bj][n] = *(const f32x4*)(gp + bj * 128 + n * 16);
#pragma unroll
        for (int ai = 0; ai < 2; ++ai)
#pragma unroll
            for (int m = 0; m < 4; ++m) { const size_t off = (size_t)(row0 + ai * 128 + m * 16) * D + col0;
#pragma unroll
                for (int bj = 0; bj < 2; ++bj)
#pragma unroll
                    for (int n = 0; n < 2; ++n) { const f32x4 xv = *(const f32x4*)(x + off + bj * 128 + n * 16);
                        *(f32x4*)(x1 + off + bj * 128 + n * 16) = xv + gv[bj][n] * acc[ai][bj][m][n]; } }
    }
};
struct EpiGU {
    static constexpr bool PERM = true;
    bf16_t* H;
    __device__ __forceinline__ void operator()(const f32x4 (&acc)[2][2][4][2], const pg8::Unit& u, int wr, int wc, int fr, int fq) const {
        const int row0 = u.pm * 256 + wr * 64 + fr, col0 = u.pn * 128 + wc * 16 + 4 * fq;
#pragma unroll
        for (int ai = 0; ai < 2; ++ai)
#pragma unroll
            for (int m = 0; m < 4; ++m) { bf16_t* rowp = H + (size_t)(row0 + ai * 128 + m * 16) * EH + col0;
#pragma unroll
                for (int bj = 0; bj < 2; ++bj) { const f32x4 gt = acc[ai][bj][m][0], up = acc[ai][bj][m][1];
                    u32x2 w; w.x = pk2(silu_f(gt[0]) * up[0], silu_f(gt[1]) * up[1]); w.y = pk2(silu_f(gt[2]) * up[2], silu_f(gt[3]) * up[3]);
                    *(u32x2*)(rowp + bj * 64) = w; } }
    }
};
struct EpiDown {
    static constexpr bool PERM = true;
    bf16_t* Y; const LAS int* tab;
    __device__ __forceinline__ void operator()(const f32x4 (&acc)[2][2][4][2], const pg8::Unit& u, int wr, int wc, int fr, int fq) const {
        const int col0 = u.pn * 256 + wc * 32 + 8 * fq;
        const LAS int* tb = tab + u.li * 512;
#pragma unroll
        for (int ai = 0; ai < 2; ++ai)
#pragma unroll
            for (int m = 0; m < 4; ++m) { const int r = ai * 128 + wr * 64 + m * 16 + fr; const int a = tb[2 * r]; const float gt = __int_as_float(tb[2 * r + 1]);
                if (a >= 0) { bf16_t* rowp = Y + (size_t)a * D + col0;
#pragma unroll
                    for (int bj = 0; bj < 2; ++bj) { const f32x4 v0 = acc[ai][bj][m][0] * gt, v1 = acc[ai][bj][m][1] * gt;
                        u32x4 w; w.x = pk2(v0[0], v0[1]); w.y = pk2(v0[2], v0[3]); w.z = pk2(v1[0], v1[1]); w.w = pk2(v1[2], v1[3]);
                        *(u32x4*)(rowp + bj * 128) = w; } } }
    }
};
struct MoeOrder {
    const LAS int* tilebase; int ntiles, npn, G, c; const LAS unsigned* goff_tab;
    __device__ __forceinline__ bool next(int i, pg8::Unit& u) const {
        const long L = (long)i * G + c; if (L >= (long)ntiles * npn) return false;
        const int tau = (int)(L / npn); u.pn = (int)(L % npn); u.pm = tau; u.li = i;
        int e = 0;
        for (int j = 1; j < NEXP; ++j) e += (tilebase[j] <= tau) ? 1 : 0;
        u.e = e; return true;
    }
    __device__ __forceinline__ void a_ready(const pg8::Unit&) const {}
    __device__ __forceinline__ void done(const pg8::Unit&) const {}
    __device__ __forceinline__ void load_goff(const pg8::Unit& u, unsigned (&goff)[2][2], const int (&RA)[2], const int (&CA)[2]) const {
        const LAS unsigned* tb = goff_tab + u.li * 256;
#pragma unroll
        for (int h = 0; h < 2; ++h)
#pragma unroll
            for (int i = 0; i < 2; ++i) goff[h][i] = tb[h * 128 + RA[i]] + (unsigned)CA[i] * 2u;
    }
};

struct Args { const void* in[24]; float* out; unsigned char* ws; int ph_lo, ph_hi; };
enum InIdx { I_X = 0, I_C, I_POS, I_WADA, I_BADA, I_N1G, I_WIN, I_CONVW, I_CONVB, I_DTBIAS, I_ALOG, I_DSKIP, I_SSDG, I_QG, I_KG, I_WOUT, I_N2G, I_WRG, I_BRG, I_WRE, I_BRE, I_WG, I_WU, I_WD };

__device__ __forceinline__ float wave_sum(float v) {
#pragma unroll
    for (int o = 1; o < 64; o <<= 1) v += __shfl_xor(v, o);
    return v;
}

__device__ __forceinline__ void p0_adaln(const float* c, const float* w_ada, const float* b_ada, float* mod, LAS float* lds) {
    const int tid = threadIdx.x;
    LAS float* sc = lds; LAS float* red = lds + 4096;
    for (int i = tid; i < 2 * D; i += 512) sc[i] = silu_f(c[i]);
    __syncthreads();
    for (int cg = blockIdx.x; cg < 256; cg += gridDim.x) {
        if (tid < 504) {
            const int c4 = tid % 12, r0 = tid / 12;
            f32x4 a0 = {0.f, 0.f, 0.f, 0.f}, a1 = {0.f, 0.f, 0.f, 0.f};
            const float* wp = w_ada + 48 * cg + 4 * c4;
#pragma unroll 7
            for (int k = r0; k < D; k += 42) { const f32x4 w = *(const f32x4*)(wp + (size_t)k * 12288); a0 += w * sc[k]; a1 += w * sc[D + k]; }
            LAS float* rp = red + (r0 * 12 + c4) * 8;
            rp[0] = a0[0]; rp[1] = a0[1]; rp[2] = a0[2]; rp[3] = a0[3]; rp[4] = a1[0]; rp[5] = a1[1]; rp[6] = a1[2]; rp[7] = a1[3];
        }
        __syncthreads();
        if (tid < 96) {
            const int c4 = tid >> 3, j = tid & 7; float s = 0.f;
            for (int r = 0; r < 42; ++r) s += red[(r * 12 + c4) * 8 + j];
            const int col = 48 * cg + 4 * c4 + (j & 3);
            mod[(j >> 2) * 12288 + col] = s + b_ada[col];
        }
        __syncthreads();
    }
}
template <class RowMap>
__device__ __forceinline__ void transpose_item(const float* W, int ldw, int nvalid, bf16_t* WT, int ldt, int k0, int n0, LAS float* scr, int lane, RowMap rm) {
#pragma unroll 4
    for (int it = 0; it < 16; ++it) {
        const int kk = 4 * it + (lane >> 4), n = n0 + 4 * (lane & 15);
        f32x4 v = {0.f, 0.f, 0.f, 0.f};
        if (n < nvalid) v = *(const f32x4*)(W + (size_t)(k0 + kk) * ldw + n);
        LAS float* s = scr + kk * 65 + 4 * (lane & 15);
        s[0] = v[0]; s[1] = v[1]; s[2] = v[2]; s[3] = v[3];
    }
    LDS_WAIT(); asm volatile("" ::: "memory");
    const int c = lane & 7;
#pragma unroll
    for (int j = 0; j < 8; ++j) {
        const int nn = (lane >> 3) + 8 * j, n = n0 + nn;
        const LAS float* s = scr + (8 * c) * 65 + nn;
        u32x4 o; o.x = pk2(s[0], s[65]); o.y = pk2(s[2 * 65], s[3 * 65]); o.z = pk2(s[4 * 65], s[5 * 65]); o.w = pk2(s[6 * 65], s[7 * 65]);
        if (n < nvalid) *(u32x4*)(WT + (size_t)rm(n) * ldt + k0 + 8 * c) = o;
    }
    LDS_WAIT(); asm volatile("" ::: "memory");
}
struct RmId { __device__ __forceinline__ int operator()(int n) const { return n; } };
struct RmGU { int add; __device__ __forceinline__ int operator()(int n) const { return 8 * (n >> 2) + add + (n & 3); } };

__device__ __forceinline__ void p0_prologue(const Args& A, LAS unsigned char* lds) {
    const int tid = threadIdx.x, lane = tid & 63, wave = tid >> 6;
    unsigned char* ws = A.ws;
    p0_adaln((const float*)A.in[I_C], (const float*)A.in[I_WADA], (const float*)A.in[I_BADA], (float*)(ws + WS_MOD), (LAS float*)lds);
    const int gtid = blockIdx.x * 512 + tid, NT = gridDim.x * 512;
    { const int* pos = (const int*)A.in[I_POS]; float* rope = (float*)(ws + WS_ROPE);
      for (int i = gtid; i < T * 32; i += NT) { const int t = i >> 5, f = i & 31;
          const float invf = powf(10000.0f, -(float)f / 32.0f); const float ang = (float)pos[t] * invf;
          const double rev = (double)ang * 0.15915494309189533577; const float fr = (float)(rev - rint(rev));
          rope[2 * i] = __builtin_amdgcn_cosf(fr); rope[2 * i + 1] = __builtin_amdgcn_sinf(fr); } }
    { const float* wrg = (const float*)A.in[I_WRG]; const float* wre = (const float*)A.in[I_WRE]; bf16_t* hi = (bf16_t*)(ws + WS_WRT); bf16_t* lo = hi + NRT * D;
      for (int i = gtid; i < NRT * D; i += NT) { const int n = i / D, k = i % D; float w = 0.f;
          if (n < 8) w = wrg[k * 8 + n]; else if (n >= 16) w = wre[k * 64 + (n - 16)];
          const unsigned h = f2bf(w); hi[i] = (bf16_t)h; lo[i] = (bf16_t)f2bf(w - bf2f(h)); } }
    { u32x4* z = (u32x4*)(ws + WS_WINT + (size_t)NPROJ * D * 2); const int n16 = (NPROJ_PAD - NPROJ) * D * 2 / 16;
      for (int i = gtid; i < n16; i += NT) z[i] = (u32x4){0u, 0u, 0u, 0u}; }
    __syncthreads();
    LAS float* scr = (LAS float*)(lds) + wave * (64 * 65);
    const int gw = blockIdx.x * 8 + wave, NGW = gridDim.x * 8;
    constexpr int I_IN = 32 * 89, I_OUT = 32 * 32, I_E = 32 * 8, I_DN = 8 * 32;
    constexpr int NITEMS = I_IN + I_OUT + NEXP * (2 * I_E + I_DN);
    for (int it = gw; it < NITEMS; it += NGW) {
        int r = it;
        if (r < I_IN) { transpose_item((const float*)A.in[I_WIN], NPROJ, NPROJ, (bf16_t*)(ws + WS_WINT), D, 64 * (r / 89), 64 * (r % 89), scr, lane, RmId{}); continue; } r -= I_IN;
        if (r < I_OUT) { transpose_item((const float*)A.in[I_WOUT], D, D, (bf16_t*)(ws + WS_WOUTT), D, 64 * (r / 32), 64 * (r % 32), scr, lane, RmId{}); continue; } r -= I_OUT;
        const int e = r / (2 * I_E + I_DN); r -= e * (2 * I_E + I_DN);
        if (r < I_E) { transpose_item((const float*)A.in[I_WG] + (size_t)e * D * EH, EH, EH, (bf16_t*)(ws + WS_WGUT) + (size_t)e * 1024 * D, D, 64 * (r / 8), 64 * (r % 8), scr, lane, RmGU{0}); continue; } r -= I_E;
        if (r < I_E) { transpose_item((const float*)A.in[I_WU] + (size_t)e * D * EH, EH, EH, (bf16_t*)(ws + WS_WGUT) + (size_t)e * 1024 * D, D, 64 * (r / 8), 64 * (r % 8), scr, lane, RmGU{4}); continue; } r -= I_E;
        transpose_item((const float*)A.in[I_WD] + (size_t)e * EH * D, D, D, (bf16_t*)(ws + WS_WDT) + (size_t)e * D * EH, EH, 64 * (r / 32), 64 * (r % 32), scr, lane, RmId{});
    }
}

__device__ __forceinline__ void p1_norm1(const Args& A) {
    const int tid = threadIdx.x, lane = tid & 63, wave = tid >> 6;
    const float* x = (const float*)A.in[I_X]; const float* g1 = (const float*)A.in[I_N1G]; const float* mod = (const float*)(A.ws + WS_MOD);
    bf16_t* hb = (bf16_t*)(A.ws + WS_HB);
    const int gw = blockIdx.x * 8 + wave, NGW = gridDim.x * 8;
    for (int m = gw; m < T; m += NGW) {
        const f32x4* xr = (const f32x4*)(x + (size_t)m * D) + lane;
        f32x4 v[8]; float s = 0.f;
#pragma unroll
        for (int j = 0; j < 8; ++j) { v[j] = xr[64 * j]; s += (v[j][0] * v[j][0] + v[j][1] * v[j][1]) + (v[j][2] * v[j][2] + v[j][3] * v[j][3]); }
        const float rstd = rsqrtf(wave_sum(s) * (1.f / D) + RMS_EPS);
        const float* mb = mod + (m >= SEQ ? 12288 : 0);
        u32x2* o = (u32x2*)(hb + (size_t)m * D) + lane;
#pragma unroll
        for (int j = 0; j < 8; ++j) { const int col = 4 * lane + 256 * j;
            const f32x4 g = *(const f32x4*)(g1 + col), sh = *(const f32x4*)(mb + col), sc = *(const f32x4*)(mb + D + col);
            const f32x4 h = (v[j] * rstd) * g * (sc + 1.f) + sh;
            u32x2 w; w.x = pk2(h[0], h[1]); w.y = pk2(h[2], h[3]); o[64 * j] = w; }
    }
}

__device__ __forceinline__ void p3_post(const Args& A) {
    const int tid = threadIdx.x, lane = tid & 63, wave = tid >> 6;
    unsigned char* ws = A.ws;
    bf16_t* proj = (bf16_t*)(ws + WS_PROJ);
    const int gw = blockIdx.x * 8 + wave, NGW = gridDim.x * 8;
    { const float* qg = (const float*)A.in[I_QG]; const float* kg = (const float*)A.in[I_KG]; const float* rope = (const float*)(ws + WS_ROPE);
      const int isk = lane >> 5, head = (lane >> 1) & 15, half = lane & 1;
      const float* gn = (isk ? kg : qg) + 32 * half;
      for (int t = gw; t < T; t += NGW) {
          bf16_t* p = proj + (size_t)t * NPROJ_PAD + (isk ? OFF_K : OFF_Q) + 64 * head + 32 * half;
          float v[32]; float ss = 0.f;
#pragma unroll
          for (int i = 0; i < 4; ++i) { const u32x4 w = *(const u32x4*)(p + 8 * i);
              v[8 * i + 0] = lo_f(w.x); v[8 * i + 1] = hi_f(w.x); v[8 * i + 2] = lo_f(w.y); v[8 * i + 3] = hi_f(w.y);
              v[8 * i + 4] = lo_f(w.z); v[8 * i + 5] = hi_f(w.z); v[8 * i + 6] = lo_f(w.w); v[8 * i + 7] = hi_f(w.w); }
#pragma unroll
          for (int i = 0; i < 32; ++i) ss += v[i] * v[i];
          ss += __shfl_xor(ss, 1);
          const float rstd = rsqrtf(ss * (1.f / 64.f) + RMS_EPS);
          const float sc = isk ? 1.f : 0.125f;
          const float* rp = rope + (size_t)t * 64;
          unsigned ow[16];
#pragma unroll
          for (int i = 0; i < 32; i += 2) {
              float o2[2];
#pragma unroll
              for (int j = 0; j < 2; ++j) { const float mine = v[i + j] * rstd * gn[i + j]; const float other = __shfl_xor(mine, 1);
                  const float cs = rp[2 * (i + j)], sn = rp[2 * (i + j) + 1];
                  o2[j] = (half ? (other * sn + mine * cs) : (mine * cs - other * sn)) * sc; }
              ow[i >> 1] = pk2(o2[0], o2[1]); }
#pragma unroll
          for (int i = 0; i < 4; ++i) { u32x4 w; w.x = ow[4 * i]; w.y = ow[4 * i + 1]; w.z = ow[4 * i + 2]; w.w = ow[4 * i + 3]; *(u32x4*)(p + 8 * i) = w; }
      } }
    { const float* cw = (const float*)A.in[I_CONVW]; const float* cb = (const float*)A.in[I_CONVB]; bf16_t* xc = (bf16_t*)(ws + WS_HB);
      const int gtid = blockIdx.x * 512 + tid, NT = gridDim.x * 512;
      for (int i = gtid; i < T * (XBCW / 8); i += NT) {
          const int t = i / (XBCW / 8), c8 = (i % (XBCW / 8)) * 8, s = t & (SEQ - 1);
          float acc[8];
#pragma unroll
          for (int j = 0; j < 8; ++j) acc[j] = cb[c8 + j];
#pragma unroll
          for (int k = 0; k < 5; ++k) { const int ss = s + k - 2;
              if (ss >= 0 && ss < SEQ) { const u32x4 w = *(const u32x4*)(proj + (size_t)(t + k - 2) * NPROJ_PAD + OFF_XBC + c8);
                  const f32x4 w0 = *(const f32x4*)(cw + k * XBCW + c8), w1 = *(const f32x4*)(cw + k * XBCW + c8 + 4);
                  acc[0] += lo_f(w.x) * w0[0]; acc[1] += hi_f(w.x) * w0[1]; acc[2] += lo_f(w.y) * w0[2]; acc[3] += hi_f(w.y) * w0[3];
                  acc[4] += lo_f(w.z) * w1[0]; acc[5] += hi_f(w.z) * w1[1]; acc[6] += lo_f(w.w) * w1[2]; acc[7] += hi_f(w.w) * w1[3]; } }
          u32x4 o; o.x = pk2(silu_f(acc[0]), silu_f(acc[1])); o.y = pk2(silu_f(acc[2]), silu_f(acc[3])); o.z = pk2(silu_f(acc[4]), silu_f(acc[5])); o.w = pk2(silu_f(acc[6]), silu_f(acc[7]));
          *(u32x4*)(xc + (size_t)t * XBCW + c8) = o; } }
    { const float* dtraw = (const float*)(ws + WS_DTRAW); const float* dtbias = (const float*)A.in[I_DTBIAS]; const float* alog = (const float*)A.in[I_ALOG];
      float* dtf = (float*)(ws + WS_DTF); float* dtb = (float*)(ws + WS_DTB); float* acs = (float*)(ws + WS_ACS); float* rcs = (float*)(ws + WS_RCS); float* dec = (float*)(ws + WS_DEC);
      const int gtid = blockIdx.x * 512 + tid, NT = gridDim.x * 512;
      for (int i = gtid; i < BATCH * NCHUNK * 32; i += NT) {
          const int h = i & 15, dir = (i >> 4) & 1, bc = i >> 5; const int t0 = bc * CHUNK;
          const float aneg = -__expf(alog[dir * 16 + h]), bias = dtbias[dir * 16 + h];
          float run = 0.f;
          if (dir == 0) { for (int l = 0; l < CHUNK; ++l) { const float r = dtraw[(size_t)(t0 + l) * 32 + h] + bias; const float d = r > 20.f ? r : log1pf(__expf(r));
                  run += d * aneg; dtf[(size_t)(t0 + l) * 16 + h] = d; acs[(size_t)(t0 + l) * 16 + h] = run; } }
          else { for (int l = CHUNK - 1; l >= 0; --l) { const float r = dtraw[(size_t)(t0 + l) * 32 + 16 + h] + bias; const float d = r > 20.f ? r : log1pf(__expf(r));
                  run += d * aneg; dtb[(size_t)(t0 + l) * 16 + h] = d; rcs[(size_t)(t0 + l) * 16 + h] = run; } }
          dec[i] = __expf(run);
      } }
}

__device__ __forceinline__ bf16x8 mk_frag(u32x4 w) { return __builtin_bit_cast(bf16x8, w); }
__device__ __forceinline__ f32x4 mfma16(bf16x8 a, bf16x8 b, f32x4 c) { return __builtin_amdgcn_mfma_f32_16x16x32_bf16(a, b, c, 0, 0, 0); }

constexpr int SP = 136;
__device__ __forceinline__ void p4_ssd_local(const Args& A, LAS unsigned char* lds) {
    const int tid = threadIdx.x, lane = tid & 63, w = __builtin_amdgcn_readfirstlane(tid >> 6), fr = lane & 15, fq = lane >> 4;
    unsigned char* ws = A.ws;
    const bf16_t* xc = (const bf16_t*)(ws + WS_HB);
    const float* DTF = (const float*)(ws + WS_DTF); const float* DTB = (const float*)(ws + WS_DTB); const float* ACS = (const float*)(ws + WS_ACS); const float* RCS = (const float*)(ws + WS_RCS);
    float* YD = (float*)(ws + WS_YD); float* ST = (float*)(ws + WS_ST);
    LAS bf16_t* Cs = (LAS bf16_t*)lds; LAS bf16_t* Bs = (LAS bf16_t*)(lds + 34816); LAS bf16_t* BT = (LAS bf16_t*)(lds + 69632);
    LAS float* VEC = (LAS float*)(lds + 104448);
    LAS bf16_t* XT = Bs;
    for (int u = blockIdx.x; u < BATCH * NCHUNK * 2; u += gridDim.x) {
        const int b = u >> 7, c = (u >> 1) & 63, g = u & 1; const int t0 = b * SEQ + c * CHUNK;
        { const int l = tid >> 2, q = tid & 3; const bf16_t* src = xc + (size_t)(t0 + l) * XBCW + 1024 + 128 * g + 32 * q;
#pragma unroll
          for (int i = 0; i < 4; ++i) { const u32x4 vb = *(const u32x4*)(src + 8 * i), vc = *(const u32x4*)(src + 256 + 8 * i);
              *(LAS u32x4*)(Bs + l * SP + 32 * q + 8 * i) = vb; *(LAS u32x4*)(Cs + l * SP + 32 * q + 8 * i) = vc;
              const unsigned ww[4] = {vb.x, vb.y, vb.z, vb.w};
#pragma unroll
              for (int j = 0; j < 4; ++j) { BT[(32 * q + 8 * i + 2 * j) * SP + l] = (bf16_t)(ww[j] & 0xffffu); BT[(32 * q + 8 * i + 2 * j + 1) * SP + l] = (bf16_t)(ww[j] >> 16); } } }
        __syncthreads();
        { bf16x8 af[4];
#pragma unroll
          for (int ks = 0; ks < 4; ++ks) af[ks] = *(const LAS bf16x8*)(Cs + (16 * w + fr) * SP + 32 * ks + 8 * fq);
          f32x4 cbv[8];
#pragma unroll
          for (int st = 0; st < 8; ++st) { f32x4 acc = {0.f, 0.f, 0.f, 0.f};
#pragma unroll
              for (int ks = 0; ks < 4; ++ks) acc = mfma16(af[ks], *(const LAS bf16x8*)(Bs + (16 * st + fr) * SP + 32 * ks + 8 * fq), acc);
              cbv[st] = acc; }
#pragma unroll
          for (int st = 0; st < 8; ++st)
#pragma unroll
              for (int r = 0; r < 4; ++r) Cs[(16 * w + 4 * fq + r) * SP + 16 * st + fr] = (bf16_t)f2bf(cbv[st][r]); }
        __syncthreads();
        bf16x8 btf[4];
#pragma unroll
        for (int ks = 0; ks < 4; ++ks) btf[ks] = *(const LAS bf16x8*)(BT + (16 * w + fr) * SP + 32 * ks + 8 * fq);
        for (int hh = 0; hh < 8; ++hh) {
            const int h = 8 * g + hh;
            { const int l = tid >> 2, q = tid & 3; const bf16_t* src = xc + (size_t)(t0 + l) * XBCW + 64 * h + 16 * q;
#pragma unroll
              for (int i = 0; i < 2; ++i) { const u32x4 v = *(const u32x4*)(src + 8 * i); const unsigned ww[4] = {v.x, v.y, v.z, v.w};
#pragma unroll
                  for (int j = 0; j < 4; ++j) { XT[(16 * q + 8 * i + 2 * j) * SP + l] = (bf16_t)(ww[j] & 0xffffu); XT[(16 * q + 8 * i + 2 * j + 1) * SP + l] = (bf16_t)(ww[j] >> 16); } } }
            if (tid < 128) { const int l = tid; const size_t o = (size_t)(t0 + l) * 16 + h;
                const float df = DTF[o], db = DTB[o], ac = ACS[o], rc = RCS[o];
                const float acl = ACS[(size_t)(t0 + 127) * 16 + h], rcf = RCS[(size_t)t0 * 16 + h];
                VEC[l] = df; VEC[128 + l] = db; VEC[256 + l] = ac; VEC[384 + l] = rc; VEC[512 + l] = __expf(acl - ac) * df; VEC[640 + l] = __expf(rcf - rc) * db; }
            __syncthreads();
            { const int l = 16 * w + fr; const float ac_l = VEC[256 + l], rc_l = VEC[384 + l];
              f32x4 acc[4];
#pragma unroll
              for (int pt = 0; pt < 4; ++pt) acc[pt] = (f32x4){0.f, 0.f, 0.f, 0.f};
#pragma unroll
              for (int ks = 0; ks < 4; ++ks) { const int s0 = 32 * ks + 8 * fq;
                  const u32x4 cb = *(const LAS u32x4*)(Cs + l * SP + s0); const unsigned cw[4] = {cb.x, cb.y, cb.z, cb.w};
                  float mv[8];
#pragma unroll
                  for (int j = 0; j < 8; ++j) { const int s = s0 + j; const float cbj = (j & 1) ? hi_f(cw[j >> 1]) : lo_f(cw[j >> 1]);
                      const float df = VEC[s], db = VEC[128 + s], ac = VEC[256 + s], rc = VEC[384 + s];
                      const float arg = (s < l) ? (ac_l - ac) : (rc_l - rc);
                      const float wg = (s < l) ? df : ((s > l) ? db : df + db);
                      mv[j] = cbj * __expf(arg) * wg; }
                  u32x4 mw; mw.x = pk2(mv[0], mv[1]); mw.y = pk2(mv[2], mv[3]); mw.z = pk2(mv[4], mv[5]); mw.w = pk2(mv[6], mv[7]);
                  const bf16x8 afr = mk_frag(mw);
#pragma unroll
                  for (int pt = 0; pt < 4; ++pt) acc[pt] = mfma16(afr, *(const LAS bf16x8*)(XT + (16 * pt + fr) * SP + s0), acc[pt]); }
#pragma unroll
              for (int pt = 0; pt < 4; ++pt)
#pragma unroll
                  for (int r = 0; r < 4; ++r) YD[(size_t)(t0 + 16 * w + 4 * fq + r) * 1024 + 64 * h + 16 * pt + fr] = acc[pt][r]; }
#pragma unroll
            for (int dir = 0; dir < 2; ++dir) {
                float* stp = ST + ((size_t)(((b * NCHUNK + c) * 2 + dir) * 16 + h)) * 8192;
#pragma unroll
                for (int pt = 0; pt < 4; ++pt) { f32x4 acc = {0.f, 0.f, 0.f, 0.f};
#pragma unroll
                    for (int ks = 0; ks < 4; ++ks) { const int s0 = 32 * ks + 8 * fq;
                        const u32x4 xv = *(const LAS u32x4*)(XT + (16 * pt + fr) * SP + s0); const unsigned xw[4] = {xv.x, xv.y, xv.z, xv.w};
                        const f32x4 w0 = *(const LAS f32x4*)(VEC + 512 + 128 * dir + s0), w1 = *(const LAS f32x4*)(VEC + 512 + 128 * dir + s0 + 4);
                        u32x4 aw; aw.x = pk2(lo_f(xw[0]) * w0[0], hi_f(xw[0]) * w0[1]); aw.y = pk2(lo_f(xw[1]) * w0[2], hi_f(xw[1]) * w0[3]);
                        aw.z = pk2(lo_f(xw[2]) * w1[0], hi_f(xw[2]) * w1[1]); aw.w = pk2(lo_f(xw[3]) * w1[2], hi_f(xw[3]) * w1[3]);
                        acc = mfma16(mk_frag(aw), btf[ks], acc); }
#pragma unroll
                    for (int r = 0; r < 4; ++r) stp[(16 * pt + 4 * fq + r) * 128 + 16 * w + fr] = acc[r]; }
            }
            __syncthreads();
        }
    }
}

__device__ __forceinline__ void p5_scan(const Args& A) {
    float* ST = (float*)(A.ws + WS_ST); const float* DEC = (const float*)(A.ws + WS_DEC);
    const int gtid = blockIdx.x * 512 + threadIdx.x, NT = gridDim.x * 512;
    for (int i = gtid; i < BATCH * 2 * 16 * 2048; i += NT) {
        const int e4 = i & 2047, h = (i >> 11) & 15, dir = (i >> 15) & 1, b = i >> 16;
        f32x4 st = {0.f, 0.f, 0.f, 0.f};
        for (int cc = 0; cc < NCHUNK; cc += 8) {
            f32x4 v[8]; float dc[8];
#pragma unroll
            for (int j = 0; j < 8; ++j) { const int c = dir ? (NCHUNK - 1 - (cc + j)) : (cc + j);
                v[j] = *(const f32x4*)(ST + ((size_t)(((b * NCHUNK + c) * 2 + dir) * 16 + h)) * 8192 + 4 * e4); dc[j] = DEC[(b * NCHUNK + c) * 32 + dir * 16 + h]; }
#pragma unroll
            for (int j = 0; j < 8; ++j) { const int c = dir ? (NCHUNK - 1 - (cc + j)) : (cc + j);
                *(f32x4*)(ST + ((size_t)(((b * NCHUNK + c) * 2 + dir) * 16 + h)) * 8192 + 4 * e4) = st; st = st * dc[j] + v[j]; }
        }
    }
}

constexpr int KP = 72, VP = 264;
__device__ __forceinline__ void p4_attn(const Args& A, LAS unsigned char* lds) {
    const int tid = threadIdx.x, lane = tid & 63, w = __builtin_amdgcn_readfirstlane(tid >> 6), fr = lane & 15, fq = lane >> 4;
    unsigned char* ws = A.ws;
    const bf16_t* proj = (const bf16_t*)(ws + WS_PROJ);
    bf16_t* AO = (bf16_t*)(ws + WS_AO); float* ML = (float*)(ws + WS_ML);
    LAS bf16_t* Ks = (LAS bf16_t*)lds; LAS bf16_t* VT = (LAS bf16_t*)(lds + 36864);
    for (int u = blockIdx.x; u < 3 * 2048; u += gridDim.x) {
        const int br = u >> 11, rem = u & 2047, b = rem >> 10, h = (rem >> 6) & 15, cb = rem & 63;
        const int d = 1 << (2 * br), cls = cb & (d - 1), blk = cb >> (2 * br), n = SEQ >> (2 * br);
        { const int j = tid >> 1, half = tid & 1; const int kj = 128 * blk - 64 + j; const bool valid = (kj >= 0 && kj < n);
          const bf16_t* src = proj + (size_t)(b * SEQ + cls + d * (valid ? kj : 0)) * NPROJ_PAD + 64 * h + 32 * half;
#pragma unroll
          for (int i = 0; i < 4; ++i) { u32x4 vk = {0u, 0u, 0u, 0u}, vv = {0u, 0u, 0u, 0u};
              if (valid) { vk = *(const u32x4*)(src + OFF_K + 8 * i); vv = *(const u32x4*)(src + OFF_V + 8 * i); }
              *(LAS u32x4*)(Ks + j * KP + 32 * half + 8 * i) = vk;
              const unsigned ww[4] = {vv.x, vv.y, vv.z, vv.w};
#pragma unroll
              for (int jj = 0; jj < 4; ++jj) { VT[(32 * half + 8 * i + 2 * jj) * VP + j] = (bf16_t)(ww[jj] & 0xffffu); VT[(32 * half + 8 * i + 2 * jj + 1) * VP + j] = (bf16_t)(ww[jj] >> 16); } } }
        __syncthreads();
        const int qi = 128 * blk + 16 * w + fr; const size_t tq = (size_t)b * SEQ + cls + (size_t)d * qi;
        bf16x8 qf[2];
#pragma unroll
        for (int ks = 0; ks < 2; ++ks) qf[ks] = *(const bf16x8*)(proj + tq * NPROJ_PAD + OFF_Q + 64 * h + 32 * ks + 8 * fq);
        f32x4 st[9]; float mx = -3.0e38f;
#pragma unroll
        for (int kt = 0; kt < 9; ++kt) { f32x4 acc = {0.f, 0.f, 0.f, 0.f};
#pragma unroll
            for (int ks = 0; ks < 2; ++ks) acc = mfma16(*(const LAS bf16x8*)(Ks + (16 * w + 16 * kt + fr) * KP + 32 * ks + 8 * fq), qf[ks], acc);
#pragma unroll
            for (int r = 0; r < 4; ++r) { const int off = 16 * kt + 4 * fq + r - 64 - fr; const int kj = qi + off;
                const bool ok = (off >= -64) && (off <= 64) && (kj >= 0) && (kj < n);
                acc[r] = ok ? acc[r] * LOG2E : -1.0e30f; mx = fmaxf(mx, acc[r]); }
            st[kt] = acc; }
        mx = fmaxf(mx, __shfl_xor(mx, 16)); mx = fmaxf(mx, __shfl_xor(mx, 32));
        float sum = 0.f;
#pragma unroll
        for (int kt = 0; kt < 9; ++kt)
#pragma unroll
            for (int r = 0; r < 4; ++r) { const float p = __builtin_amdgcn_exp2f(st[kt][r] - mx); st[kt][r] = p; sum += p; }
        sum += __shfl_xor(sum, 16); sum += __shfl_xor(sum, 32);
        bf16x8 pf[5];
#pragma unroll
        for (int k2 = 0; k2 < 5; ++k2) { u32x4 pw; pw.x = pk2(st[2 * k2][0], st[2 * k2][1]); pw.y = pk2(st[2 * k2][2], st[2 * k2][3]);
            if (k2 < 4) { pw.z = pk2(st[2 * k2 + 1][0], st[2 * k2 + 1][1]); pw.w = pk2(st[2 * k2 + 1][2], st[2 * k2 + 1][3]); } else { pw.z = 0u; pw.w = 0u; }
            pf[k2] = mk_frag(pw); }
        const float inv = 1.f / sum;
#pragma unroll
        for (int et = 0; et < 4; ++et) { f32x4 acc = {0.f, 0.f, 0.f, 0.f};
#pragma unroll
            for (int k2 = 0; k2 < 5; ++k2) { const LAS bf16_t* vp = VT + (16 * et + fr) * VP + 16 * w + 32 * k2 + 4 * fq;
                const u32x2 lo = *(const LAS u32x2*)vp; u32x2 hi = {0u, 0u}; if (k2 < 4) hi = *(const LAS u32x2*)(vp + 16);
                u32x4 vw; vw.x = lo.x; vw.y = lo.y; vw.z = hi.x; vw.w = hi.y;
                acc = mfma16(mk_frag(vw), pf[k2], acc); }
            u32x2 o; o.x = pk2(acc[0] * inv, acc[1] * inv); o.y = pk2(acc[2] * inv, acc[3] * inv);
            *(u32x2*)(AO + ((size_t)br * T + tq) * 1024 + 64 * h + 16 * et + 4 * fq) = o; }
        if (fq == 0) { f32x2 ml = {mx, sum}; *(f32x2*)(ML + (((size_t)br * T + tq) * 16 + h) * 2) = ml; }
        __syncthreads();
    }
}

__device__ __forceinline__ void p6_ssd_final(const Args& A, LAS unsigned char* lds) {
    const int tid = threadIdx.x, lane = tid & 63, w = __builtin_amdgcn_readfirstlane(tid >> 6), fr = lane & 15, fq = lane >> 4;
    unsigned char* ws = A.ws;
    const bf16_t* xc = (const bf16_t*)(ws + WS_HB); const bf16_t* proj = (const bf16_t*)(ws + WS_PROJ);
    const float* ACS = (const float*)(ws + WS_ACS); const float* RCS = (const float*)(ws + WS_RCS);
    const float* YD = (const float*)(ws + WS_YD); const float* ST = (const float*)(ws + WS_ST);
    const float* dskip = (const float*)A.in[I_DSKIP]; const float* sg = (const float*)A.in[I_SSDG];
    bf16_t* mix = (bf16_t*)(ws + WS_MIX);
    LAS bf16_t* Cs = (LAS bf16_t*)lds;
    LAS float* EF = (LAS float*)(lds + 34816);
    LAS float* RED = (LAS float*)(lds + 34816 + 8192);
    LAS float* YT = (LAS float*)(lds + 45056) + w * (32 * 68);
    const int prow = lane >> 1, pch = (lane & 1) * 32;
    for (int u = blockIdx.x; u < BATCH * NCHUNK * 2; u += gridDim.x) {
        const int b = u >> 7, c = (u >> 1) & 63, hf = u & 1; const int t0 = b * SEQ + c * CHUNK + 64 * hf;
        { const int row = tid >> 3, part = tid & 7, grp = part >> 2, q = part & 3; const bf16_t* src = xc + (size_t)(t0 + row) * XBCW + 1280 + 128 * grp + 32 * q;
#pragma unroll
          for (int i = 0; i < 4; ++i) *(LAS u32x4*)(Cs + grp * 64 * SP + row * SP + 32 * q + 8 * i) = *(const u32x4*)(src + 8 * i);
#pragma unroll
          for (int k = 0; k < 4; ++k) { const int idx = tid + 512 * k, dir = idx >> 10, hh = (idx >> 6) & 15, row2 = idx & 63;
              EF[idx] = __expf((dir ? RCS : ACS)[(size_t)(t0 + row2) * 16 + hh]); } }
        __syncthreads();
        const int grp = w >> 2;
        float ssr[2] = {0.f, 0.f};
#pragma unroll 1
        for (int hx = 0; hx < 2; ++hx) {
            const int h = 2 * w + hx;
            f32x4 y[4][4];
#pragma unroll
            for (int rt = 0; rt < 4; ++rt)
#pragma unroll
                for (int pt = 0; pt < 4; ++pt) y[rt][pt] = (f32x4){0.f, 0.f, 0.f, 0.f};
#pragma unroll 1
            for (int dk = 0; dk < 8; ++dk) {
                const int dir = dk >> 2, ks = dk & 3;
                const float* stp = ST + ((size_t)(((b * NCHUNK + c) * 2 + dir) * 16 + h)) * 8192 + 32 * ks + 8 * fq;
                bf16x8 hfr[4];
#pragma unroll
                for (int pt = 0; pt < 4; ++pt) { const float* p = stp + (16 * pt + fr) * 128; const f32x4 a = *(const f32x4*)p, bb = *(const f32x4*)(p + 4);
                    u32x4 hw; hw.x = pk2(a[0], a[1]); hw.y = pk2(a[2], a[3]); hw.z = pk2(bb[0], bb[1]); hw.w = pk2(bb[2], bb[3]); hfr[pt] = mk_frag(hw); }
#pragma unroll
                for (int rt = 0; rt < 4; ++rt) {
                    const u32x4 cw = *(const LAS u32x4*)(Cs + grp * 64 * SP + (16 * rt + fr) * SP + 32 * ks + 8 * fq);
                    const float ev = EF[dir * 1024 + h * 64 + 16 * rt + fr];
                    u32x4 aw; aw.x = pk2(lo_f(cw.x) * ev, hi_f(cw.x) * ev); aw.y = pk2(lo_f(cw.y) * ev, hi_f(cw.y) * ev); aw.z = pk2(lo_f(cw.z) * ev, hi_f(cw.z) * ev); aw.w = pk2(lo_f(cw.w) * ev, hi_f(cw.w) * ev);
                    const bf16x8 af = mk_frag(aw);
#pragma unroll
                    for (int pt = 0; pt < 4; ++pt) y[rt][pt] = mfma16(af, hfr[pt], y[rt][pt]); }
            }
            const float dsk = dskip[h];
#pragma unroll
            for (int pass = 0; pass < 2; ++pass) {
#pragma unroll
                for (int rtl = 0; rtl < 2; ++rtl)
#pragma unroll
                    for (int pt = 0; pt < 4; ++pt)
#pragma unroll
                        for (int r = 0; r < 4; ++r) YT[(16 * rtl + 4 * fq + r) * 68 + 16 * pt + fr] = y[2 * pass + rtl][pt][r];
                LDS_WAIT(); asm volatile("" ::: "memory");
                const size_t tok = (size_t)(t0 + 32 * pass + prow); const int col0 = 64 * h + pch;
                const float* ydp = YD + tok * 1024 + col0; const bf16_t* xp = xc + tok * XBCW + col0; const bf16_t* zp = proj + tok * NPROJ_PAD + OFF_Z + col0; bf16_t* mp = mix + tok * D + col0;
                float sacc = 0.f;
#pragma unroll
                for (int i = 0; i < 4; ++i) {
                    const f32x4 ya = *(const LAS f32x4*)(YT + prow * 68 + pch + 8 * i), yb = *(const LAS f32x4*)(YT + prow * 68 + pch + 8 * i + 4);
                    const f32x4 da = *(const f32x4*)(ydp + 8 * i), db = *(const f32x4*)(ydp + 8 * i + 4);
                    const u32x4 xv = *(const u32x4*)(xp + 8 * i), zv = *(const u32x4*)(zp + 8 * i);
                    float gv[8];
                    gv[0] = (ya[0] + da[0] + dsk * lo_f(xv.x)) * silu_f(lo_f(zv.x)); gv[1] = (ya[1] + da[1] + dsk * hi_f(xv.x)) * silu_f(hi_f(zv.x));
                    gv[2] = (ya[2] + da[2] + dsk * lo_f(xv.y)) * silu_f(lo_f(zv.y)); gv[3] = (ya[3] + da[3] + dsk * hi_f(xv.y)) * silu_f(hi_f(zv.y));
                    gv[4] = (yb[0] + db[0] + dsk * lo_f(xv.z)) * silu_f(lo_f(zv.z)); gv[5] = (yb[1] + db[1] + dsk * hi_f(xv.z)) * silu_f(hi_f(zv.z));
                    gv[6] = (yb[2] + db[2] + dsk * lo_f(xv.w)) * silu_f(lo_f(zv.w)); gv[7] = (yb[3] + db[3] + dsk * hi_f(xv.w)) * silu_f(hi_f(zv.w));
#pragma unroll
                    for (int j = 0; j < 8; ++j) sacc += gv[j] * gv[j];
                    u32x4 o; o.x = pk2(gv[0], gv[1]); o.y = pk2(gv[2], gv[3]); o.z = pk2(gv[4], gv[5]); o.w = pk2(gv[6], gv[7]);
                    *(u32x4*)(mp + 8 * i) = o; }
                ssr[pass] += sacc;
                LDS_WAIT(); asm volatile("" ::: "memory");
            }
        }
#pragma unroll
        for (int pass = 0; pass < 2; ++pass) { float v = ssr[pass]; v += __shfl_xor(v, 1); if ((lane & 1) == 0) RED[(32 * pass + prow) * 8 + w] = v; }
        VM_WAIT();
        __syncthreads();
#pragma unroll
        for (int pass = 0; pass < 2; ++pass) { const LAS float* rp = RED + (32 * pass + prow) * 8; const f32x4 a = *(const LAS f32x4*)rp, bb = *(const LAS f32x4*)(rp + 4);
            ssr[pass] = rsqrtf(((a[0] + a[1]) + (a[2] + a[3]) + (bb[0] + bb[1]) + (bb[2] + bb[3])) * (1.f / 1024.f) + RMS_EPS); }
#pragma unroll 1
        for (int hx = 0; hx < 2; ++hx) { const int h = 2 * w + hx; const int col0 = 64 * h + pch;
#pragma unroll
            for (int pass = 0; pass < 2; ++pass) { bf16_t* mp = mix + (size_t)(t0 + 32 * pass + prow) * D + col0; const float rs = ssr[pass];
#pragma unroll
                for (int i = 0; i < 4; ++i) { const u32x4 v = *(const u32x4*)(mp + 8 * i); const f32x4 g0 = *(const f32x4*)(sg + col0 + 8 * i), g1 = *(const f32x4*)(sg + col0 + 8 * i + 4);
                    u32x4 o; o.x = pk2(lo_f(v.x) * rs * g0[0], hi_f(v.x) * rs * g0[1]); o.y = pk2(lo_f(v.y) * rs * g0[2], hi_f(v.y) * rs * g0[3]);
                    o.z = pk2(lo_f(v.z) * rs * g1[0], hi_f(v.z) * rs * g1[1]); o.w = pk2(lo_f(v.w) * rs * g1[2], hi_f(v.w) * rs * g1[3]);
                    *(u32x4*)(mp + 8 * i) = o; } } }
        __syncthreads();
    }
}

__device__ __forceinline__ void p6_attn_merge(const Args& A) {
    unsigned char* ws = A.ws;
    const bf16_t* AO = (const bf16_t*)(ws + WS_AO); const float* ML = (const float*)(ws + WS_ML); bf16_t* mix = (bf16_t*)(ws + WS_MIX);
    const int gtid = blockIdx.x * 512 + threadIdx.x, NT = gridDim.x * 512;
    for (int i = gtid; i < T * 16 * 8; i += NT) {
        const int e8 = i & 7, h = (i >> 3) & 15, t = i >> 7;
        float m[3], l[3];
#pragma unroll
        for (int r = 0; r < 3; ++r) { const f32x2 v = *(const f32x2*)(ML + (((size_t)r * T + t) * 16 + h) * 2); m[r] = v[0]; l[r] = v[1]; }
        const float M = fmaxf(m[0], fmaxf(m[1], m[2]));
        float wgt[3], W = 0.f;
#pragma unroll
        for (int r = 0; r < 3; ++r) { wgt[r] = l[r] * __builtin_amdgcn_exp2f(m[r] - M); W += wgt[r]; }
        const float iw = 1.f / W; float o[8];
#pragma unroll
        for (int j = 0; j < 8; ++j) o[j] = 0.f;
#pragma unroll
        for (int r = 0; r < 3; ++r) { const u32x4 v = *(const u32x4*)(AO + ((size_t)r * T + t) * 1024 + 64 * h + 8 * e8); const float ww = wgt[r] * iw;
            o[0] += ww * lo_f(v.x); o[1] += ww * hi_f(v.x); o[2] += ww * lo_f(v.y); o[3] += ww * hi_f(v.y); o[4] += ww * lo_f(v.z); o[5] += ww * hi_f(v.z); o[6] += ww * lo_f(v.w); o[7] += ww * hi_f(v.w); }
        u32x4 ow; ow.x = pk2(o[0], o[1]); ow.y = pk2(o[2], o[3]); ow.z = pk2(o[4], o[5]); ow.w = pk2(o[6], o[7]);
        *(u32x4*)(mix + (size_t)t * D + 1024 + 64 * h + 8 * e8) = ow;
    }
}

__device__ __forceinline__ void p8_router(const Args& A, LAS unsigned char* lds) {
    const int tid = threadIdx.x, lane = tid & 63, w = __builtin_amdgcn_readfirstlane(tid >> 6), fr = lane & 15, fq = lane >> 4;
    unsigned char* ws = A.ws;
    const float* x1 = (const float*)(ws + WS_X1); const float* mod = (const float*)(ws + WS_MOD); const float* g2 = (const float*)A.in[I_N2G];
    const bf16_t* whi = (const bf16_t*)(ws + WS_WRT); const bf16_t* wlo = whi + NRT * D;
    const float* brg = (const float*)A.in[I_BRG]; const float* bre = (const float*)A.in[I_BRE];
    bf16_t* h2 = (bf16_t*)(ws + WS_HB);
    unsigned* cnt = (unsigned*)(ws + WS_CTL) + CW_CNT; int* elist = (int*)(ws + WS_ELIST); float* gates = (float*)(ws + WS_GATES);
    LAS float* A2 = (LAS float*)lds; LAS float* SH2 = A2 + D; LAS float* SS = (LAS float*)(lds + 16384); LAS float* ACC = (LAS float*)(lds + 16896); LAS float* LG = (LAS float*)(lds + 37376);
    const int sub = w >> 1, kh = w & 1;
    for (int tt = blockIdx.x; tt < T / 64; tt += gridDim.x) {
        const int b = (tt * 64) >= SEQ ? 1 : 0; const float* mb = mod + b * 12288;
        for (int i = tid; i < D; i += 512) { A2[i] = g2[i] * (1.f + mb[4 * D + i]); SH2[i] = mb[3 * D + i]; }
        const int tk = tt * 64 + 16 * sub + fr; const float* xr = x1 + (size_t)tk * D + 8 * fq;
        float ssq = 0.f;
#pragma unroll 4
        for (int ks = 32 * kh; ks < 32 * kh + 32; ++ks) { const f32x4 a = *(const f32x4*)(xr + 32 * ks), c = *(const f32x4*)(xr + 32 * ks + 4);
            ssq += (a[0] * a[0] + a[1] * a[1]) + (a[2] * a[2] + a[3] * a[3]) + (c[0] * c[0] + c[1] * c[1]) + (c[2] * c[2] + c[3] * c[3]); }
        ssq += __shfl_xor(ssq, 16); ssq += __shfl_xor(ssq, 32);
        if (fq == 0) SS[w * 16 + fr] = ssq;
        __syncthreads();
        const float rstd = rsqrtf((SS[(2 * sub) * 16 + fr] + SS[(2 * sub + 1) * 16 + fr]) * (1.f / D) + RMS_EPS);
        f32x4 acc[5];
#pragma unroll
        for (int ct = 0; ct < 5; ++ct) acc[ct] = (f32x4){0.f, 0.f, 0.f, 0.f};
#pragma unroll 2
        for (int ks = 32 * kh; ks < 32 * kh + 32; ++ks) { const int col = 32 * ks + 8 * fq;
            const f32x4 a = *(const f32x4*)(xr + 32 * ks), c = *(const f32x4*)(xr + 32 * ks + 4);
            const f32x4 m0 = *(const LAS f32x4*)(A2 + col), m1 = *(const LAS f32x4*)(A2 + col + 4), s0 = *(const LAS f32x4*)(SH2 + col), s1 = *(const LAS f32x4*)(SH2 + col + 4);
            const f32x4 v0 = (a * rstd) * m0 + s0, v1 = (c * rstd) * m1 + s1;
            u32x4 hw; hw.x = pk2(v0[0], v0[1]); hw.y = pk2(v0[2], v0[3]); hw.z = pk2(v1[0], v1[1]); hw.w = pk2(v1[2], v1[3]);
            u32x4 lw; lw.x = pk2(v0[0] - lo_f(hw.x), v0[1] - hi_f(hw.x)); lw.y = pk2(v0[2] - lo_f(hw.y), v0[3] - hi_f(hw.y));
            lw.z = pk2(v1[0] - lo_f(hw.z), v1[1] - hi_f(hw.z)); lw.w = pk2(v1[2] - lo_f(hw.w), v1[3] - hi_f(hw.w));
            *(u32x4*)(h2 + (size_t)tk * D + col) = hw;
            const bf16x8 ah = mk_frag(hw), al = mk_frag(lw);
#pragma unroll
            for (int ct = 0; ct < 5; ++ct) { const bf16x8 bh = *(const bf16x8*)(whi + (size_t)(16 * ct + fr) * D + col), bl = *(const bf16x8*)(wlo + (size_t)(16 * ct + fr) * D + col);
                acc[ct] = mfma16(ah, bh, acc[ct]); acc[ct] = mfma16(al, bh, acc[ct]); acc[ct] = mfma16(ah, bl, acc[ct]); } }
        if (kh == 1) {
#pragma unroll
            for (int ct = 0; ct < 5; ++ct) *(LAS f32x4*)(ACC + (sub * 64 + lane) * 20 + 4 * ct) = acc[ct]; }
        __syncthreads();
        if (kh == 0) {
#pragma unroll
            for (int ct = 0; ct < 5; ++ct) { const f32x4 o = acc[ct] + *(const LAS f32x4*)(ACC + (sub * 64 + lane) * 20 + 4 * ct);
#pragma unroll
                for (int r = 0; r < 4; ++r) LG[(sub * 16 + 4 * fq + r) * NRT + 16 * ct + fr] = o[r]; } }
        __syncthreads();
        if (kh == 0 && lane < 16) {
            const LAS float* lg = LG + (sub * 16 + lane) * NRT; const int tok = tt * 64 + 16 * sub + lane;
            float gmx = -3.0e38f; int gi = 0;
#pragma unroll
            for (int j = 0; j < 8; ++j) { const float v = lg[j] + brg[j]; if (v > gmx) { gmx = v; gi = j; } }
            float gse = 0.f;
#pragma unroll
            for (int j = 0; j < 8; ++j) gse += __expf(lg[j] + brg[j] - gmx);
            const float pgroup = 1.f / gse;
            const LAS float* el = lg + 16 + 8 * gi; const float* be = bre + 8 * gi;
            float emx = -3.0e38f; int i1 = 0;
#pragma unroll
            for (int j = 0; j < 8; ++j) { const float v = el[j] + be[j]; if (v > emx) { emx = v; i1 = j; } }
            float e2 = -3.0e38f; int i2 = 0; float ese = 0.f;
#pragma unroll
            for (int j = 0; j < 8; ++j) { const float v = el[j] + be[j]; ese += __expf(v - emx); if (j != i1 && v > e2) { e2 = v; i2 = j; } }
            const float p1 = 1.f / ese, p2 = __expf(e2 - emx) / ese; const float ps = p1 + p2;
            const float g1v = pgroup * p1 / ps, g2v = pgroup * p2 / ps;
            const int ea = 8 * gi + i1, eb = 8 * gi + i2;
            const unsigned pa = atomicAdd(cnt + ea, 1u), pb = atomicAdd(cnt + eb, 1u);
            elist[(size_t)ea * ECAP + pa] = 2 * tok; elist[(size_t)eb * ECAP + pb] = 2 * tok + 1;
            gates[2 * tok] = g1v; gates[2 * tok + 1] = g2v;
        }
        __syncthreads();
    }
}

__device__ __forceinline__ int moe_tables(const Args& A, LAS unsigned char* lds, int npn, bool down) {
    const int tid = threadIdx.x;
    unsigned char* ws = A.ws;
    const unsigned* cnt = (const unsigned*)(ws + WS_CTL) + CW_CNT; const int* elist = (const int*)(ws + WS_ELIST); const float* gates = (const float*)(ws + WS_GATES);
    LAS int* tb = (LAS int*)(lds + ETAB_OFF); LAS int* cn = tb + 80;
    if (tid < 64) cn[tid] = (int)__hip_atomic_load(cnt + tid, __ATOMIC_RELAXED, __HIP_MEMORY_SCOPE_AGENT);
    __syncthreads();
    if (tid <= 64) { int s = 0; for (int j = 0; j < tid; ++j) s += (cn[j] + 255) >> 8; tb[tid] = s; }
    __syncthreads();
    const int ntiles = tb[64];
    LAS int* tab = (LAS int*)(lds + TAB_OFF);
    const int cap = down ? 6 : 12;
    for (int li = 0; li < cap; ++li) {
        const long L = (long)li * gridDim.x + blockIdx.x; if (L >= (long)ntiles * npn) break;
        const int tau = (int)(L / npn); int e = 0;
        for (int j = 1; j < NEXP; ++j) e += (tb[j] <= tau) ? 1 : 0;
        const int mt = tau - tb[e], ce = cn[e];
        if (tid < 256) { const int pos = 256 * mt + tid; const bool ok = pos < ce; const int a = ok ? elist[(size_t)e * ECAP + pos] : -1;
            if (down) { tab[li * 512 + 2 * tid] = a; tab[li * 512 + 2 * tid + 1] = ok ? __float_as_int(gates[a]) : 0; }
            else tab[li * 256 + tid] = ok ? (a >> 1) * (D * 2) : 0; }
    }
    __syncthreads();
    return ntiles;
}

__device__ __forceinline__ void p11_combine(const Args& A) {
    unsigned char* ws = A.ws;
    const float* x1 = (const float*)(ws + WS_X1); const float* mod = (const float*)(ws + WS_MOD); const bf16_t* Y = (const bf16_t*)(ws + WS_YSLOT);
    const int gtid = blockIdx.x * 512 + threadIdx.x, NT = gridDim.x * 512;
    for (int i = gtid; i < T * (D / 8); i += NT) {
        const int t = i >> 8, c8 = (i & 255) * 8;
        const float* gp = mod + (t >= SEQ ? 12288 : 0) + 5 * D + c8;
        const f32x4 g0 = *(const f32x4*)gp, g1 = *(const f32x4*)(gp + 4);
        const f32x4 a0 = *(const f32x4*)(x1 + (size_t)t * D + c8), a1 = *(const f32x4*)(x1 + (size_t)t * D + c8 + 4);
        const u32x4 ya = *(const u32x4*)(Y + (size_t)(2 * t) * D + c8), yb = *(const u32x4*)(Y + (size_t)(2 * t + 1) * D + c8);
        f32x4 s0, s1;
        s0[0] = lo_f(ya.x) + lo_f(yb.x); s0[1] = hi_f(ya.x) + hi_f(yb.x); s0[2] = lo_f(ya.y) + lo_f(yb.y); s0[3] = hi_f(ya.y) + hi_f(yb.y);
        s1[0] = lo_f(ya.z) + lo_f(yb.z); s1[1] = hi_f(ya.z) + hi_f(yb.z); s1[2] = lo_f(ya.w) + lo_f(yb.w); s1[3] = hi_f(ya.w) + hi_f(yb.w);
        *(f32x4*)(A.out + (size_t)t * D + c8) = a0 + g0 * s0; *(f32x4*)(A.out + (size_t)t * D + c8 + 4) = a1 + g1 * s1;
    }
}

constexpr int NPH = 12;
__global__ void __launch_bounds__(512, 2) hyb_fwd(Args args) {
    extern __shared__ __attribute__((aligned(16))) unsigned char lds_raw[];
    LAS unsigned char* lds = (LAS unsigned char*)lds_raw;
    const int tid = threadIdx.x;
    volatile LAS unsigned* MISC = (volatile LAS unsigned*)(lds + MISC_OFF);
    for (int u = tid; u < 128; u += 512) MISC[u] = 0u;
    __syncthreads();
    unsigned char* ws = args.ws;
    unsigned* ctl = (unsigned*)(ws + WS_CTL);
    const int lo = args.ph_lo, hi = args.ph_hi;
    XcdBarrier bar; bar.bar = ctl + CW_BAR; bar.x = 0; bar.st = nullptr;
    if (hi - lo > 1) bar = xcd_barrier_post(ctl + CW_BAR, MISC + 8);
#ifndef PH_MASK
#define PH_MASK 0xFFF
#endif
#define IN(k) ((((PH_MASK) >> (k)) & 1) && lo <= (k) && (k) < hi)
#define SEAM(k) do { if (IN(k) && IN((k) + 1)) xcd_barrier(bar); } while (0)

    if (IN(0)) { p0_prologue(args, lds); } SEAM(0);
    if (IN(1)) { p1_norm1(args); } SEAM(1);
    if (IN(2)) {
        pg8::Gemm g{(const bf16_t*)(ws + WS_HB), (const bf16_t*)(ws + WS_WINT), D, 0};
        pg8::StaticOrder S; S.init(T, NPROJ_PAD, (int)gridDim.x, (int)blockIdx.x);
        EpiProj E{(bf16_t*)(ws + WS_PROJ), (float*)(ws + WS_DTRAW)};
        pg8::gemm_phase<EpiProj, pg8::StaticOrder, true, false>(lds, g, S, E);
    } SEAM(2);
    if (IN(3)) { p3_post(args); } SEAM(3);
    if (IN(4)) { p4_ssd_local(args, lds); p4_attn(args, lds); } SEAM(4);
    if (IN(5)) { p5_scan(args); } SEAM(5);
    if (IN(6)) { p6_ssd_final(args, lds); p6_attn_merge(args); } SEAM(6);
    if (IN(7)) {
        pg8::Gemm g{(const bf16_t*)(ws + WS_MIX), (const bf16_t*)(ws + WS_WOUTT), D, 0};
        pg8::StaticOrder S; S.init(T, D, (int)gridDim.x, (int)blockIdx.x);
        EpiOut E{(const float*)args.in[I_X], (const float*)(ws + WS_MOD), (float*)(ws + WS_X1)};
        pg8::gemm_phase<EpiOut, pg8::StaticOrder, true, false>(lds, g, S, E);
    } SEAM(7);
    if (IN(8)) { p8_router(args, lds); } SEAM(8);
    if (IN(9)) {
        const int ntiles = moe_tables(args, lds, 4, false);
        pg8::Gemm g{(const bf16_t*)(ws + WS_HB), (const bf16_t*)(ws + WS_WGUT), D, (size_t)1024 * D * 2};
        MoeOrder S{(const LAS int*)(lds + ETAB_OFF), ntiles, 4, (int)gridDim.x, (int)blockIdx.x, (const LAS unsigned*)(lds + TAB_OFF)};
        EpiGU E{(bf16_t*)(ws + WS_HMOE)};
        pg8::gemm_phase<EpiGU, MoeOrder, true, true>(lds, g, S, E);
    } SEAM(9);
    if (IN(10)) {
        const int ntiles = moe_tables(args, lds, 8, true);
        pg8::Gemm g{(const bf16_t*)(ws + WS_HMOE), (const bf16_t*)(ws + WS_WDT), EH, (size_t)D * EH * 2};
        MoeOrder S{(const LAS int*)(lds + ETAB_OFF), ntiles, 8, (int)gridDim.x, (int)blockIdx.x, (const LAS unsigned*)(lds + TAB_OFF)};
        EpiDown E{(bf16_t*)(ws + WS_YSLOT), (const LAS int*)(lds + TAB_OFF)};
        pg8::gemm_phase<EpiDown, MoeOrder, true, false>(lds, g, S, E);
    } SEAM(10);
    if (IN(11)) { p11_combine(args); }
#undef IN
#undef SEAM
}

extern "C" void kernel_launch(void* const* d_in, const int* in_sizes, int n_in, void* d_out, int out_size, void* d_ws, size_t ws_size, hipStream_t stream) {
    static int grid = 0;
    if (grid == 0) {
        if (n_in != 24 || in_sizes[0] != T * D || out_size != T * D || ws_size < WS_END) { fprintf(stderr, "kernel_launch: unexpected shapes (n_in %d, in0 %d, out %d, ws %zu < %zu); nothing launched\n", n_in, n_in > 0 ? in_sizes[0] : -1, out_size, ws_size, (size_t)WS_END); grid = -1; return; }
        int dev = 0, cus = 0, per_cu = 0;
        if (hipGetDevice(&dev) != hipSuccess || hipDeviceGetAttribute(&cus, hipDeviceAttributeMultiprocessorCount, dev) != hipSuccess) { grid = -1; return; }
        if (hipFuncSetAttribute((const void*)hyb_fwd, hipFuncAttributeMaxDynamicSharedMemorySize, LDS_BYTES) != hipSuccess) { fprintf(stderr, "kernel_launch: hipFuncSetAttribute failed\n"); grid = -1; return; }
        if (hipOccupancyMaxActiveBlocksPerMultiprocessor(&per_cu, (const void*)hyb_fwd, 512, LDS_BYTES) != hipSuccess || per_cu < 1) fprintf(stderr, "kernel_launch: occupancy query reports %d\n", per_cu);
        (void)hipGetLastError();
        grid = cus;
    }
    if (grid < 0) return;
    (void)hipMemsetAsync((char*)d_ws + WS_CTL, 0, CTL_BYTES, stream);
    Args a{};
    for (int i = 0; i < 24; ++i) a.in[i] = d_in[i];
    a.out = (float*)d_out; a.ws = (unsigned char*)d_ws;
#if MK_ONE_LAUNCH
    a.ph_lo = 0; a.ph_hi = NPH;
    hipLaunchKernelGGL(hyb_fwd, dim3(grid), dim3(512), LDS_BYTES, stream, a);
#else
    for (int p = 0; p < NPH; ++p) { a.ph_lo = p; a.ph_hi = p + 1; hipLaunchKernelGGL(hyb_fwd, dim3(grid), dim3(512), LDS_BYTES, stream, a); }
#endif
}
```

```cpp
#include <hip/hip_runtime.h>
#include <cstdio>
#include <cstdint>

#ifndef MK_ONE_LAUNCH
#define MK_ONE_LAUNCH 1
#endif

#define LAS __attribute__((address_space(3)))
#define GAS __attribute__((address_space(1)))
typedef unsigned short bf16_t;
typedef short bf16x8 __attribute__((ext_vector_type(8)));
typedef float f32x4 __attribute__((ext_vector_type(4)));
typedef float f32x2 __attribute__((ext_vector_type(2)));
typedef unsigned u32x4 __attribute__((ext_vector_type(4)));
typedef unsigned u32x2 __attribute__((ext_vector_type(2)));

constexpr int BATCH = 2, SEQ = 8192, T = BATCH * SEQ, D = 2048;
constexpr int NPROJ = 5664, NPROJ_PAD = 5888;
constexpr int OFF_Q = 0, OFF_K = 1024, OFF_V = 2048, OFF_Z = 3072, OFF_XBC = 4096, OFF_DT = 5632;
constexpr int XBCW = 1536, NHEAD = 16, CHUNK = 128, NCHUNK = SEQ / CHUNK;
constexpr int NEXP = 64, EH = 512;
constexpr int ECAP = T;
constexpr int NRT = 80;
constexpr float RMS_EPS = 1e-6f;
constexpr float LOG2E = 1.4426950408889634f;

constexpr size_t MiB = 1u << 20;
constexpr size_t WS_CTL = 0, CTL_BYTES = 1 * MiB;
constexpr size_t WS_MOD = 1 * MiB;
constexpr size_t WS_ROPE = 2 * MiB;
constexpr size_t WS_WRT = 6 * MiB;
constexpr size_t WS_SMALL = 7 * MiB;
constexpr size_t WS_DTRAW = WS_SMALL, WS_DTF = WS_SMALL + 2 * MiB, WS_DTB = WS_SMALL + 3 * MiB, WS_ACS = WS_SMALL + 4 * MiB, WS_RCS = WS_SMALL + 5 * MiB, WS_DEC = WS_SMALL + 6 * MiB;
constexpr size_t WS_ML = 14 * MiB;
constexpr size_t WS_ELIST = 20 * MiB;
constexpr size_t WS_GATES = 24 * MiB;
constexpr size_t WS_WINT = 25 * MiB;
constexpr size_t WS_WOUTT = 48 * MiB;
constexpr size_t WS_WGUT = 56 * MiB;
constexpr size_t WS_WDT = 312 * MiB;
constexpr size_t WS_HB = 440 * MiB;
constexpr size_t WS_PROJ = 504 * MiB;
constexpr size_t WS_YSLOT = WS_PROJ, WS_HMOE = WS_PROJ + 128 * MiB;
constexpr size_t WS_ST = 688 * MiB;
constexpr size_t WS_X1 = WS_ST;
constexpr size_t WS_YD = 816 * MiB;
constexpr size_t WS_AO = 880 * MiB;
constexpr size_t WS_MIX = 976 * MiB;
constexpr size_t WS_END = 1040 * MiB;

constexpr int CW_BAR = 4096;
constexpr int CW_CNT = 16384;
constexpr int CW_FLAG = 16384 + 256;

constexpr int RING_BYTES = 131072;
constexpr int MISC_OFF = 133120;
constexpr int TAB_OFF = MISC_OFF + 512;
constexpr int ETAB_OFF = TAB_OFF + 12288;
constexpr int LDS_BYTES = 147456;
static_assert(ETAB_OFF + 1024 <= LDS_BYTES, "LDS map");

__device__ __forceinline__ float bf2f(unsigned v) { return __uint_as_float(v << 16); }
__device__ __forceinline__ unsigned f2bf(float f) { unsigned u = __float_as_uint(f); return (u + 0x7fffu + ((u >> 16) & 1u)) >> 16; }
__device__ __forceinline__ unsigned pk2(float lo, float hi) { unsigned r; asm volatile("v_cvt_pk_bf16_f32 %0, %1, %2" : "=v"(r) : "v"(lo), "v"(hi)); return r; }
__device__ __forceinline__ float lo_f(unsigned w) { return __uint_as_float(w << 16); }
__device__ __forceinline__ float hi_f(unsigned w) { return __uint_as_float(w & 0xffff0000u); }
__device__ __forceinline__ float silu_f(float v) { return v / (1.f + __expf(-v)); }
#define LDS_WAIT() asm volatile("s_waitcnt lgkmcnt(0)" ::: "memory")
#define VM_WAIT() asm volatile("s_waitcnt vmcnt(0)" ::: "memory")

#define XB_TMO      128
#define XB_XCNT(j)  (256  + 64 * (j))
#define XB_XSUB(j)  (1280 + 64 * (j))
#define XB_XGEN(j)  (2304 + 64 * (j))
#define XB_TOP      3328
#define XB_TOPGEN   3392
#define XCD_BAR_WORDS 3456
#define XB_SPIN_CAP (1u << 18)
__device__ __forceinline__ unsigned xb_ld(unsigned* p)              { return __hip_atomic_load(p, __ATOMIC_RELAXED, __HIP_MEMORY_SCOPE_AGENT); }
__device__ __forceinline__ unsigned xb_add(unsigned* p, unsigned v) { return __hip_atomic_fetch_add(p, v, __ATOMIC_RELAXED, __HIP_MEMORY_SCOPE_AGENT); }
__device__ __forceinline__ unsigned xb_xcc_id() { return (unsigned)__builtin_amdgcn_s_getreg((3 << 11) | 20) & 0xFu; }
#define XB_SPIN(cond, bar) do { unsigned _sp = 0; while (cond) { __builtin_amdgcn_s_sleep(1); \
    if ((++_sp & 255u) == 0u) { if (xb_ld(&(bar)[XB_TMO])) break; if (_sp > XB_SPIN_CAP) { atomicAdd(&(bar)[XB_TMO], 1u); break; } } } } while (0)
struct XcdBarrier { unsigned* bar; unsigned x; volatile LAS unsigned* st; };
__device__ __forceinline__ XcdBarrier xcd_barrier_post(unsigned* bar, volatile LAS unsigned* st) {
    XcdBarrier b; b.bar = bar; b.x = xb_xcc_id(); b.st = st;
    if (threadIdx.x == 0) (void)xb_add(&bar[XB_XCNT(b.x)], 1u);
    return b;
}
__device__ __forceinline__ void xcd_barrier_complete(unsigned* bar, unsigned x, unsigned& nloc, unsigned& nx) {
    const unsigned G = gridDim.x * gridDim.y * gridDim.z;
    unsigned sum, cnt, mine, sp = 0u;
    for (;;) {
        sum = 0u; cnt = 0u; mine = 0u;
#pragma unroll
        for (unsigned j = 0; j < 16; ++j) { const unsigned c = xb_ld(&bar[XB_XCNT(j)]); sum += c; cnt += (c > 0u) ? 1u : 0u; mine = (j == x) ? c : mine; }
        if (sum == G) break;
        __builtin_amdgcn_s_sleep(1);
        if ((++sp & 255u) == 0u) { if (xb_ld(&bar[XB_TMO])) break; if (sp > XB_SPIN_CAP) { atomicAdd(&bar[XB_TMO], 1u); break; } }
    }
    nloc = mine > 0u ? mine : 1u; nx = cnt > 0u ? cnt : 1u;
}
__device__ __forceinline__ void xcd_barrier(const XcdBarrier& b) {
    asm volatile("s_waitcnt vmcnt(0)" ::: "memory");
    __syncthreads();
    if (threadIdx.x == 0) {
        unsigned* bar = b.bar;
        __builtin_amdgcn_s_waitcnt(0);
        unsigned nloc = b.st[0], nx = b.st[1];
        if (nloc == 0u) { xcd_barrier_complete(bar, b.x, nloc, nx); b.st[0] = nloc; b.st[1] = nx; }
        const unsigned old = xb_add(&bar[XB_XSUB(b.x)], 1u);
        const unsigned gen = old / nloc;
        if (old + 1u == (gen + 1u) * nloc) {
            __builtin_amdgcn_fence(__ATOMIC_RELEASE, "agent");
            asm volatile("s_waitcnt vmcnt(0)" ::: "memory");
            const unsigned og = xb_add(&bar[XB_TOP], 1u);
            const unsigned tg = og / nx;
            if (og + 1u == (tg + 1u) * nx) xb_add(&bar[XB_TOPGEN], 1u);
            else XB_SPIN(xb_ld(&bar[XB_TOPGEN]) == tg, bar);
            __builtin_amdgcn_fence(__ATOMIC_ACQUIRE, "agent");
            xb_add(&bar[XB_XGEN(b.x)], 1u);
            asm volatile("s_waitcnt vmcnt(0)" ::: "memory");
        } else {
            XB_SPIN(xb_ld(&bar[XB_XGEN(b.x)]) == gen, bar);
            __builtin_amdgcn_fence(__ATOMIC_ACQUIRE, "agent");
            asm volatile("s_waitcnt vmcnt(0)" ::: "memory");
        }
    }
    __syncthreads();
}

namespace pg8 {
constexpr int BM = 256, BK = 64, HALF = 128, HTB = HALF * BK * 2, STAGE_BYTES = 8 * HTB, NXCD = 8, WGM = 8;
__device__ __forceinline__ int lds_byte(int r, int c) { const int st = (r >> 4) * 2 + (c >> 5), rr = r & 15, cc = c & 31, ob = rr * 64 + cc * 2; return st * 1024 + (ob ^ (((ob >> 9) & 1) << 5)); }
__device__ __forceinline__ void stage_rc(int b, int& R, int& C) { const int st = b / 1024, sb = b % 1024, swz = sb ^ (((sb >> 9) & 1) << 5); R = (st >> 1) * 16 + swz / 64; C = (st & 1) * 32 + (swz % 64) / 2; }
__device__ __forceinline__ int perm32(int rho) { const int n = rho >> 4, i = rho & 15; return 8 * (i >> 2) + 4 * n + (i & 3); }

struct Unit { int pm, pn, e, li; };
struct Gemm { const bf16_t* A; const bf16_t* Bt; int K; size_t bstride; };

struct StaticOrder {
    int nM, nN, nwg, G, c;
    __device__ void init(int M, int N, int G_, int c_) { nM = M / BM; nN = N / BM; nwg = nM * nN; G = G_; c = c_; }
    __device__ bool next(int i, Unit& u) const {
        const long L = (long)i * G + c; if (L >= nwg) return false;
        int wgid = (int)L; { const int q = nwg / NXCD, r = nwg % NXCD, xcd = wgid % NXCD, off = wgid / NXCD; wgid = (xcd < r ? xcd * (q + 1) : r * (q + 1) + (xcd - r) * q) + off; }
        const int nig = WGM * nN, gid = wgid / nig, fm = gid * WGM, gsz = (nM - fm) < WGM ? (nM - fm) : WGM;
        u.pm = fm + ((wgid % nig) % gsz); u.pn = (wgid % nig) / gsz; u.e = 0; u.li = i; return true;
    }
    __device__ __forceinline__ void a_ready(const Unit&) const {}
    __device__ __forceinline__ void done(const Unit&) const {}
    __device__ __forceinline__ void load_goff(const Unit&, unsigned (&)[2][2], const int (&)[2], const int (&)[2]) const {}
};

template <class Epi, class Sched, bool ALIGN_EPI, bool GATHER>
__device__ __forceinline__ void gemm_phase(LAS unsigned char* lds, const Gemm g, const Sched& S, const Epi& E) {
    const int tid = threadIdx.x, wid = __builtin_amdgcn_readfirstlane(tid >> 6), lane = tid & 63, wr = wid >> 2, wc = wid & 3, fr = lane & 15, fq = lane >> 4;
    const int K = g.K, nt = K / BK;
    unsigned voffA[2], voffB[2]; int RA[2], CA[2];
#pragma unroll
    for (int i = 0; i < 2; ++i) { int R, C; stage_rc(tid * 16 + i * 8192, R, C); const int Rb = Epi::PERM ? ((R & ~31) + perm32(R & 31)) : R; RA[i] = R; CA[i] = C;
        voffA[i] = (unsigned)(R * K + C) * 2u; voffB[i] = (unsigned)(Rb * K + C) * 2u; }
    unsigned goff[2][2] = {{0u, 0u}, {0u, 0u}};
    const size_t kstep = (size_t)(BK * 2);
    const size_t hstep = (size_t)HALF * K * 2;
    const size_t tstep = 2 * hstep;
    const unsigned ldsw = (unsigned)wid * 1024u;
    const int aoff = lds_byte(wr * 64 + fr, fq * 8), boff = lds_byte(wc * 32 + fr, fq * 8);
#define PG8_SA(b, h) (((b) * 2 + (h)) * HTB)
#define PG8_SB(b, h) ((4 + (b) * 2 + (h)) * HTB)
#define PG8_STAGE(bufoff, gbase, voff) do { _Pragma("unroll") for (int _i = 0; _i < 2; ++_i) \
        __builtin_amdgcn_global_load_lds((const unsigned*)((const char*)(gbase) + (voff)[_i]), (LAS unsigned*)(lds + (bufoff) + ldsw + _i * 8192), 16, 0, 0); } while (0)
#define PG8_STAGE_A(bufoff, cptr, kb, h) do { if constexpr (GATHER) { PG8_STAGE(bufoff, (const char*)g.A + (kb), goff[h]); } else { PG8_STAGE(bufoff, (cptr) + (kb) + ((h) ? hstep : 0), voffA); } } while (0)
#define PG8_LDA(dst, b, h) do { _Pragma("unroll") for (int m = 0; m < 4; ++m) _Pragma("unroll") for (int k = 0; k < 2; ++k) dst[m][k] = *(const LAS bf16x8*)(lds + PG8_SA(b, h) + aoff + m * 2048 + k * 1024); } while (0)
#define PG8_LDB(dst, b, h) do { _Pragma("unroll") for (int n = 0; n < 2; ++n) _Pragma("unroll") for (int k = 0; k < 2; ++k) dst[n][k] = *(const LAS bf16x8*)(lds + PG8_SB(b, h) + boff + n * 2048 + k * 1024); } while (0)
#define PG8_MMA(ai, bj, At, Bt) do { __builtin_amdgcn_s_setprio(1); _Pragma("unroll") for (int m = 0; m < 4; ++m) _Pragma("unroll") for (int n = 0; n < 2; ++n) _Pragma("unroll") for (int k = 0; k < 2; ++k) \
        acc[ai][bj][m][n] = __builtin_amdgcn_mfma_f32_16x16x32_bf16(Bt[n][k], At[m][k], acc[ai][bj][m][n], 0, 0, 0); __builtin_amdgcn_s_setprio(0); } while (0)
#define PG8_WAIT_V(n) asm volatile("s_waitcnt vmcnt(" #n ")" ::: "memory")
#define PG8_WAIT_L(n) asm volatile("s_waitcnt lgkmcnt(" #n ")" ::: "memory")
#define PG8_BAR __builtin_amdgcn_s_barrier()
#define PG8_SCHED __builtin_amdgcn_sched_barrier(0)
    Unit cur, nxt; int ui = 0;
    if (!S.next(0, cur)) return;
    f32x4 acc[2][2][4][2];
#pragma unroll
    for (int a = 0; a < 2; ++a)
#pragma unroll
        for (int b = 0; b < 2; ++b)
#pragma unroll
            for (int m = 0; m < 4; ++m)
#pragma unroll
                for (int n = 0; n < 2; ++n) acc[a][b][m][n] = (f32x4){0.f, 0.f, 0.f, 0.f};
    bf16x8 At[4][2], B0[2][2], B1[2][2];
    const char* cA = GATHER ? (const char*)g.A : (const char*)g.A + (size_t)cur.pm * tstep;
    const char* cB = (const char*)g.Bt + (size_t)cur.e * g.bstride + (size_t)cur.pn * tstep;
    S.a_ready(cur);
    if constexpr (GATHER) { S.load_goff(cur, goff, RA, CA); }
    PG8_STAGE(PG8_SB(0, 0), cB, voffB); PG8_STAGE(PG8_SB(0, 1), cB + hstep, voffB); PG8_STAGE_A(PG8_SA(0, 0), cA, 0, 0); PG8_STAGE_A(PG8_SA(0, 1), cA, 0, 1);
    if (wr == 1) PG8_BAR;
    PG8_WAIT_V(2); PG8_BAR;
    PG8_STAGE(PG8_SB(1, 0), cB + kstep, voffB); PG8_STAGE_A(PG8_SA(1, 0), cA, kstep, 0); PG8_STAGE(PG8_SB(1, 1), cB + hstep + kstep, voffB);
    PG8_WAIT_V(6); PG8_BAR;
    for (;;) {
        const bool has_next = S.next(ui + 1, nxt);
        const char* nA = GATHER ? cA : (has_next ? (const char*)g.A + (size_t)nxt.pm * tstep : cA);
        const char* nB = has_next ? (const char*)g.Bt + (size_t)nxt.e * g.bstride + (size_t)nxt.pn * tstep : cB;
        for (int t = 0; t < nt; t += 2) {
            const bool last = (t == nt - 2);
            const size_t kb1 = (size_t)(t + 1) * kstep;
            const char* a2 = last ? nA : cA; const size_t kb2 = last ? 0 : (size_t)(t + 2) * kstep; const char* b2 = last ? nB : cB + (size_t)(t + 2) * kstep;
            const size_t kb3 = kb2 + kstep; const char* b3 = b2 + kstep;
            if (last && has_next) S.a_ready(nxt);
            PG8_LDB(B0, 0, 0); PG8_LDB(B1, 0, 1); PG8_SCHED; PG8_LDA(At, 0, 0); PG8_STAGE_A(PG8_SA(1, 1), cA, kb1, 1);
            PG8_WAIT_V(8); PG8_WAIT_L(0); PG8_BAR; PG8_MMA(0, 0, At, B0); PG8_MMA(0, 1, At, B1); PG8_BAR; PG8_SCHED;
            if constexpr (GATHER) { if (last && has_next) S.load_goff(nxt, goff, RA, CA); }
            PG8_LDA(At, 0, 1); PG8_STAGE(PG8_SB(0, 0), b2, voffB); PG8_STAGE(PG8_SB(0, 1), b2 + hstep, voffB); PG8_STAGE_A(PG8_SA(0, 0), a2, kb2, 0);
            PG8_WAIT_V(8); PG8_WAIT_L(0); PG8_BAR; PG8_MMA(1, 0, At, B0); PG8_MMA(1, 1, At, B1); PG8_BAR; PG8_SCHED;
            PG8_LDB(B0, 1, 0); PG8_LDB(B1, 1, 1); PG8_SCHED; PG8_LDA(At, 1, 0); PG8_STAGE_A(PG8_SA(0, 1), a2, kb2, 1);
            PG8_WAIT_V(8); PG8_WAIT_L(0); PG8_BAR; PG8_MMA(0, 0, At, B0); PG8_MMA(0, 1, At, B1); PG8_BAR; PG8_SCHED;
            PG8_LDA(At, 1, 1); PG8_STAGE(PG8_SB(1, 0), b3, voffB); PG8_STAGE(PG8_SB(1, 1), b3 + hstep, voffB); PG8_STAGE_A(PG8_SA(1, 0), a2, kb3, 0);
            PG8_WAIT_V(8); PG8_WAIT_L(0); PG8_BAR; PG8_MMA(1, 0, At, B0); PG8_MMA(1, 1, At, B1); PG8_BAR; PG8_SCHED;
        }
        if constexpr (ALIGN_EPI) { if (wr == 0) PG8_BAR; }
        E(acc, cur, wr, wc, fr, fq); S.done(cur);
        if (!has_next) break;
#pragma unroll
        for (int a = 0; a < 2; ++a)
#pragma unroll
            for (int b = 0; b < 2; ++b)
#pragma unroll
                for (int m = 0; m < 4; ++m)
#pragma unroll
                    for (int n = 0; n < 2; ++n) acc[a][b][m][n] = (f32x4){0.f, 0.f, 0.f, 0.f};
        cur = nxt; cA = nA; cB = nB; ++ui;
        if constexpr (ALIGN_EPI) { if (wr == 1) PG8_BAR; }
    }
    PG8_WAIT_V(0);
    if constexpr (!ALIGN_EPI) { if (wr == 0) PG8_BAR; }
    PG8_BAR;
#undef PG8_SA
#undef PG8_SB
#undef PG8_STAGE
#undef PG8_STAGE_A
#undef PG8_LDA
#undef PG8_LDB
#undef PG8_MMA
#undef PG8_WAIT_V
#undef PG8_WAIT_L
#undef PG8_BAR
#undef PG8_SCHED
}
}

struct EpiProj {
    static constexpr bool PERM = true;
    bf16_t* O; float* dtraw;
    __device__ __forceinline__ void operator()(const f32x4 (&acc)[2][2][4][2], const pg8::Unit& u, int wr, int wc, int fr, int fq) const {
        const int row0 = u.pm * 256 + wr * 64 + fr, col0 = u.pn * 256 + wc * 32 + 8 * fq;
#pragma unroll
        for (int ai = 0; ai < 2; ++ai)
#pragma unroll
            for (int m = 0; m < 4; ++m) { bf16_t* rowp = O + (size_t)(row0 + ai * 128 + m * 16) * NPROJ_PAD + col0;
#pragma unroll
                for (int bj = 0; bj < 2; ++bj) { const f32x4 v0 = acc[ai][bj][m][0], v1 = acc[ai][bj][m][1];
                    u32x4 w; w.x = pk2(v0[0], v0[1]); w.y = pk2(v0[2], v0[3]); w.z = pk2(v1[0], v1[1]); w.w = pk2(v1[2], v1[3]);
                    *(u32x4*)(rowp + bj * 128) = w; } }
        if (u.pn == 22 && wc == 0) {
#pragma unroll
            for (int ai = 0; ai < 2; ++ai)
#pragma unroll
                for (int m = 0; m < 4; ++m) { float* p = dtraw + (size_t)(row0 + ai * 128 + m * 16) * 32 + 8 * fq;
                    *(f32x4*)p = acc[ai][0][m][0]; *(f32x4*)(p + 4) = acc[ai][0][m][1]; }
        }
    }
};
struct EpiOut {
    static constexpr bool PERM = false;
    const float* x; const float* mod; float* x1;
    __device__ __forceinline__ void operator()(const f32x4 (&acc)[2][2][4][2], const pg8::Unit& u, int wr, int wc, int fr, int fq) const {
        const int row0 = u.pm * 256 + wr * 64 + fr, col0 = u.pn * 256 + wc * 32 + 4 * fq;
        const float* gp = mod + (size_t)(u.pm >= 32 ? 1 : 0) * 12288 + 2 * D + col0;
        f32x4 gv[2][2];
#pragma unroll
        for (int bj = 0; bj < 2; ++bj)
#pragma unroll
            for (int n = 0; n < 2; ++n) gv[bj][n] = *(const f32x4*)(gp + bj * 128 + n * 16);
#pragma unroll
        for (int ai = 0; ai < 2; ++ai)
#pragma unroll
            for (int m = 0; m < 4; ++m) { const size_t off = (size_t)(row0 + ai * 128 + m * 16) * D + col0;
#pragma unroll
                for (int bj = 0; bj < 2; ++bj)
#pragma unroll
                    for (int n = 0; n < 2; ++n) { const f32x4 xv = *(const f32x4*)(x + off + bj * 128 + n * 16);
                        *(f32x4*)(x1 + off + bj * 128 + n * 16) = xv + gv[bj][n] * acc[ai][bj][m][n]; } }
    }
};
struct EpiGU {
    static constexpr bool PERM = true;
    bf16_t* H;
    __device__ __forceinline__ void operator()(const f32x4 (&acc)[2][2][4][2], const pg8::Unit& u, int wr, int wc, int fr, int fq) const {
        const int row0 = u.pm * 256 + wr * 64 + fr, col0 = u.pn * 128 + wc * 16 + 4 * fq;
#pragma unroll
        for (int ai = 0; ai < 2; ++ai)
#pragma unroll
            for (int m = 0; m < 4; ++m) { bf16_t* rowp = H + (size_t)(row0 + ai * 128 + m * 16) * EH + col0;
#pragma unroll
                for (int bj = 0; bj < 2; ++bj) { const f32x4 gt = acc[ai][bj][m][0], up = acc[ai][bj][m][1];
                    u32x2 w; w.x = pk2(silu_f(gt[0]) * up[0], silu_f(gt[1]) * up[1]); w.y = pk2(silu_f(gt[2]) * up[2], silu_f(gt[3]) * up[3]);
                    *(u32x2*)(rowp + bj * 64) = w; } }
    }
};
struct EpiDown {
    static constexpr bool PERM = true;
    bf16_t* Y; const LAS int* tab;
    __device__ __forceinline__ void operator()(const f32x4 (&acc)[2][2][4][2], const pg8::Unit& u, int wr, int wc, int fr, int fq) const {
        const int col0 = u.pn * 256 + wc * 32 + 8 * fq;
        const LAS int* tb = tab + u.li * 512;
#pragma unroll
        for (int ai = 0; ai < 2; ++ai)
#pragma unroll
            for (int m = 0; m < 4; ++m) { const int r = ai * 128 + wr * 64 + m * 16 + fr; const int a = tb[2 * r]; const float gt = __int_as_float(tb[2 * r + 1]);
                if (a >= 0) { bf16_t* rowp = Y + (size_t)a * D + col0;
#pragma unroll
                    for (int bj = 0; bj < 2; ++bj) { const f32x4 v0 = acc[ai][bj][m][0] * gt, v1 = acc[ai][bj][m][1] * gt;
                        u32x4 w; w.x = pk2(v0[0], v0[1]); w.y = pk2(v0[2], v0[3]); w.z = pk2(v1[0], v1[1]); w.w = pk2(v1[2], v1[3]);
                        *(u32x4*)(rowp + bj * 128) = w; } } }
    }
};
struct MoeOrder {
    const LAS int* tilebase; int ntiles, npn, G, c; const LAS unsigned* goff_tab;
    __device__ __forceinline__ bool next(int i, pg8::Unit& u) const {
        const long L = (long)i * G + c; if (L >= (long)ntiles * npn) return false;
        const int tau = (int)(L / npn); u.pn = (int)(L % npn); u.pm = tau; u.li = i;
        int e = 0;
        for (int j = 1; j < NEXP; ++j) e += (tilebase[j] <= tau) ? 1 : 0;
        u.e = e; return true;
    }
    __device__ __forceinline__ void a_ready(const pg8::Unit&) const {}
    __device__ __forceinline__ void done(const pg8::Unit&) const {}
    __device__ __forceinline__ void load_goff(const pg8::Unit& u, unsigned (&goff)[2][2], const int (&RA)[2], const int (&CA)[2]) const {
        const LAS unsigned* tb = goff_tab + u.li * 256;
#pragma unroll
        for (int h = 0; h < 2; ++h)
#pragma unroll
            for (int i = 0; i < 2; ++i) goff[h][i] = tb[h * 128 + RA[i]] + (unsigned)CA[i] * 2u;
    }
};

struct Args { const void* in[24]; float* out; unsigned char* ws; int ph_lo, ph_hi; };
enum InIdx { I_X = 0, I_C, I_POS, I_WADA, I_BADA, I_N1G, I_WIN, I_CONVW, I_CONVB, I_DTBIAS, I_ALOG, I_DSKIP, I_SSDG, I_QG, I_KG, I_WOUT, I_N2G, I_WRG, I_BRG, I_WRE, I_BRE, I_WG, I_WU, I_WD };

__device__ __forceinline__ float wave_sum(float v) {
#pragma unroll
    for (int o = 1; o < 64; o <<= 1) v += __shfl_xor(v, o);
    return v;
}

__device__ __forceinline__ void p0_adaln(const float* c, const float* w_ada, const float* b_ada, float* mod, LAS float* lds) {
    const int tid = threadIdx.x;
    LAS float* sc = lds; LAS float* red = lds + 4096;
    for (int i = tid; i < 2 * D; i += 512) sc[i] = silu_f(c[i]);
    __syncthreads();
    for (int cg = blockIdx.x; cg < 256; cg += gridDim.x) {
        if (tid < 504) {
            const int c4 = tid % 12, r0 = tid / 12;
            f32x4 a0 = {0.f, 0.f, 0.f, 0.f}, a1 = {0.f, 0.f, 0.f, 0.f};
            const float* wp = w_ada + 48 * cg + 4 * c4;
#pragma unroll 7
            for (int k = r0; k < D; k += 42) { const f32x4 w = *(const f32x4*)(wp + (size_t)k * 12288); a0 += w * sc[k]; a1 += w * sc[D + k]; }
            LAS float* rp = red + (r0 * 12 + c4) * 8;
            rp[0] = a0[0]; rp[1] = a0[1]; rp[2] = a0[2]; rp[3] = a0[3]; rp[4] = a1[0]; rp[5] = a1[1]; rp[6] = a1[2]; rp[7] = a1[3];
        }
        __syncthreads();
        if (tid < 96) {
            const int c4 = tid >> 3, j = tid & 7; float s = 0.f;
            for (int r = 0; r < 42; ++r) s += red[(r * 12 + c4) * 8 + j];
            const int col = 48 * cg + 4 * c4 + (j & 3);
            mod[(j >> 2) * 12288 + col] = s + b_ada[col];
        }
        __syncthreads();
    }
}
template <class RowMap>
__device__ __forceinline__ void transpose_item(const float* W, int ldw, int nvalid, bf16_t* WT, int ldt, int k0, int n0, LAS float* scr, int lane, RowMap rm) {
#pragma unroll 4
    for (int it = 0; it < 16; ++it) {
        const int kk = 4 * it + (lane >> 4), n = n0 + 4 * (lane & 15);
        f32x4 v = {0.f, 0.f, 0.f, 0.f};
        if (n < nvalid) v = *(const f32x4*)(W + (size_t)(k0 + kk) * ldw + n);
        LAS float* s = scr + kk * 65 + 4 * (lane & 15);
        s[0] = v[0]; s[1] = v[1]; s[2] = v[2]; s[3] = v[3];
    }
    LDS_WAIT(); asm volatile("" ::: "memory");
    const int c = lane & 7;
#pragma unroll
    for (int j = 0; j < 8; ++j) {
        const int nn = (lane >> 3) + 8 * j, n = n0 + nn;
        const LAS float* s = scr + (8 * c) * 65 + nn;
        u32x4 o; o.x = pk2(s[0], s[65]); o.y = pk2(s[2 * 65], s[3 * 65]); o.z = pk2(s[4 * 65], s[5 * 65]); o.w = pk2(s[6 * 65], s[7 * 65]);
        if (n < nvalid) *(u32x4*)(WT + (size_t)rm(n) * ldt + k0 + 8 * c) = o;
    }
    LDS_WAIT(); asm volatile("" ::: "memory");
}
struct RmId { __device__ __forceinline__ int operator()(int n) const { return n; } };
struct RmGU { int add; __device__ __forceinline__ int operator()(int n) const { return 8 * (n >> 2) + add + (n & 3); } };

__device__ __forceinline__ void p0_prologue(const Args& A, LAS unsigned char* lds) {
    const int tid = threadIdx.x, lane = tid & 63, wave = tid >> 6;
    unsigned char* ws = A.ws;
    p0_adaln((const float*)A.in[I_C], (const float*)A.in[I_WADA], (const float*)A.in[I_BADA], (float*)(ws + WS_MOD), (LAS float*)lds);
    const int gtid = blockIdx.x * 512 + tid, NT = gridDim.x * 512;
    { const int* pos = (const int*)A.in[I_POS]; float* rope = (float*)(ws + WS_ROPE);
      for (int i = gtid; i < T * 32; i += NT) { const int t = i >> 5, f = i & 31;
          const float invf = powf(10000.0f, -(float)f / 32.0f); const float ang = (float)pos[t] * invf;
          const double rev = (double)ang * 0.15915494309189533577; const float fr = (float)(rev - rint(rev));
          rope[2 * i] = __builtin_amdgcn_cosf(fr); rope[2 * i + 1] = __builtin_amdgcn_sinf(fr); } }
    { const float* wrg = (const float*)A.in[I_WRG]; const float* wre = (const float*)A.in[I_WRE]; bf16_t* hi = (bf16_t*)(ws + WS_WRT); bf16_t* lo = hi + NRT * D;
      for (int i = gtid; i < NRT * D; i += NT) { const int n = i / D, k = i % D; float w = 0.f;
          if (n < 8) w = wrg[k * 8 + n]; else if (n >= 16) w = wre[k * 64 + (n - 16)];
          const unsigned h = f2bf(w); hi[i] = (bf16_t)h; lo[i] = (bf16_t)f2bf(w - bf2f(h)); } }
    { u32x4* z = (u32x4*)(ws + WS_WINT + (size_t)NPROJ * D * 2); const int n16 = (NPROJ_PAD - NPROJ) * D * 2 / 16;
      for (int i = gtid; i < n16; i += NT) z[i] = (u32x4){0u, 0u, 0u, 0u}; }
    __syncthreads();
    LAS float* scr = (LAS float*)(lds) + wave * (64 * 65);
    const int gw = blockIdx.x * 8 + wave, NGW = gridDim.x * 8;
    constexpr int I_IN = 32 * 89, I_OUT = 32 * 32, I_E = 32 * 8, I_DN = 8 * 32;
    constexpr int NITEMS = I_IN + I_OUT + NEXP * (2 * I_E + I_DN);
    for (int it = gw; it < NITEMS; it += NGW) {
        int r = it;
        if (r < I_IN) { transpose_item((const float*)A.in[I_WIN], NPROJ, NPROJ, (bf16_t*)(ws + WS_WINT), D, 64 * (r / 89), 64 * (r % 89), scr, lane, RmId{}); continue; } r -= I_IN;
        if (r < I_OUT) { transpose_item((const float*)A.in[I_WOUT], D, D, (bf16_t*)(ws + WS_WOUTT), D, 64 * (r / 32), 64 * (r % 32), scr, lane, RmId{}); continue; } r -= I_OUT;
        const int e = r / (2 * I_E + I_DN); r -= e * (2 * I_E + I_DN);
        if (r < I_E) { transpose_item((const float*)A.in[I_WG] + (size_t)e * D * EH, EH, EH, (bf16_t*)(ws + WS_WGUT) + (size_t)e * 1024 * D, D, 64 * (r / 8), 64 * (r % 8), scr, lane, RmGU{0}); continue; } r -= I_E;
        if (r < I_E) { transpose_item((const float*)A.in[I_WU] + (size_t)e * D * EH, EH, EH, (bf16_t*)(ws + WS_WGUT) + (size_t)e * 1024 * D, D, 64 * (r / 8), 64 * (r % 8), scr, lane, RmGU{4}); continue; } r -= I_E;
        transpose_item((const float*)A.in[I_WD] + (size_t)e * EH * D, D, D, (bf16_t*)(ws + WS_WDT) + (size_t)e * D * EH, EH, 64 * (r / 32), 64 * (r % 32), scr, lane, RmId{});
    }
}

__device__ __forceinline__ void p1_norm1(const Args& A) {
    const int tid = threadIdx.x, lane = tid & 63, wave = tid >> 6;
    const float* x = (const float*)A.in[I_X]; const float* g1 = (const float*)A.in[I_N1G]; const float* mod = (const float*)(A.ws + WS_MOD);
    bf16_t* hb = (bf16_t*)(A.ws + WS_HB);
    const int gw = blockIdx.x * 8 + wave, NGW = gridDim.x * 8;
    for (int m = gw; m < T; m += NGW) {
        const f32x4* xr = (const f32x4*)(x + (size_t)m * D) + lane;
        f32x4 v[8]; float s = 0.f;
#pragma unroll
        for (int j = 0; j < 8; ++j) { v[j] = xr[64 * j]; s += (v[j][0] * v[j][0] + v[j][1] * v[j][1]) + (v[j][2] * v[j][2] + v[j][3] * v[j][3]); }
        const float rstd = rsqrtf(wave_sum(s) * (1.f / D) + RMS_EPS);
        const float* mb = mod + (m >= SEQ ? 12288 : 0);
        u32x2* o = (u32x2*)(hb + (size_t)m * D) + lane;
#pragma unroll
        for (int j = 0; j < 8; ++j) { const int col = 4 * lane + 256 * j;
            const f32x4 g = *(const f32x4*)(g1 + col), sh = *(const f32x4*)(mb + col), sc = *(const f32x4*)(mb + D + col);
            const f32x4 h = (v[j] * rstd) * g * (sc + 1.f) + sh;
            u32x2 w; w.x = pk2(h[0], h[1]); w.y = pk2(h[2], h[3]); o[64 * j] = w; }
    }
}

__device__ __forceinline__ void p3_post(const Args& A) {
    const int tid = threadIdx.x, lane = tid & 63, wave = tid >> 6;
    unsigned char* ws = A.ws;
    bf16_t* proj = (bf16_t*)(ws + WS_PROJ);
    const int gw = blockIdx.x * 8 + wave, NGW = gridDim.x * 8;
    { const float* qg = (const float*)A.in[I_QG]; const float* kg = (const float*)A.in[I_KG]; const float* rope = (const float*)(ws + WS_ROPE);
      const int isk = lane >> 5, head = (lane >> 1) & 15, half = lane & 1;
      const float* gn = (isk ? kg : qg) + 32 * half;
      for (int t = gw; t < T; t += NGW) {
          bf16_t* p = proj + (size_t)t * NPROJ_PAD + (isk ? OFF_K : OFF_Q) + 64 * head + 32 * half;
          float v[32]; float ss = 0.f;
#pragma unroll
          for (int i = 0; i < 4; ++i) { const u32x4 w = *(const u32x4*)(p + 8 * i);
              v[8 * i + 0] = lo_f(w.x); v[8 * i + 1] = hi_f(w.x); v[8 * i + 2] = lo_f(w.y); v[8 * i + 3] = hi_f(w.y);
              v[8 * i + 4] = lo_f(w.z); v[8 * i + 5] = hi_f(w.z); v[8 * i + 6] = lo_f(w.w); v[8 * i + 7] = hi_f(w.w); }
#pragma unroll
          for (int i = 0; i < 32; ++i) ss += v[i] * v[i];
          ss += __shfl_xor(ss, 1);
          const float rstd = rsqrtf(ss * (1.f / 64.f) + RMS_EPS);
          const float sc = isk ? 1.f : 0.125f;
          const float* rp = rope + (size_t)t * 64;
          unsigned ow[16];
#pragma unroll
          for (int i = 0; i < 32; i += 2) {
              float o2[2];
#pragma unroll
              for (int j = 0; j < 2; ++j) { const float mine = v[i + j] * rstd * gn[i + j]; const float other = __shfl_xor(mine, 1);
                  const float cs = rp[2 * (i + j)], sn = rp[2 * (i + j) + 1];
                  o2[j] = (half ? (other * sn + mine * cs) : (mine * cs - other * sn)) * sc; }
              ow[i >> 1] = pk2(o2[0], o2[1]); }
#pragma unroll
          for (int i = 0; i < 4; ++i) { u32x4 w; w.x = ow[4 * i]; w.y = ow[4 * i + 1]; w.z = ow[4 * i + 2]; w.w = ow[4 * i + 3]; *(u32x4*)(p + 8 * i) = w; }
      } }
    { const float* cw = (const float*)A.in[I_CONVW]; const float* cb = (const float*)A.in[I_CONVB]; bf16_t* xc = (bf16_t*)(ws + WS_HB);
      const int gtid = blockIdx.x * 512 + tid, NT = gridDim.x * 512;
      for (int i = gtid; i < T * (XBCW / 8); i += NT) {
          const int t = i / (XBCW / 8), c8 = (i % (XBCW / 8)) * 8, s = t & (SEQ - 1);
          float acc[8];
#pragma unroll
          for (int j = 0; j < 8; ++j) acc[j] = cb[c8 + j];
#pragma unroll
          for (int k = 0; k < 5; ++k) { const int ss = s + k - 2;
              if (ss >= 0 && ss < SEQ) { const u32x4 w = *(const u32x4*)(proj + (size_t)(t + k - 2) * NPROJ_PAD + OFF_XBC + c8);
                  const f32x4 w0 = *(const f32x4*)(cw + k * XBCW + c8), w1 = *(const f32x4*)(cw + k * XBCW + c8 + 4);
                  acc[0] += lo_f(w.x) * w0[0]; acc[1] += hi_f(w.x) * w0[1]; acc[2] += lo_f(w.y) * w0[2]; acc[3] += hi_f(w.y) * w0[3];
                  acc[4] += lo_f(w.z) * w1[0]; acc[5] += hi_f(w.z) * w1[1]; acc[6] += lo_f(w.w) * w1[2]; acc[7] += hi_f(w.w) * w1[3]; } }
          u32x4 o; o.x = pk2(silu_f(acc[0]), silu_f(acc[1])); o.y = pk2(silu_f(acc[2]), silu_f(acc[3])); o.z = pk2(silu_f(acc[4]), silu_f(acc[5])); o.w = pk2(silu_f(acc[6]), silu_f(acc[7]));
          *(u32x4*)(xc + (size_t)t * XBCW + c8) = o; } }
    { const float* dtraw = (const float*)(ws + WS_DTRAW); const float* dtbias = (const float*)A.in[I_DTBIAS]; const float* alog = (const float*)A.in[I_ALOG];
      float* dtf = (float*)(ws + WS_DTF); float* dtb = (float*)(ws + WS_DTB); float* acs = (float*)(ws + WS_ACS); float* rcs = (float*)(ws + WS_RCS); float* dec = (float*)(ws + WS_DEC);
      const int gtid = blockIdx.x * 512 + tid, NT = gridDim.x * 512;
      for (int i = gtid; i < BATCH * NCHUNK * 32; i += NT) {
          const int h = i & 15, dir = (i >> 4) & 1, bc = i >> 5; const int t0 = bc * CHUNK;
          const float aneg = -__expf(alog[dir * 16 + h]), bias = dtbias[dir * 16 + h];
          float run = 0.f;
          if (dir == 0) { for (int l = 0; l < CHUNK; ++l) { const float r = dtraw[(size_t)(t0 + l) * 32 + h] + bias; const float d = r > 20.f ? r : log1pf(__expf(r));
                  run += d * aneg; dtf[(size_t)(t0 + l) * 16 + h] = d; acs[(size_t)(t0 + l) * 16 + h] = run; } }
          else { for (int l = CHUNK - 1; l >= 0; --l) { const float r = dtraw[(size_t)(t0 + l) * 32 + 16 + h] + bias; const float d = r > 20.f ? r : log1pf(__expf(r));
                  run += d * aneg; dtb[(size_t)(t0 + l) * 16 + h] = d; rcs[(size_t)(t0 + l) * 16 + h] = run; } }
          dec[i] = __expf(run);
      } }
}

__device__ __forceinline__ bf16x8 mk_frag(u32x4 w) { return __builtin_bit_cast(bf16x8, w); }
__device__ __forceinline__ f32x4 mfma16(bf16x8 a, bf16x8 b, f32x4 c) { return __builtin_amdgcn_mfma_f32_16x16x32_bf16(a, b, c, 0, 0, 0); }

constexpr int SP = 136;
__device__ __forceinline__ void p4_ssd_local(const Args& A, LAS unsigned char* lds) {
    const int tid = threadIdx.x, lane = tid & 63, w = __builtin_amdgcn_readfirstlane(tid >> 6), fr = lane & 15, fq = lane >> 4;
    unsigned char* ws = A.ws;
    const bf16_t* xc = (const bf16_t*)(ws + WS_HB);
    const float* DTF = (const float*)(ws + WS_DTF); const float* DTB = (const float*)(ws + WS_DTB); const float* ACS = (const float*)(ws + WS_ACS); const float* RCS = (const float*)(ws + WS_RCS);
    float* YD = (float*)(ws + WS_YD); float* ST = (float*)(ws + WS_ST);
    LAS bf16_t* Cs = (LAS bf16_t*)lds; LAS bf16_t* Bs = (LAS bf16_t*)(lds + 34816); LAS bf16_t* BT = (LAS bf16_t*)(lds + 69632);
    LAS float* VEC = (LAS float*)(lds + 104448);
    LAS bf16_t* XT = Bs;
    for (int u = blockIdx.x; u < BATCH * NCHUNK * 2; u += gridDim.x) {
        const int b = u >> 7, c = (u >> 1) & 63, g = u & 1; const int t0 = b * SEQ + c * CHUNK;
        { const int l = tid >> 2, q = tid & 3; const bf16_t* src = xc + (size_t)(t0 + l) * XBCW + 1024 + 128 * g + 32 * q;
#pragma unroll
          for (int i = 0; i < 4; ++i) { const u32x4 vb = *(const u32x4*)(src + 8 * i), vc = *(const u32x4*)(src + 256 + 8 * i);
              *(LAS u32x4*)(Bs + l * SP + 32 * q + 8 * i) = vb; *(LAS u32x4*)(Cs + l * SP + 32 * q + 8 * i) = vc;
              const unsigned ww[4] = {vb.x, vb.y, vb.z, vb.w};
#pragma unroll
              for (int j = 0; j < 4; ++j) { BT[(32 * q + 8 * i + 2 * j) * SP + l] = (bf16_t)(ww[j] & 0xffffu); BT[(32 * q + 8 * i + 2 * j + 1) * SP + l] = (bf16_t)(ww[j] >> 16); } } }
        __syncthreads();
        { bf16x8 af[4];
#pragma unroll
          for (int ks = 0; ks < 4; ++ks) af[ks] = *(const LAS bf16x8*)(Cs + (16 * w + fr) * SP + 32 * ks + 8 * fq);
          f32x4 cbv[8];
#pragma unroll
          for (int st = 0; st < 8; ++st) { f32x4 acc = {0.f, 0.f, 0.f, 0.f};
#pragma unroll
              for (int ks = 0; ks < 4; ++ks) acc = mfma16(af[ks], *(const LAS bf16x8*)(Bs + (16 * st + fr) * SP + 32 * ks + 8 * fq), acc);
              cbv[st] = acc; }
#pragma unroll
          for (int st = 0; st < 8; ++st)
#pragma unroll
              for (int r = 0; r < 4; ++r) Cs[(16 * w + 4 * fq + r) * SP + 16 * st + fr] = (bf16_t)f2bf(cbv[st][r]); }
        __syncthreads();
        bf16x8 btf[4];
#pragma unroll
        for (int ks = 0; ks < 4; ++ks) btf[ks] = *(const LAS bf16x8*)(BT + (16 * w + fr) * SP + 32 * ks + 8 * fq);
        for (int hh = 0; hh < 8; ++hh) {
            const int h = 8 * g + hh;
            { const int l = tid >> 2, q = tid & 3; const bf16_t* src = xc + (size_t)(t0 + l) * XBCW + 64 * h + 16 * q;
#pragma unroll
              for (int i = 0; i < 2; ++i) { const u32x4 v = *(const u32x4*)(src + 8 * i); const unsigned ww[4] = {v.x, v.y, v.z, v.w};
#pragma unroll
                  for (int j = 0; j < 4; ++j) { XT[(16 * q + 8 * i + 2 * j) * SP + l] = (bf16_t)(ww[j] & 0xffffu); XT[(16 * q + 8 * i + 2 * j + 1) * SP + l] = (bf16_t)(ww[j] >> 16); } } }
            if (tid < 128) { const int l = tid; const size_t o = (size_t)(t0 + l) * 16 + h;
                const float df = DTF[o], db = DTB[o], ac = ACS[o], rc = RCS[o];
                const float acl = ACS[(size_t)(t0 + 127) * 16 + h], rcf = RCS[(size_t)t0 * 16 + h];
                VEC[l] = df; VEC[128 + l] = db; VEC[256 + l] = ac; VEC[384 + l] = rc; VEC[512 + l] = __expf(acl - ac) * df; VEC[640 + l] = __expf(rcf - rc) * db; }
            __syncthreads();
            { const int l = 16 * w + fr; const float ac_l = VEC[256 + l], rc_l = VEC[384 + l];
              f32x4 acc[4];
#pragma unroll
              for (int pt = 0; pt < 4; ++pt) acc[pt] = (f32x4){0.f, 0.f, 0.f, 0.f};
#pragma unroll
              for (int ks = 0; ks < 4; ++ks) { const int s0 = 32 * ks + 8 * fq;
                  const u32x4 cb = *(const LAS u32x4*)(Cs + l * SP + s0); const unsigned cw[4] = {cb.x, cb.y, cb.z, cb.w};
                  float mv[8];
#pragma unroll
                  for (int j = 0; j < 8; ++j) { const int s = s0 + j; const float cbj = (j & 1) ? hi_f(cw[j >> 1]) : lo_f(cw[j >> 1]);
                      const float df = VEC[s], db = VEC[128 + s], ac = VEC[256 + s], rc = VEC[384 + s];
                      const float arg = (s < l) ? (ac_l - ac) : (rc_l - rc);
                      const float wg = (s < l) ? df : ((s > l) ? db : df + db);
                      mv[j] = cbj * __expf(arg) * wg; }
                  u32x4 mw; mw.x = pk2(mv[0], mv[1]); mw.y = pk2(mv[2], mv[3]); mw.z = pk2(mv[4], mv[5]); mw.w = pk2(mv[6], mv[7]);
                  const bf16x8 afr = mk_frag(mw);
#pragma unroll
                  for (int pt = 0; pt < 4; ++pt) acc[pt] = mfma16(afr, *(const LAS bf16x8*)(XT + (16 * pt + fr) * SP + s0), acc[pt]); }
#pragma unroll
              for (int pt = 0; pt < 4; ++pt)
#pragma unroll
                  for (int r = 0; r < 4; ++r) YD[(size_t)(t0 + 16 * w + 4 * fq + r) * 1024 + 64 * h + 16 * pt + fr] = acc[pt][r]; }
#pragma unroll
            for (int dir = 0; dir < 2; ++dir) {
                float* stp = ST + ((size_t)(((b * NCHUNK + c) * 2 + dir) * 16 + h)) * 8192;
#pragma unroll
                for (int pt = 0; pt < 4; ++pt) { f32x4 acc = {0.f, 0.f, 0.f, 0.f};
#pragma unroll
                    for (int ks = 0; ks < 4; ++ks) { const int s0 = 32 * ks + 8 * fq;
                        const u32x4 xv = *(const LAS u32x4*)(XT + (16 * pt + fr) * SP + s0); const unsigned xw[4] = {xv.x, xv.y, xv.z, xv.w};
                        const f32x4 w0 = *(const LAS f32x4*)(VEC + 512 + 128 * dir + s0), w1 = *(const LAS f32x4*)(VEC + 512 + 128 * dir + s0 + 4);
                        u32x4 aw; aw.x = pk2(lo_f(xw[0]) * w0[0], hi_f(xw[0]) * w0[1]); aw.y = pk2(lo_f(xw[1]) * w0[2], hi_f(xw[1]) * w0[3]);
                        aw.z = pk2(lo_f(xw[2]) * w1[0], hi_f(xw[2]) * w1[1]); aw.w = pk2(lo_f(xw[3]) * w1[2], hi_f(xw[3]) * w1[3]);
                        acc = mfma16(mk_frag(aw), btf[ks], acc); }
#pragma unroll
                    for (int r = 0; r < 4; ++r) stp[(16 * pt + 4 * fq + r) * 128 + 16 * w + fr] = acc[r]; }
            }
            __syncthreads();
        }
    }
}

__device__ __forceinline__ void p5_scan(const Args& A) {
    float* ST = (float*)(A.ws + WS_ST); const float* DEC = (const float*)(A.ws + WS_DEC);
    const int gtid = blockIdx.x * 512 + threadIdx.x, NT = gridDim.x * 512;
    for (int i = gtid; i < BATCH * 2 * 16 * 2048; i += NT) {
        const int e4 = i & 2047, h = (i >> 11) & 15, dir = (i >> 15) & 1, b = i >> 16;
        f32x4 st = {0.f, 0.f, 0.f, 0.f};
        for (int cc = 0; cc < NCHUNK; cc += 8) {
            f32x4 v[8]; float dc[8];
#pragma unroll
            for (int j = 0; j < 8; ++j) { const int c = dir ? (NCHUNK - 1 - (cc + j)) : (cc + j);
                v[j] = *(const f32x4*)(ST + ((size_t)(((b * NCHUNK + c) * 2 + dir) * 16 + h)) * 8192 + 4 * e4); dc[j] = DEC[(b * NCHUNK + c) * 32 + dir * 16 + h]; }
#pragma unroll
            for (int j = 0; j < 8; ++j) { const int c = dir ? (NCHUNK - 1 - (cc + j)) : (cc + j);
                *(f32x4*)(ST + ((size_t)(((b * NCHUNK + c) * 2 + dir) * 16 + h)) * 8192 + 4 * e4) = st; st = st * dc[j] + v[j]; }
        }
    }
}

constexpr int KP = 72, VP = 264;
__device__ __forceinline__ void p4_attn(const Args& A, LAS unsigned char* lds) {
    const int tid = threadIdx.x, lane = tid & 63, w = __builtin_amdgcn_readfirstlane(tid >> 6), fr = lane & 15, fq = lane >> 4;
    unsigned char* ws = A.ws;
    const bf16_t* proj = (const bf16_t*)(ws + WS_PROJ);
    bf16_t* AO = (bf16_t*)(ws + WS_AO); float* ML = (float*)(ws + WS_ML);
    LAS bf16_t* Ks = (LAS bf16_t*)lds; LAS bf16_t* VT = (LAS bf16_t*)(lds + 36864);
    for (int u = blockIdx.x; u < 3 * 2048; u += gridDim.x) {
        const int br = u >> 11, rem = u & 2047, b = rem >> 10, h = (rem >> 6) & 15, cb = rem & 63;
        const int d = 1 << (2 * br), cls = cb & (d - 1), blk = cb >> (2 * br), n = SEQ >> (2 * br);
        { const int j = tid >> 1, half = tid & 1; const int kj = 128 * blk - 64 + j; const bool valid = (kj >= 0 && kj < n);
          const bf16_t* src = proj + (size_t)(b * SEQ + cls + d * (valid ? kj : 0)) * NPROJ_PAD + 64 * h + 32 * half;
#pragma unroll
          for (int i = 0; i < 4; ++i) { u32x4 vk = {0u, 0u, 0u, 0u}, vv = {0u, 0u, 0u, 0u};
              if (valid) { vk = *(const u32x4*)(src + OFF_K + 8 * i); vv = *(const u32x4*)(src + OFF_V + 8 * i); }
              *(LAS u32x4*)(Ks + j * KP + 32 * half + 8 * i) = vk;
              const unsigned ww[4] = {vv.x, vv.y, vv.z, vv.w};
#pragma unroll
              for (int jj = 0; jj < 4; ++jj) { VT[(32 * half + 8 * i + 2 * jj) * VP + j] = (bf16_t)(ww[jj] & 0xffffu); VT[(32 * half + 8 * i + 2 * jj + 1) * VP + j] = (bf16_t)(ww[jj] >> 16); } } }
        __syncthreads();
        const int qi = 128 * blk + 16 * w + fr; const size_t tq = (size_t)b * SEQ + cls + (size_t)d * qi;
        bf16x8 qf[2];
#pragma unroll
        for (int ks = 0; ks < 2; ++ks) qf[ks] = *(const bf16x8*)(proj + tq * NPROJ_PAD + OFF_Q + 64 * h + 32 * ks + 8 * fq);
        f32x4 st[9]; float mx = -3.0e38f;
#pragma unroll
        for (int kt = 0; kt < 9; ++kt) { f32x4 acc = {0.f, 0.f, 0.f, 0.f};
#pragma unroll
            for (int ks = 0; ks < 2; ++ks) acc = mfma16(*(const LAS bf16x8*)(Ks + (16 * w + 16 * kt + fr) * KP + 32 * ks + 8 * fq), qf[ks], acc);
#pragma unroll
            for (int r = 0; r < 4; ++r) { const int off = 16 * kt + 4 * fq + r - 64 - fr; const int kj = qi + off;
                const bool ok = (off >= -64) && (off <= 64) && (kj >= 0) && (kj < n);
                acc[r] = ok ? acc[r] * LOG2E : -1.0e30f; mx = fmaxf(mx, acc[r]); }
            st[kt] = acc; }
        mx = fmaxf(mx, __shfl_xor(mx, 16)); mx = fmaxf(mx, __shfl_xor(mx, 32));
        float sum = 0.f;
#pragma unroll
        for (int kt = 0; kt < 9; ++kt)
#pragma unroll
            for (int r = 0; r < 4; ++r) { const float p = __builtin_amdgcn_exp2f(st[kt][r] - mx); st[kt][r] = p; sum += p; }
        sum += __shfl_xor(sum, 16); sum += __shfl_xor(sum, 32);
        bf16x8 pf[5];
#pragma unroll
        for (int k2 = 0; k2 < 5; ++k2) { u32x4 pw; pw.x = pk2(st[2 * k2][0], st[2 * k2][1]); pw.y = pk2(st[2 * k2][2], st[2 * k2][3]);
            if (k2 < 4) { pw.z = pk2(st[2 * k2 + 1][0], st[2 * k2 + 1][1]); pw.w = pk2(st[2 * k2 + 1][2], st[2 * k2 + 1][3]); } else { pw.z = 0u; pw.w = 0u; }
            pf[k2] = mk_frag(pw); }
        const float inv = 1.f / sum;
#pragma unroll
        for (int et = 0; et < 4; ++et) { f32x4 acc = {0.f, 0.f, 0.f, 0.f};
#pragma unroll
            for (int k2 = 0; k2 < 5; ++k2) { const LAS bf16_t* vp = VT + (16 * et + fr) * VP + 16 * w + 32 * k2 + 4 * fq;
                const u32x2 lo = *(const LAS u32x2*)vp; u32x2 hi = {0u, 0u}; if (k2 < 4) hi = *(const LAS u32x2*)(vp + 16);
                u32x4 vw; vw.x = lo.x; vw.y = lo.y; vw.z = hi.x; vw.w = hi.y;
                acc = mfma16(mk_frag(vw), pf[k2], acc); }
            u32x2 o; o.x = pk2(acc[0] * inv, acc[1] * inv); o.y = pk2(acc[2] * inv, acc[3] * inv);
            *(u32x2*)(AO + ((size_t)br * T + tq) * 1024 + 64 * h + 16 * et + 4 * fq) = o; }
        if (fq == 0) { f32x2 ml = {mx, sum}; *(f32x2*)(ML + (((size_t)br * T + tq) * 16 + h) * 2) = ml; }
        __syncthreads();
    }
}

__device__ __forceinline__ void p6_ssd_final(const Args& A, LAS unsigned char* lds) {
    const int tid = threadIdx.x, lane = tid & 63, w = __builtin_amdgcn_readfirstlane(tid >> 6), fr = lane & 15, fq = lane >> 4;
    unsigned char* ws = A.ws;
    const bf16_t* xc = (const bf16_t*)(ws + WS_HB); const bf16_t* proj = (const bf16_t*)(ws + WS_PROJ);
    const float* ACS = (const float*)(ws + WS_ACS); const float* RCS = (const float*)(ws + WS_RCS);
    const float* YD = (const float*)(ws + WS_YD); const float* ST = (const float*)(ws + WS_ST);
    const float* dskip = (const float*)A.in[I_DSKIP]; const float* sg = (const float*)A.in[I_SSDG];
    bf16_t* mix = (bf16_t*)(ws + WS_MIX);
    LAS bf16_t* Cs = (LAS bf16_t*)lds;
    LAS float* EF = (LAS float*)(lds + 34816);
    LAS float* RED = (LAS float*)(lds + 34816 + 8192);
    LAS float* YT = (LAS float*)(lds + 45056) + w * (32 * 68);
    const int prow = lane >> 1, pch = (lane & 1) * 32;
    for (int u = blockIdx.x; u < BATCH * NCHUNK * 2; u += gridDim.x) {
        const int b = u >> 7, c = (u >> 1) & 63, hf = u & 1; const int t0 = b * SEQ + c * CHUNK + 64 * hf;
        { const int row = tid >> 3, part = tid & 7, grp = part >> 2, q = part & 3; const bf16_t* src = xc + (size_t)(t0 + row) * XBCW + 1280 + 128 * grp + 32 * q;
#pragma unroll
          for (int i = 0; i < 4; ++i) *(LAS u32x4*)(Cs + grp * 64 * SP + row * SP + 32 * q + 8 * i) = *(const u32x4*)(src + 8 * i);
#pragma unroll
          for (int k = 0; k < 4; ++k) { const int idx = tid + 512 * k, dir = idx >> 10, hh = (idx >> 6) & 15, row2 = idx & 63;
              EF[idx] = __expf((dir ? RCS : ACS)[(size_t)(t0 + row2) * 16 + hh]); } }
        __syncthreads();
        const int grp = w >> 2;
        float ssr[2] = {0.f, 0.f};
#pragma unroll 1
        for (int hx = 0; hx < 2; ++hx) {
            const int h = 2 * w + hx;
            f32x4 y[4][4];
#pragma unroll
            for (int rt = 0; rt < 4; ++rt)
#pragma unroll
                for (int pt = 0; pt < 4; ++pt) y[rt][pt] = (f32x4){0.f, 0.f, 0.f, 0.f};
#pragma unroll 1
            for (int dk = 0; dk < 8; ++dk) {
                const int dir = dk >> 2, ks = dk & 3;
                const float* stp = ST + ((size_t)(((b * NCHUNK + c) * 2 + dir) * 16 + h)) * 8192 + 32 * ks + 8 * fq;
                bf16x8 hfr[4];
#pragma unroll
                for (int pt = 0; pt < 4; ++pt) { const float* p = stp + (16 * pt + fr) * 128; const f32x4 a = *(const f32x4*)p, bb = *(const f32x4*)(p + 4);
                    u32x4 hw; hw.x = pk2(a[0], a[1]); hw.y = pk2(a[2], a[3]); hw.z = pk2(bb[0], bb[1]); hw.w = pk2(bb[2], bb[3]); hfr[pt] = mk_frag(hw); }
#pragma unroll
                for (int rt = 0; rt < 4; ++rt) {
                    const u32x4 cw = *(const LAS u32x4*)(Cs + grp * 64 * SP + (16 * rt + fr) * SP + 32 * ks + 8 * fq);
                    const float ev = EF[dir * 1024 + h * 64 + 16 * rt + fr];
                    u32x4 aw; aw.x = pk2(lo_f(cw.x) * ev, hi_f(cw.x) * ev); aw.y = pk2(lo_f(cw.y) * ev, hi_f(cw.y) * ev); aw.z = pk2(lo_f(cw.z) * ev, hi_f(cw.z) * ev); aw.w = pk2(lo_f(cw.w) * ev, hi_f(cw.w) * ev);
                    const bf16x8 af = mk_frag(aw);
#pragma unroll
                    for (int pt = 0; pt < 4; ++pt) y[rt][pt] = mfma16(af, hfr[pt], y[rt][pt]); }
            }
            const float dsk = dskip[h];
#pragma unroll
            for (int pass = 0; pass < 2; ++pass) {
#pragma unroll
                for (int rtl = 0; rtl < 2; ++rtl)
#pragma unroll
                    for (int pt = 0; pt < 4; ++pt)
#pragma unroll
                        for (int r = 0; r < 4; ++r) YT[(16 * rtl + 4 * fq + r) * 68 + 16 * pt + fr] = y[2 * pass + rtl][pt][r];
                LDS_WAIT(); asm volatile("" ::: "memory");
                const size_t tok = (size_t)(t0 + 32 * pass + prow); const int col0 = 64 * h + pch;
                const float* ydp = YD + tok * 1024 + col0; const bf16_t* xp = xc + tok * XBCW + col0; const bf16_t* zp = proj + tok * NPROJ_PAD + OFF_Z + col0; bf16_t* mp = mix + tok * D + col0;
                float sacc = 0.f;
#pragma unroll
                for (int i = 0; i < 4; ++i) {
                    const f32x4 ya = *(const LAS f32x4*)(YT + prow * 68 + pch + 8 * i), yb = *(const LAS f32x4*)(YT + prow * 68 + pch + 8 * i + 4);
                    const f32x4 da = *(const f32x4*)(ydp + 8 * i), db = *(const f32x4*)(ydp + 8 * i + 4);
                    const u32x4 xv = *(const u32x4*)(xp + 8 * i), zv = *(const u32x4*)(zp + 8 * i);
                    float gv[8];
                    gv[0] = (ya[0] + da[0] + dsk * lo_f(xv.x)) * silu_f(lo_f(zv.x)); gv[1] = (ya[1] + da[1] + dsk * hi_f(xv.x)) * silu_f(hi_f(zv.x));
                    gv[2] = (ya[2] + da[2] + dsk * lo_f(xv.y)) * silu_f(lo_f(zv.y)); gv[3] = (ya[3] + da[3] + dsk * hi_f(xv.y)) * silu_f(hi_f(zv.y));
                    gv[4] = (yb[0] + db[0] + dsk * lo_f(xv.z)) * silu_f(lo_f(zv.z)); gv[5] = (yb[1] + db[1] + dsk * hi_f(xv.z)) * silu_f(hi_f(zv.z));
                    gv[6] = (yb[2] + db[2] + dsk * lo_f(xv.w)) * silu_f(lo_f(zv.w)); gv[7] = (yb[3] + db[3] + dsk * hi_f(xv.w)) * silu_f(hi_f(zv.w));
#pragma unroll
                    for (int j = 0; j < 8; ++j) sacc += gv[j] * gv[j];
                    u32x4 o; o.x = pk2(gv[0], gv[1]); o.y = pk2(gv[2], gv[3]); o.z = pk2(gv[4], gv[5]); o.w = pk2(gv[6], gv[7]);
                    *(u32x4*)(mp + 8 * i) = o; }
                ssr[pass] += sacc;
                LDS_WAIT(); asm volatile("" ::: "memory");
            }
        }
#pragma unroll
        for (int pass = 0; pass < 2; ++pass) { float v = ssr[pass]; v += __shfl_xor(v, 1); if ((lane & 1) == 0) RED[(32 * pass + prow) * 8 + w] = v; }
        VM_WAIT();
        __syncthreads();
#pragma unroll
        for (int pass = 0; pass < 2; ++pass) { const LAS float* rp = RED + (32 * pass + prow) * 8; const f32x4 a = *(const LAS f32x4*)rp, bb = *(const LAS f32x4*)(rp + 4);
            ssr[pass] = rsqrtf(((a[0] + a[1]) + (a[2] + a[3]) + (bb[0] + bb[1]) + (bb[2] + bb[3])) * (1.f / 1024.f) + RMS_EPS); }
#pragma unroll 1
        for (int hx = 0; hx < 2; ++hx) { const int h = 2 * w + hx; const int col0 = 64 * h + pch;
#pragma unroll
            for (int pass = 0; pass < 2; ++pass) { bf16_t* mp = mix + (size_t)(t0 + 32 * pass + prow) * D + col0; const float rs = ssr[pass];
#pragma unroll
                for (int i = 0; i < 4; ++i) { const u32x4 v = *(const u32x4*)(mp + 8 * i); const f32x4 g0 = *(const f32x4*)(sg + col0 + 8 * i), g1 = *(const f32x4*)(sg + col0 + 8 * i + 4);
                    u32x4 o; o.x = pk2(lo_f(v.x) * rs * g0[0], hi_f(v.x) * rs * g0[1]); o.y = pk2(lo_f(v.y) * rs * g0[2], hi_f(v.y) * rs * g0[3]);
                    o.z = pk2(lo_f(v.z) * rs * g1[0], hi_f(v.z) * rs * g1[1]); o.w = pk2(lo_f(v.w) * rs * g1[2], hi_f(v.w) * rs * g1[3]);
                    *(u32x4*)(mp + 8 * i) = o; } } }
        __syncthreads();
    }
}

__device__ __forceinline__ void p6_attn_merge(const Args& A) {
    unsigned char* ws = A.ws;
    const bf16_t* AO = (const bf16_t*)(ws + WS_AO); const float* ML = (const float*)(ws + WS_ML); bf16_t* mix = (bf16_t*)(ws + WS_MIX);
    const int gtid = blockIdx.x * 512 + threadIdx.x, NT = gridDim.x * 512;
    for (int i = gtid; i < T * 16 * 8; i += NT) {
        const int e8 = i & 7, h = (i >> 3) & 15, t = i >> 7;
        float m[3], l[3];
#pragma unroll
        for (int r = 0; r < 3; ++r) { const f32x2 v = *(const f32x2*)(ML + (((size_t)r * T + t) * 16 + h) * 2); m[r] = v[0]; l[r] = v[1]; }
        const float M = fmaxf(m[0], fmaxf(m[1], m[2]));
        float wgt[3], W = 0.f;
#pragma unroll
        for (int r = 0; r < 3; ++r) { wgt[r] = l[r] * __builtin_amdgcn_exp2f(m[r] - M); W += wgt[r]; }
        const float iw = 1.f / W; float o[8];
#pragma unroll
        for (int j = 0; j < 8; ++j) o[j] = 0.f;
#pragma unroll
        for (int r = 0; r < 3; ++r) { const u32x4 v = *(const u32x4*)(AO + ((size_t)r * T + t) * 1024 + 64 * h + 8 * e8); const float ww = wgt[r] * iw;
            o[0] += ww * lo_f(v.x); o[1] += ww * hi_f(v.x); o[2] += ww * lo_f(v.y); o[3] += ww * hi_f(v.y); o[4] += ww * lo_f(v.z); o[5] += ww * hi_f(v.z); o[6] += ww * lo_f(v.w); o[7] += ww * hi_f(v.w); }
        u32x4 ow; ow.x = pk2(o[0], o[1]); ow.y = pk2(o[2], o[3]); ow.z = pk2(o[4], o[5]); ow.w = pk2(o[6], o[7]);
        *(u32x4*)(mix + (size_t)t * D + 1024 + 64 * h + 8 * e8) = ow;
    }
}

__device__ __forceinline__ void p8_router(const Args& A, LAS unsigned char* lds) {
    const int tid = threadIdx.x, lane = tid & 63, w = __builtin_amdgcn_readfirstlane(tid >> 6), fr = lane & 15, fq = lane >> 4;
    unsigned char* ws = A.ws;
    const float* x1 = (const float*)(ws + WS_X1); const float* mod = (const float*)(ws + WS_MOD); const float* g2 = (const float*)A.in[I_N2G];
    const bf16_t* whi = (const bf16_t*)(ws + WS_WRT); const bf16_t* wlo = whi + NRT * D;
    const float* brg = (const float*)A.in[I_BRG]; const float* bre = (const float*)A.in[I_BRE];
    bf16_t* h2 = (bf16_t*)(ws + WS_HB);
    unsigned* cnt = (unsigned*)(ws + WS_CTL) + CW_CNT; int* elist = (int*)(ws + WS_ELIST); float* gates = (float*)(ws + WS_GATES);
    LAS float* A2 = (LAS float*)lds; LAS float* SH2 = A2 + D; LAS float* SS = (LAS float*)(lds + 16384); LAS float* ACC = (LAS float*)(lds + 16896); LAS float* LG = (LAS float*)(lds + 37376);
    const int sub = w >> 1, kh = w & 1;
    for (int tt = blockIdx.x; tt < T / 64; tt += gridDim.x) {
        const int b = (tt * 64) >= SEQ ? 1 : 0; const float* mb = mod + b * 12288;
        for (int i = tid; i < D; i += 512) { A2[i] = g2[i] * (1.f + mb[4 * D + i]); SH2[i] = mb[3 * D + i]; }
        const int tk = tt * 64 + 16 * sub + fr; const float* xr = x1 + (size_t)tk * D + 8 * fq;
        float ssq = 0.f;
#pragma unroll 4
        for (int ks = 32 * kh; ks < 32 * kh + 32; ++ks) { const f32x4 a = *(const f32x4*)(xr + 32 * ks), c = *(const f32x4*)(xr + 32 * ks + 4);
            ssq += (a[0] * a[0] + a[1] * a[1]) + (a[2] * a[2] + a[3] * a[3]) + (c[0] * c[0] + c[1] * c[1]) + (c[2] * c[2] + c[3] * c[3]); }
        ssq += __shfl_xor(ssq, 16); ssq += __shfl_xor(ssq, 32);
        if (fq == 0) SS[w * 16 + fr] = ssq;
        __syncthreads();
        const float rstd = rsqrtf((SS[(2 * sub) * 16 + fr] + SS[(2 * sub + 1) * 16 + fr]) * (1.f / D) + RMS_EPS);
        f32x4 acc[5];
#pragma unroll
        for (int ct = 0; ct < 5; ++ct) acc[ct] = (f32x4){0.f, 0.f, 0.f, 0.f};
#pragma unroll 2
        for (int ks = 32 * kh; ks < 32 * kh + 32; ++ks) { const int col = 32 * ks + 8 * fq;
            const f32x4 a = *(const f32x4*)(xr + 32 * ks), c = *(const f32x4*)(xr + 32 * ks + 4);
            const f32x4 m0 = *(const LAS f32x4*)(A2 + col), m1 = *(const LAS f32x4*)(A2 + col + 4), s0 = *(const LAS f32x4*)(SH2 + col), s1 = *(const LAS f32x4*)(SH2 + col + 4);
            const f32x4 v0 = (a * rstd) * m0 + s0, v1 = (c * rstd) * m1 + s1;
            u32x4 hw; hw.x = pk2(v0[0], v0[1]); hw.y = pk2(v0[2], v0[3]); hw.z = pk2(v1[0], v1[1]); hw.w = pk2(v1[2], v1[3]);
            u32x4 lw; lw.x = pk2(v0[0] - lo_f(hw.x), v0[1] - hi_f(hw.x)); lw.y = pk2(v0[2] - lo_f(hw.y), v0[3] - hi_f(hw.y));
            lw.z = pk2(v1[0] - lo_f(hw.z), v1[1] - hi_f(hw.z)); lw.w = pk2(v1[2] - lo_f(hw.w), v1[3] - hi_f(hw.w));
            *(u32x4*)(h2 + (size_t)tk * D + col) = hw;
            const bf16x8 ah = mk_frag(hw), al = mk_frag(lw);
#pragma unroll
            for (int ct = 0; ct < 5; ++ct) { const bf16x8 bh = *(const bf16x8*)(whi + (size_t)(16 * ct + fr) * D + col), bl = *(const bf16x8*)(wlo + (size_t)(16 * ct + fr) * D + col);
                acc[ct] = mfma16(ah, bh, acc[ct]); acc[ct] = mfma16(al, bh, acc[ct]); acc[ct] = mfma16(ah, bl, acc[ct]); } }
        if (kh == 1) {
#pragma unroll
            for (int ct = 0; ct < 5; ++ct) *(LAS f32x4*)(ACC + (sub * 64 + lane) * 20 + 4 * ct) = acc[ct]; }
        __syncthreads();
        if (kh == 0) {
#pragma unroll
            for (int ct = 0; ct < 5; ++ct) { const f32x4 o = acc[ct] + *(const LAS f32x4*)(ACC + (sub * 64 + lane) * 20 + 4 * ct);
#pragma unroll
                for (int r = 0; r < 4; ++r) LG[(sub * 16 + 4 * fq + r) * NRT + 16 * ct + fr] = o[r]; } }
        __syncthreads();
        if (kh == 0 && lane < 16) {
            const LAS float* lg = LG + (sub * 16 + lane) * NRT; const int tok = tt * 64 + 16 * sub + lane;
            float gmx = -3.0e38f; int gi = 0;
#pragma unroll
            for (int j = 0; j < 8; ++j) { const float v = lg[j] + brg[j]; if (v > gmx) { gmx = v; gi = j; } }
            float gse = 0.f;
#pragma unroll
            for (int j = 0; j < 8; ++j) gse += __expf(lg[j] + brg[j] - gmx);
            const float pgroup = 1.f / gse;
            const LAS float* el = lg + 16 + 8 * gi; const float* be = bre + 8 * gi;
            float emx = -3.0e38f; int i1 = 0;
#pragma unroll
            for (int j = 0; j < 8; ++j) { const float v = el[j] + be[j]; if (v > emx) { emx = v; i1 = j; } }
            float e2 = -3.0e38f; int i2 = 0; float ese = 0.f;
#pragma unroll
            for (int j = 0; j < 8; ++j) { const float v = el[j] + be[j]; ese += __expf(v - emx); if (j != i1 && v > e2) { e2 = v; i2 = j; } }
            const float p1 = 1.f / ese, p2 = __expf(e2 - emx) / ese; const float ps = p1 + p2;
            const float g1v = pgroup * p1 / ps, g2v = pgroup * p2 / ps;
            const int ea = 8 * gi + i1, eb = 8 * gi + i2;
            const unsigned pa = atomicAdd(cnt + ea, 1u), pb = atomicAdd(cnt + eb, 1u);
            elist[(size_t)ea * ECAP + pa] = 2 * tok; elist[(size_t)eb * ECAP + pb] = 2 * tok + 1;
            gates[2 * tok] = g1v; gates[2 * tok + 1] = g2v;
        }
        __syncthreads();
    }
}

__device__ __forceinline__ int moe_tables(const Args& A, LAS unsigned char* lds, int npn, bool down) {
    const int tid = threadIdx.x;
    unsigned char* ws = A.ws;
    const unsigned* cnt = (const unsigned*)(ws + WS_CTL) + CW_CNT; const int* elist = (const int*)(ws + WS_ELIST); const float* gates = (const float*)(ws + WS_GATES);
    LAS int* tb = (LAS int*)(lds + ETAB_OFF); LAS int* cn = tb + 80;
    if (tid < 64) cn[tid] = (int)__hip_atomic_load(cnt + tid, __ATOMIC_RELAXED, __HIP_MEMORY_SCOPE_AGENT);
    __syncthreads();
    if (tid <= 64) { int s = 0; for (int j = 0; j < tid; ++j) s += (cn[j] + 255) >> 8; tb[tid] = s; }
    __syncthreads();
    const int ntiles = tb[64];
    LAS int* tab = (LAS int*)(lds + TAB_OFF);
    const int cap = down ? 6 : 12;
    for (int li = 0; li < cap; ++li) {
        const long L = (long)li * gridDim.x + blockIdx.x; if (L >= (long)ntiles * npn) break;
        const int tau = (int)(L / npn); int e = 0;
        for (int j = 1; j < NEXP; ++j) e += (tb[j] <= tau) ? 1 : 0;
        const int mt = tau - tb[e], ce = cn[e];
        if (tid < 256) { const int pos = 256 * mt + tid; const bool ok = pos < ce; const int a = ok ? elist[(size_t)e * ECAP + pos] : -1;
            if (down) { tab[li * 512 + 2 * tid] = a; tab[li * 512 + 2 * tid + 1] = ok ? __float_as_int(gates[a]) : 0; }
            else tab[li * 256 + tid] = ok ? (a >> 1) * (D * 2) : 0; }
    }
    __syncthreads();
    return ntiles;
}

__device__ __forceinline__ void p11_combine(const Args& A) {
    unsigned char* ws = A.ws;
    const float* x1 = (const float*)(ws + WS_X1); const float* mod = (const float*)(ws + WS_MOD); const bf16_t* Y = (const bf16_t*)(ws + WS_YSLOT);
    const int gtid = blockIdx.x * 512 + threadIdx.x, NT = gridDim.x * 512;
    for (int i = gtid; i < T * (D / 8); i += NT) {
        const int t = i >> 8, c8 = (i & 255) * 8;
        const float* gp = mod + (t >= SEQ ? 12288 : 0) + 5 * D + c8;
        const f32x4 g0 = *(const f32x4*)gp, g1 = *(const f32x4*)(gp + 4);
        const f32x4 a0 = *(const f32x4*)(x1 + (size_t)t * D + c8), a1 = *(const f32x4*)(x1 + (size_t)t * D + c8 + 4);
        const u32x4 ya = *(const u32x4*)(Y + (size_t)(2 * t) * D + c8), yb = *(const u32x4*)(Y + (size_t)(2 * t + 1) * D + c8);
        f32x4 s0, s1;
        s0[0] = lo_f(ya.x) + lo_f(yb.x); s0[1] = hi_f(ya.x) + hi_f(yb.x); s0[2] = lo_f(ya.y) + lo_f(yb.y); s0[3] = hi_f(ya.y) + hi_f(yb.y);
        s1[0] = lo_f(ya.z) + lo_f(yb.z); s1[1] = hi_f(ya.z) + hi_f(yb.z); s1[2] = lo_f(ya.w) + lo_f(yb.w); s1[3] = hi_f(ya.w) + hi_f(yb.w);
        *(f32x4*)(A.out + (size_t)t * D + c8) = a0 + g0 * s0; *(f32x4*)(A.out + (size_t)t * D + c8 + 4) = a1 + g1 * s1;
    }
}

constexpr int NPH = 12;
__global__ void __launch_bounds__(512, 2) hyb_fwd(Args args) {
    extern __shared__ __attribute__((aligned(16))) unsigned char lds_raw[];
    LAS unsigned char* lds = (LAS unsigned char*)lds_raw;
    const int tid = threadIdx.x;
    volatile LAS unsigned* MISC = (volatile LAS unsigned*)(lds + MISC_OFF);
    for (int u = tid; u < 128; u += 512) MISC[u] = 0u;
    __syncthreads();
    unsigned char* ws = args.ws;
    unsigned* ctl = (unsigned*)(ws + WS_CTL);
    const int lo = args.ph_lo, hi = args.ph_hi;
    XcdBarrier bar; bar.bar = ctl + CW_BAR; bar.x = 0; bar.st = nullptr;
    if (hi - lo > 1) bar = xcd_barrier_post(ctl + CW_BAR, MISC + 8);
#ifndef PH_MASK
#define PH_MASK 0xFFF
#endif
#define IN(k) ((((PH_MASK) >> (k)) & 1) && lo <= (k) && (k) < hi)
#define SEAM(k) do { if (IN(k) && IN((k) + 1)) xcd_barrier(bar); } while (0)

    if (IN(0)) { p0_prologue(args, lds); } SEAM(0);
    if (IN(1)) { p1_norm1(args); } SEAM(1);
    if (IN(2)) {
        pg8::Gemm g{(const bf16_t*)(ws + WS_HB), (const bf16_t*)(ws + WS_WINT), D, 0};
        pg8::StaticOrder S; S.init(T, NPROJ_PAD, (int)gridDim.x, (int)blockIdx.x);
        EpiProj E{(bf16_t*)(ws + WS_PROJ), (float*)(ws + WS_DTRAW)};
        pg8::gemm_phase<EpiProj, pg8::StaticOrder, true, false>(lds, g, S, E);
    } SEAM(2);
    if (IN(3)) { p3_post(args); } SEAM(3);
    if (IN(4)) { p4_ssd_local(args, lds); p4_attn(args, lds); } SEAM(4);
    if (IN(5)) { p5_scan(args); } SEAM(5);
    if (IN(6)) { p6_ssd_final(args, lds); p6_attn_merge(args); } SEAM(6);
    if (IN(7)) {
        pg8::Gemm g{(const bf16_t*)(ws + WS_MIX), (const bf16_t*)(ws + WS_WOUTT), D, 0};
        pg8::StaticOrder S; S.init(T, D, (int)gridDim.x, (int)blockIdx.x);
        EpiOut E{(const float*)args.in[I_X], (const float*)(ws + WS_MOD), (float*)(ws + WS_X1)};
        pg8::gemm_phase<EpiOut, pg8::StaticOrder, true, false>(lds, g, S, E);
    } SEAM(7);
    if (IN(8)) { p8_router(args, lds); } SEAM(8);
    if (IN(9)) {
        const int ntiles = moe_tables(args, lds, 4, false);
        pg8::Gemm g{(const bf16_t*)(ws + WS_HB), (const bf16_t*)(ws + WS_WGUT), D, (size_t)1024 * D * 2};
        MoeOrder S{(const LAS int*)(lds + ETAB_OFF), ntiles, 4, (int)gridDim.x, (int)blockIdx.x, (const LAS unsigned*)(lds + TAB_OFF)};
        EpiGU E{(bf16_t*)(ws + WS_HMOE)};
        pg8::gemm_phase<EpiGU, MoeOrder, true, true>(lds, g, S, E);
    } SEAM(9);
    if (IN(10)) {
        const int ntiles = moe_tables(args, lds, 8, true);
        pg8::Gemm g{(const bf16_t*)(ws + WS_HMOE), (const bf16_t*)(ws + WS_WDT), EH, (size_t)D * EH * 2};
        MoeOrder S{(const LAS int*)(lds + ETAB_OFF), ntiles, 8, (int)gridDim.x, (int)blockIdx.x, (const LAS unsigned*)(lds + TAB_OFF)};
        EpiDown E{(bf16_t*)(ws + WS_YSLOT), (const LAS int*)(lds + TAB_OFF)};
        pg8::gemm_phase<EpiDown, MoeOrder, true, false>(lds, g, S, E);
    } SEAM(10);
    if (IN(11)) { p11_combine(args); }
#undef IN
#undef SEAM
}

extern "C" void kernel_launch(void* const* d_in, const int* in_sizes, int n_in, void* d_out, int out_size, void* d_ws, size_t ws_size, hipStream_t stream) {
    static int grid = 0;
    if (grid == 0) {
        if (n_in != 24 || in_sizes[0] != T * D || out_size != T * D || ws_size < WS_END) { fprintf(stderr, "kernel_launch: unexpected shapes (n_in %d, in0 %d, out %d, ws %zu < %zu); nothing launched\n", n_in, n_in > 0 ? in_sizes[0] : -1, out_size, ws_size, (size_t)WS_END); grid = -1; return; }
        int dev = 0, cus = 0, per_cu = 0;
        if (hipGetDevice(&dev) != hipSuccess || hipDeviceGetAttribute(&cus, hipDeviceAttributeMultiprocessorCount, dev) != hipSuccess) { grid = -1; return; }
        if (hipFuncSetAttribute((const void*)hyb_fwd, hipFuncAttributeMaxDynamicSharedMemorySize, LDS_BYTES) != hipSuccess) { fprintf(stderr, "kernel_launch: hipFuncSetAttribute failed\n"); grid = -1; return; }
        if (hipOccupancyMaxActiveBlocksPerMultiprocessor(&per_cu, (const void*)hyb_fwd, 512, LDS_BYTES) != hipSuccess || per_cu < 1) fprintf(stderr, "kernel_launch: occupancy query reports %d\n", per_cu);
        (void)hipGetLastError();
        grid = cus;
    }
    if (grid < 0) return;
    (void)hipMemsetAsync((char*)d_ws + WS_CTL, 0, CTL_BYTES, stream);
    Args a{};
    for (int i = 0; i < 24; ++i) a.in[i] = d_in[i];
    a.out = (float*)d_out; a.ws = (unsigned char*)d_ws;
#if MK_ONE_LAUNCH
    a.ph_lo = 0; a.ph_hi = NPH;
    hipLaunchKernelGGL(hyb_fwd, dim3(grid), dim3(512), LDS_BYTES, stream, a);
#else
    for (int p = 0; p < NPH; ++p) { a.ph_lo = p; a.ph_hi = p + 1; hipLaunchKernelGGL(hyb_fwd, dim3(grid), dim3(512), LDS_BYTES, stream, a); }
#endif
}
```

```cpp
#include <hip/hip_runtime.h>
#include <cstdio>
#include <cstdint>

#ifndef MK_ONE_LAUNCH
#define MK_ONE_LAUNCH 1
#endif

#define LAS __attribute__((address_space(3)))
#define GAS __attribute__((address_space(1)))
typedef unsigned short bf16_t;
typedef short bf16x8 __attribute__((ext_vector_type(8)));
typedef float f32x4 __attribute__((ext_vector_type(4)));
typedef float f32x2 __attribute__((ext_vector_type(2)));
typedef unsigned u32x4 __attribute__((ext_vector_type(4)));
typedef unsigned u32x2 __attribute__((ext_vector_type(2)));

constexpr int BATCH = 2, SEQ = 8192, T = BATCH * SEQ, D = 2048;
constexpr int NPROJ = 5664, NPROJ_PAD = 5888;
constexpr int OFF_Q = 0, OFF_K = 1024, OFF_V = 2048, OFF_Z = 3072, OFF_XBC = 4096, OFF_DT = 5632;
constexpr int XBCW = 1536, NHEAD = 16, CHUNK = 128, NCHUNK = SEQ / CHUNK;
constexpr int NEXP = 64, EH = 512;
constexpr int ECAP = T;
constexpr int NRT = 80;
constexpr float RMS_EPS = 1e-6f;
constexpr float LOG2E = 1.4426950408889634f;

constexpr size_t MiB = 1u << 20;
constexpr size_t WS_CTL = 0, CTL_BYTES = 1 * MiB;
constexpr size_t WS_MOD = 1 * MiB;
constexpr size_t WS_ROPE = 2 * MiB;
constexpr size_t WS_WRT = 6 * MiB;
constexpr size_t WS_SMALL = 7 * MiB;
constexpr size_t WS_DTRAW = WS_SMALL, WS_DTF = WS_SMALL + 2 * MiB, WS_DTB = WS_SMALL + 3 * MiB, WS_ACS = WS_SMALL + 4 * MiB, WS_RCS = WS_SMALL + 5 * MiB, WS_DEC = WS_SMALL + 6 * MiB;
constexpr size_t WS_ML = 14 * MiB;
constexpr size_t WS_ELIST = 20 * MiB;
constexpr size_t WS_GATES = 24 * MiB;
constexpr size_t WS_WINT = 25 * MiB;
constexpr size_t WS_WOUTT = 48 * MiB;
constexpr size_t WS_WGUT = 56 * MiB;
constexpr size_t WS_WDT = 312 * MiB;
constexpr size_t WS_HB = 440 * MiB;
constexpr size_t WS_PROJ = 504 * MiB;
constexpr size_t WS_YSLOT = WS_PROJ, WS_HMOE = WS_PROJ + 128 * MiB;
constexpr size_t WS_ST = 688 * MiB;
constexpr size_t WS_X1 = WS_ST;
constexpr size_t WS_YD = 816 * MiB;
constexpr size_t WS_AO = 880 * MiB;
constexpr size_t WS_RSS = WS_AO;
constexpr size_t WS_MIX = 976 * MiB;
constexpr size_t WS_END = 1040 * MiB;

constexpr int CW_BAR = 4096;
constexpr int CW_CNT = 16384;
constexpr int CW_FLAG = 16384 + 4096;

constexpr int RING_BYTES = 131072;
constexpr int MISC_OFF = 133120;
constexpr int TAB_OFF = MISC_OFF + 512;
constexpr int ETAB_OFF = TAB_OFF + 12288;
constexpr int LDS_BYTES = 147456;
static_assert(ETAB_OFF + 1024 <= LDS_BYTES, "LDS map");

__device__ __forceinline__ float bf2f(unsigned v) { return __uint_as_float(v << 16); }
__device__ __forceinline__ unsigned f2bf(float f) { unsigned u = __float_as_uint(f); return (u + 0x7fffu + ((u >> 16) & 1u)) >> 16; }
typedef __bf16 bf16v2_t __attribute__((ext_vector_type(2)));
__device__ __forceinline__ unsigned pk2(float lo, float hi) { const f32x2 v = {lo, hi}; return __builtin_bit_cast(unsigned, __builtin_convertvector(v, bf16v2_t)); }
__device__ __forceinline__ float lo_f(unsigned w) { return __uint_as_float(w << 16); }
__device__ __forceinline__ float hi_f(unsigned w) { return __uint_as_float(w & 0xffff0000u); }
__device__ __forceinline__ float silu_f(float v) { return v / (1.f + __expf(-v)); }
#define LDS_WAIT() asm volatile("s_waitcnt lgkmcnt(0)" ::: "memory")
#define VM_WAIT() asm volatile("s_waitcnt vmcnt(0)" ::: "memory")

#define XB_TMO      128
#define XB_XCNT(j)  (256  + 64 * (j))
#define XB_XSUB(j)  (1280 + 64 * (j))
#define XB_XGEN(j)  (2304 + 64 * (j))
#define XB_TOP      3328
#define XB_TOPGEN   3392
#define XCD_BAR_WORDS 3456
#define XB_SPIN_CAP (1u << 18)
__device__ __forceinline__ unsigned xb_ld(unsigned* p)              { return __hip_atomic_load(p, __ATOMIC_RELAXED, __HIP_MEMORY_SCOPE_AGENT); }
__device__ __forceinline__ unsigned xb_add(unsigned* p, unsigned v) { return __hip_atomic_fetch_add(p, v, __ATOMIC_RELAXED, __HIP_MEMORY_SCOPE_AGENT); }
__device__ __forceinline__ unsigned xb_xcc_id() { return (unsigned)__builtin_amdgcn_s_getreg((3 << 11) | 20) & 0xFu; }
#define XB_SPIN(cond, bar) do { unsigned _sp = 0; while (cond) { __builtin_amdgcn_s_sleep(1); \
    if ((++_sp & 255u) == 0u) { if (xb_ld(&(bar)[XB_TMO])) break; if (_sp > XB_SPIN_CAP) { atomicAdd(&(bar)[XB_TMO], 1u); break; } } } } while (0)
struct XcdBarrier { unsigned* bar; unsigned x; volatile LAS unsigned* st; };
__device__ __forceinline__ XcdBarrier xcd_barrier_post(unsigned* bar, volatile LAS unsigned* st) {
    XcdBarrier b; b.bar = bar; b.x = xb_xcc_id(); b.st = st;
    if (threadIdx.x == 0) (void)xb_add(&bar[XB_XCNT(b.x)], 1u);
    return b;
}
__device__ __forceinline__ void xcd_barrier_complete(unsigned* bar, unsigned x, unsigned& nloc, unsigned& nx) {
    const unsigned G = gridDim.x * gridDim.y * gridDim.z;
    unsigned sum, cnt, mine, sp = 0u;
    for (;;) {
        sum = 0u; cnt = 0u; mine = 0u;
#pragma unroll
        for (unsigned j = 0; j < 16; ++j) { const unsigned c = xb_ld(&bar[XB_XCNT(j)]); sum += c; cnt += (c > 0u) ? 1u : 0u; mine = (j == x) ? c : mine; }
        if (sum == G) break;
        __builtin_amdgcn_s_sleep(1);
        if ((++sp & 255u) == 0u) { if (xb_ld(&bar[XB_TMO])) break; if (sp > XB_SPIN_CAP) { atomicAdd(&bar[XB_TMO], 1u); break; } }
    }
    nloc = mine > 0u ? mine : 1u; nx = cnt > 0u ? cnt : 1u;
}
__device__ __forceinline__ void xcd_barrier(const XcdBarrier& b) {
    asm volatile("s_waitcnt vmcnt(0)" ::: "memory");
    __syncthreads();
    if (threadIdx.x == 0) {
        unsigned* bar = b.bar;
        __builtin_amdgcn_s_waitcnt(0);
        unsigned nloc = b.st[0], nx = b.st[1];
        if (nloc == 0u) { xcd_barrier_complete(bar, b.x, nloc, nx); b.st[0] = nloc; b.st[1] = nx; }
        const unsigned old = xb_add(&bar[XB_XSUB(b.x)], 1u);
        const unsigned gen = old / nloc;
        if (old + 1u == (gen + 1u) * nloc) {
            __builtin_amdgcn_fence(__ATOMIC_RELEASE, "agent");
            asm volatile("s_waitcnt vmcnt(0)" ::: "memory");
            const unsigned og = xb_add(&bar[XB_TOP], 1u);
            const unsigned tg = og / nx;
            if (og + 1u == (tg + 1u) * nx) xb_add(&bar[XB_TOPGEN], 1u);
            else XB_SPIN(xb_ld(&bar[XB_TOPGEN]) == tg, bar);
            __builtin_amdgcn_fence(__ATOMIC_ACQUIRE, "agent");
            xb_add(&bar[XB_XGEN(b.x)], 1u);
            asm volatile("s_waitcnt vmcnt(0)" ::: "memory");
        } else {
            XB_SPIN(xb_ld(&bar[XB_XGEN(b.x)]) == gen, bar);
            __builtin_amdgcn_fence(__ATOMIC_ACQUIRE, "agent");
            asm volatile("s_waitcnt vmcnt(0)" ::: "memory");
        }
    }
    __syncthreads();
}

namespace pg8 {
constexpr int BM = 256, BK = 64, HALF = 128, HTB = HALF * BK * 2, STAGE_BYTES = 8 * HTB, NXCD = 8, WGM = 8;
__device__ __forceinline__ int lds_byte(int r, int c) { const int st = (r >> 4) * 2 + (c >> 5), rr = r & 15, cc = c & 31, ob = rr * 64 + cc * 2; return st * 1024 + (ob ^ (((ob >> 9) & 1) << 5)); }
__device__ __forceinline__ void stage_rc(int b, int& R, int& C) { const int st = b / 1024, sb = b % 1024, swz = sb ^ (((sb >> 9) & 1) << 5); R = (st >> 1) * 16 + swz / 64; C = (st & 1) * 32 + (swz % 64) / 2; }
__device__ __forceinline__ int perm32(int rho) { const int n = rho >> 4, i = rho & 15; return 8 * (i >> 2) + 4 * n + (i & 3); }

struct Unit { int pm, pn, e, li, hf; };
struct Gemm { const bf16_t* A; const bf16_t* Bt; int K; size_t bstride; };

struct StaticOrder {
    int nM, nN, nwg, G, c, rep;
    __device__ void init(int M, int N, int G_, int c_, int rep_ = 1) { nM = M / BM; nN = N / BM; nwg = nM * nN; G = G_; c = c_; rep = rep_; }
    __device__ bool next(int i, Unit& u) const {
        const long L = (long)i * G + c; if (L >= (long)nwg * rep) return false;
        int wgid = (int)(L % nwg); { const int q = nwg / NXCD, r = nwg % NXCD, xcd = wgid % NXCD, off = wgid / NXCD; wgid = (xcd < r ? xcd * (q + 1) : r * (q + 1) + (xcd - r) * q) + off; }
        const int nig = WGM * nN, gid = wgid / nig, fm = gid * WGM, gsz = (nM - fm) < WGM ? (nM - fm) : WGM;
        u.pm = fm + ((wgid % nig) % gsz); u.pn = (wgid % nig) / gsz; u.e = 0; u.li = i; u.hf = 0; return true;
    }
    __device__ __forceinline__ void a_ready(const Unit&) const {}
    __device__ __forceinline__ void done(const Unit&) const {}
    __device__ __forceinline__ void load_goff(const Unit&, unsigned (&)[2][2], const int (&)[2], const int (&)[2]) const {}
};

template <class Epi, class Sched, bool ALIGN_EPI, bool GATHER>
__device__ __forceinline__ void gemm_phase(LAS unsigned char* lds, const Gemm g, const Sched& S, const Epi& E) {
    const int tid = threadIdx.x, wid = __builtin_amdgcn_readfirstlane(tid >> 6), lane = tid & 63, wr = wid >> 2, wc = wid & 3, fr = lane & 15, fq = lane >> 4;
    const int K = g.K, nt = K / BK;
    unsigned voffA[2], voffB[2]; int RA[2], CA[2];
#pragma unroll
    for (int i = 0; i < 2; ++i) { int R, C; stage_rc(tid * 16 + i * 8192, R, C); const int Rb = Epi::PERM ? ((R & ~31) + perm32(R & 31)) : R; RA[i] = R; CA[i] = C;
        voffA[i] = (unsigned)(R * K + C) * 2u; voffB[i] = (unsigned)(Rb * K + C) * 2u; }
    unsigned goff[2][2] = {{0u, 0u}, {0u, 0u}};
    const size_t kstep = (size_t)(BK * 2);
    const size_t hstep = (size_t)HALF * K * 2;
    const size_t tstep = 2 * hstep;
    const unsigned ldsw = (unsigned)wid * 1024u;
    const int aoff = lds_byte(wr * 64 + fr, fq * 8), boff = lds_byte(wc * 32 + fr, fq * 8);
#define PG8_SA(b, h) (((b) * 2 + (h)) * HTB)
#define PG8_SB(b, h) ((4 + (b) * 2 + (h)) * HTB)
#define PG8_STAGE(bufoff, gbase, voff) do { _Pragma("unroll") for (int _i = 0; _i < 2; ++_i) \
        __builtin_amdgcn_global_load_lds((const unsigned*)((const char*)(gbase) + (voff)[_i]), (LAS unsigned*)(lds + (bufoff) + ldsw + _i * 8192), 16, 0, 0); } while (0)
#define PG8_STAGE_A(bufoff, cptr, kb, h) do { if constexpr (GATHER) { PG8_STAGE(bufoff, (const char*)g.A + (kb), goff[h]); } else { PG8_STAGE(bufoff, (cptr) + (kb) + ((h) ? hstep : 0), voffA); } } while (0)
#define PG8_LDA(dst, b, h) do { _Pragma("unroll") for (int m = 0; m < 4; ++m) _Pragma("unroll") for (int k = 0; k < 2; ++k) dst[m][k] = *(const LAS bf16x8*)(lds + PG8_SA(b, h) + aoff + m * 2048 + k * 1024); } while (0)
#define PG8_LDB(dst, b, h) do { _Pragma("unroll") for (int n = 0; n < 2; ++n) _Pragma("unroll") for (int k = 0; k < 2; ++k) dst[n][k] = *(const LAS bf16x8*)(lds + PG8_SB(b, h) + boff + n * 2048 + k * 1024); } while (0)
#define PG8_MMA(ai, bj, At, Bt) do { __builtin_amdgcn_s_setprio(1); _Pragma("unroll") for (int m = 0; m < 4; ++m) _Pragma("unroll") for (int n = 0; n < 2; ++n) _Pragma("unroll") for (int k = 0; k < 2; ++k) \
        acc[ai][bj][m][n] = __builtin_amdgcn_mfma_f32_16x16x32_bf16(Bt[n][k], At[m][k], acc[ai][bj][m][n], 0, 0, 0); __builtin_amdgcn_s_setprio(0); } while (0)
#define PG8_WAIT_V(n) asm volatile("s_waitcnt vmcnt(" #n ")" ::: "memory")
#define PG8_WAIT_L(n) asm volatile("s_waitcnt lgkmcnt(" #n ")" ::: "memory")
#define PG8_BAR __builtin_amdgcn_s_barrier()
#define PG8_SCHED __builtin_amdgcn_sched_barrier(0)
    Unit cur, nxt; int ui = 0;
    if (!S.next(0, cur)) return;
    f32x4 acc[2][2][4][2];
#pragma unroll
    for (int a = 0; a < 2; ++a)
#pragma unroll
        for (int b = 0; b < 2; ++b)
#pragma unroll
            for (int m = 0; m < 4; ++m)
#pragma unroll
                for (int n = 0; n < 2; ++n) acc[a][b][m][n] = (f32x4){0.f, 0.f, 0.f, 0.f};
    bf16x8 At[4][2], B0[2][2], B1[2][2];
    const char* cA = GATHER ? (const char*)g.A : (const char*)g.A + (size_t)cur.pm * tstep;
    const char* cB = (const char*)g.Bt + (size_t)cur.e * g.bstride + (size_t)cur.pn * tstep;
    S.a_ready(cur);
    if constexpr (GATHER) { S.load_goff(cur, goff, RA, CA); }
    PG8_STAGE(PG8_SB(0, 0), cB, voffB); PG8_STAGE(PG8_SB(0, 1), cB + hstep, voffB); PG8_STAGE_A(PG8_SA(0, 0), cA, 0, 0); PG8_STAGE_A(PG8_SA(0, 1), cA, 0, 1);
    if (wr == 1) PG8_BAR;
    PG8_WAIT_V(2); PG8_BAR;
    PG8_STAGE(PG8_SB(1, 0), cB + kstep, voffB); PG8_STAGE_A(PG8_SA(1, 0), cA, kstep, 0); PG8_STAGE(PG8_SB(1, 1), cB + hstep + kstep, voffB);
    PG8_WAIT_V(6); PG8_BAR;
    for (;;) {
        const bool has_next = S.next(ui + 1, nxt);
        const char* nA = GATHER ? cA : (has_next ? (const char*)g.A + (size_t)nxt.pm * tstep : cA);
        const char* nB = has_next ? (const char*)g.Bt + (size_t)nxt.e * g.bstride + (size_t)nxt.pn * tstep : cB;
        for (int t = 0; t < nt; t += 2) {
            const bool last = (t == nt - 2);
            const size_t kb1 = (size_t)(t + 1) * kstep;
            const char* a2 = last ? nA : cA; const size_t kb2 = last ? 0 : (size_t)(t + 2) * kstep; const char* b2 = last ? nB : cB + (size_t)(t + 2) * kstep;
            const size_t kb3 = kb2 + kstep; const char* b3 = b2 + kstep;
            if (last && has_next) S.a_ready(nxt);
            PG8_LDB(B0, 0, 0); PG8_LDB(B1, 0, 1); PG8_SCHED; PG8_LDA(At, 0, 0); PG8_STAGE_A(PG8_SA(1, 1), cA, kb1, 1);
            PG8_WAIT_V(8); PG8_WAIT_L(0); PG8_BAR; PG8_MMA(0, 0, At, B0); PG8_MMA(0, 1, At, B1); PG8_BAR; PG8_SCHED;
            if constexpr (GATHER) { if (last && has_next) S.load_goff(nxt, goff, RA, CA); }
            if (!cur.hf) { PG8_LDA(At, 0, 1); } PG8_STAGE(PG8_SB(0, 0), b2, voffB); PG8_STAGE(PG8_SB(0, 1), b2 + hstep, voffB); PG8_STAGE_A(PG8_SA(0, 0), a2, kb2, 0);
            PG8_WAIT_V(8); PG8_WAIT_L(0); PG8_BAR; if (!cur.hf) { PG8_MMA(1, 0, At, B0); PG8_MMA(1, 1, At, B1); } PG8_BAR; PG8_SCHED;
            PG8_LDB(B0, 1, 0); PG8_LDB(B1, 1, 1); PG8_SCHED; PG8_LDA(At, 1, 0); PG8_STAGE_A(PG8_SA(0, 1), a2, kb2, 1);
            PG8_WAIT_V(8); PG8_WAIT_L(0); PG8_BAR; PG8_MMA(0, 0, At, B0); PG8_MMA(0, 1, At, B1); PG8_BAR; PG8_SCHED;
            if (!cur.hf) { PG8_LDA(At, 1, 1); } PG8_STAGE(PG8_SB(1, 0), b3, voffB); PG8_STAGE(PG8_SB(1, 1), b3 + hstep, voffB); PG8_STAGE_A(PG8_SA(1, 0), a2, kb3, 0);
            PG8_WAIT_V(8); PG8_WAIT_L(0); PG8_BAR; if (!cur.hf) { PG8_MMA(1, 0, At, B0); PG8_MMA(1, 1, At, B1); } PG8_BAR; PG8_SCHED;
        }
        if constexpr (ALIGN_EPI) { if (wr == 0) PG8_BAR; }
        E(acc, cur, wr, wc, fr, fq); S.done(cur);
        if (!has_next) break;
#pragma unroll
        for (int a = 0; a < 2; ++a)
#pragma unroll
            for (int b = 0; b < 2; ++b)
#pragma unroll
                for (int m = 0; m < 4; ++m)
#pragma unroll
                    for (int n = 0; n < 2; ++n) acc[a][b][m][n] = (f32x4){0.f, 0.f, 0.f, 0.f};
        cur = nxt; cA = nA; cB = nB; ++ui;
        if constexpr (ALIGN_EPI) { if (wr == 1) PG8_BAR; }
    }
    PG8_WAIT_V(0);
    if constexpr (!ALIGN_EPI) { if (wr == 0) PG8_BAR; }
    PG8_BAR;
#undef PG8_SA
#undef PG8_SB
#undef PG8_STAGE
#undef PG8_STAGE_A
#undef PG8_LDA
#undef PG8_LDB
#undef PG8_MMA
#undef PG8_WAIT_V
#undef PG8_WAIT_L
#undef PG8_BAR
#undef PG8_SCHED
}
}

struct EpiProj {
    static constexpr bool PERM = true;
    bf16_t* O; float* dtraw; const float* qg; const float* kg; const float* rope;
    __device__ __forceinline__ void operator()(const f32x4 (&acc)[2][2][4][2], const pg8::Unit& u, int wr, int wc, int fr, int fq) const {
        const int row0 = u.pm * 256 + wr * 64 + fr, col0 = u.pn * 256 + wc * 32 + 8 * fq;
        if (u.pn < 8) {
            const float* gp = (u.pn < 4 ? qg : kg) + 4 * fq; const float sc = u.pn < 4 ? 0.125f * LOG2E : 1.f;
            f32x4 gn[2][2];
#pragma unroll
            for (int bj = 0; bj < 2; ++bj)
#pragma unroll
                for (int n = 0; n < 2; ++n) gn[bj][n] = *(const f32x4*)(gp + 32 * n + 16 * bj);
#pragma unroll
            for (int ai = 0; ai < 2; ++ai)
#pragma unroll
                for (int m = 0; m < 4; ++m) { const int row = row0 + ai * 128 + m * 16;
                    float ss = 0.f;
#pragma unroll
                    for (int bj = 0; bj < 2; ++bj)
#pragma unroll
                        for (int n = 0; n < 2; ++n) { const f32x4 v = acc[ai][bj][m][n]; ss += (v[0] * v[0] + v[1] * v[1]) + (v[2] * v[2] + v[3] * v[3]); }
                    ss += __shfl_xor(ss, 16); ss += __shfl_xor(ss, 32);
                    const float rstd = rsqrtf(ss * (1.f / 64.f) + RMS_EPS);
                    bf16_t* rowp = O + (size_t)row * NPROJ_PAD + col0; const float* rp = rope + (size_t)row * 64 + 8 * fq;
#pragma unroll
                    for (int bj = 0; bj < 2; ++bj) { const f32x4 c0 = *(const f32x4*)(rp + 32 * bj), c1 = *(const f32x4*)(rp + 32 * bj + 4);
                        const f32x4 t1 = acc[ai][bj][m][0] * rstd * gn[bj][0], t2 = acc[ai][bj][m][1] * rstd * gn[bj][1];
                        f32x4 o1, o2;
                        o1[0] = (t1[0] * c0[0] - t2[0] * c0[1]) * sc; o2[0] = (t1[0] * c0[1] + t2[0] * c0[0]) * sc;
                        o1[1] = (t1[1] * c0[2] - t2[1] * c0[3]) * sc; o2[1] = (t1[1] * c0[3] + t2[1] * c0[2]) * sc;
                        o1[2] = (t1[2] * c1[0] - t2[2] * c1[1]) * sc; o2[2] = (t1[2] * c1[1] + t2[2] * c1[0]) * sc;
                        o1[3] = (t1[3] * c1[2] - t2[3] * c1[3]) * sc; o2[3] = (t1[3] * c1[3] + t2[3] * c1[2]) * sc;
                        u32x4 w; w.x = pk2(o1[0], o1[1]); w.y = pk2(o1[2], o1[3]); w.z = pk2(o2[0], o2[1]); w.w = pk2(o2[2], o2[3]);
                        *(u32x4*)(rowp + bj * 128) = w; } }
            return;
        }
#pragma unroll
        for (int ai = 0; ai < 2; ++ai)
#pragma unroll
            for (int m = 0; m < 4; ++m) { bf16_t* rowp = O + (size_t)(row0 + ai * 128 + m * 16) * NPROJ_PAD + col0;
#pragma unroll
                for (int bj = 0; bj < 2; ++bj) { const f32x4 v0 = acc[ai][bj][m][0], v1 = acc[ai][bj][m][1];
                    u32x4 w; w.x = pk2(v0[0], v0[1]); w.y = pk2(v0[2], v0[3]); w.z = pk2(v1[0], v1[1]); w.w = pk2(v1[2], v1[3]);
                    *(u32x4*)(rowp + bj * 128) = w; } }
        if (u.pn == 22 && wc == 0) {
#pragma unroll
            for (int ai = 0; ai < 2; ++ai)
#pragma unroll
                for (int m = 0; m < 4; ++m) { float* p = dtraw + (size_t)(row0 + ai * 128 + m * 16) * 32 + 8 * fq;
                    *(f32x4*)p = acc[ai][0][m][0]; *(f32x4*)(p + 4) = acc[ai][0][m][1]; }
        }
    }
};
struct EpiOut {
    static constexpr bool PERM = true;
    const float* x; const float* mod; bf16_t* x1; float* rss;
    __device__ __forceinline__ void operator()(const f32x4 (&acc)[2][2][4][2], const pg8::Unit& u, int wr, int wc, int fr, int fq) const {
        const int row0 = u.pm * 256 + wr * 64 + fr, col0 = u.pn * 256 + wc * 32 + 8 * fq;
        const float* gp = mod + (size_t)(u.pm >= 32 ? 1 : 0) * 12288 + 2 * D + col0;
        f32x4 gv[2][2];
#pragma unroll
        for (int bj = 0; bj < 2; ++bj)
#pragma unroll
            for (int n = 0; n < 2; ++n) gv[bj][n] = *(const f32x4*)(gp + bj * 128 + n * 4);
        f32x4 xa[2][2][2], xb[2][2][2];
#define EO_LOAD(ch_, buf_) do { _Pragma("unroll") for (int mm = 0; mm < 2; ++mm) { const float* p_ = x + (size_t)(row0 + ((ch_) >> 1) * 128 + (2 * ((ch_) & 1) + mm) * 16) * D + col0; \
            _Pragma("unroll") for (int bj = 0; bj < 2; ++bj) { buf_[mm][bj][0] = __builtin_nontemporal_load((const f32x4*)(p_ + bj * 128)); buf_[mm][bj][1] = __builtin_nontemporal_load((const f32x4*)(p_ + bj * 128 + 4)); } } } while (0)
#define EO_PROC(ch_, buf_) do { _Pragma("unroll") for (int mm = 0; mm < 2; ++mm) { const int ai_ = (ch_) >> 1, m_ = 2 * ((ch_) & 1) + mm; const size_t off = (size_t)(row0 + ai_ * 128 + m_ * 16) * D + col0; float ss = 0.f; \
            _Pragma("unroll") for (int bj = 0; bj < 2; ++bj) { const f32x4 o0 = buf_[mm][bj][0] + gv[bj][0] * acc[ai_][bj][m_][0], o1 = buf_[mm][bj][1] + gv[bj][1] * acc[ai_][bj][m_][1]; \
                ss += (o0[0] * o0[0] + o0[1] * o0[1]) + (o0[2] * o0[2] + o0[3] * o0[3]) + (o1[0] * o1[0] + o1[1] * o1[1]) + (o1[2] * o1[2] + o1[3] * o1[3]); \
                u32x4 w; w.x = pk2(o0[0], o0[1]); w.y = pk2(o0[2], o0[3]); w.z = pk2(o1[0], o1[1]); w.w = pk2(o1[2], o1[3]); \
                *(u32x4*)(x1 + off + bj * 128) = w; } \
            ss += __shfl_xor(ss, 16); ss += __shfl_xor(ss, 32); \
            if (fq == 0) rss[(size_t)(row0 + ai_ * 128 + m_ * 16) * 32 + 4 * u.pn + wc] = ss; } } while (0)
        EO_LOAD(0, xa); EO_LOAD(1, xb); asm volatile("" ::: "memory");
        EO_PROC(0, xa); asm volatile("" ::: "memory"); EO_LOAD(2, xa); asm volatile("" ::: "memory");
        EO_PROC(1, xb); asm volatile("" ::: "memory"); EO_LOAD(3, xb); asm volatile("" ::: "memory");
        EO_PROC(2, xa); EO_PROC(3, xb);
#undef EO_LOAD
#undef EO_PROC
    }
};
struct EpiGU {
    static constexpr bool PERM = true;
    bf16_t* H;
    __device__ __forceinline__ void operator()(const f32x4 (&acc)[2][2][4][2], const pg8::Unit& u, int wr, int wc, int fr, int fq) const {
        const int row0 = u.pm * 256 + wr * 64 + fr, col0 = u.pn * 128 + wc * 16 + 4 * fq;
#pragma unroll
        for (int ai = 0; ai < 2; ++ai)
#pragma unroll
            for (int m = 0; m < 4; ++m) { bf16_t* rowp = H + (size_t)(row0 + ai * 128 + m * 16) * EH + col0;
#pragma unroll
                for (int bj = 0; bj < 2; ++bj) { const f32x4 gt = acc[ai][bj][m][0], up = acc[ai][bj][m][1];
                    u32x2 w; w.x = pk2(silu_f(gt[0]) * up[0], silu_f(gt[1]) * up[1]); w.y = pk2(silu_f(gt[2]) * up[2], silu_f(gt[3]) * up[3]);
                    *(u32x2*)(rowp + bj * 64) = w; } }
    }
};
struct EpiDown {
    static constexpr bool PERM = true;
    bf16_t* Y; const LAS int* tab;
    __device__ __forceinline__ void operator()(const f32x4 (&acc)[2][2][4][2], const pg8::Unit& u, int wr, int wc, int fr, int fq) const {
        const int col0 = u.pn * 256 + wc * 32 + 8 * fq;
        const LAS int* tb = tab + u.li * 512;
#pragma unroll
        for (int ai = 0; ai < 2; ++ai)
#pragma unroll
            for (int m = 0; m < 4; ++m) { const int r = ai * 128 + wr * 64 + m * 16 + fr; const int a = tb[2 * r]; const float gt = __int_as_float(tb[2 * r + 1]);
                if (a >= 0) { bf16_t* rowp = Y + (size_t)a * D + col0;
#pragma unroll
                    for (int bj = 0; bj < 2; ++bj) { const f32x4 v0 = acc[ai][bj][m][0] * gt, v1 = acc[ai][bj][m][1] * gt;
                        u32x4 w; w.x = pk2(v0[0], v0[1]); w.y = pk2(v0[2], v0[3]); w.z = pk2(v1[0], v1[1]); w.w = pk2(v1[2], v1[3]);
                        *(u32x4*)(rowp + bj * 128) = w; } } }
    }
};
struct MoeOrder {
    const LAS int* tilebase; int ntiles, npn, G, c; const LAS unsigned* goff_tab;
    __device__ __forceinline__ bool next(int i, pg8::Unit& u) const {
        const long L = (long)i * G + c; if (L >= (long)ntiles * npn) return false;
        const int tau = (int)(L / npn); u.pn = (int)(L % npn); u.pm = tau; u.li = i;
        int e = 0;
        for (int j = 1; j < NEXP; ++j) e += (tilebase[j] <= tau) ? 1 : 0;
        u.e = e; u.hf = __builtin_amdgcn_readfirstlane((tilebase[80 + e] - 256 * (tau - tilebase[e]) <= 128) ? 1 : 0); return true;
    }
    __device__ __forceinline__ void a_ready(const pg8::Unit&) const {}
    __device__ __forceinline__ void done(const pg8::Unit&) const {}
    __device__ __forceinline__ void load_goff(const pg8::Unit& u, unsigned (&goff)[2][2], const int (&RA)[2], const int (&CA)[2]) const {
        const LAS unsigned* tb = goff_tab + u.li * 256;
#pragma unroll
        for (int h = 0; h < 2; ++h)
#pragma unroll
            for (int i = 0; i < 2; ++i) goff[h][i] = tb[h * 128 + RA[i]] + (unsigned)CA[i] * 2u;
    }
};

struct Args { const void* in[24]; float* out; unsigned char* ws; int ph_lo, ph_hi; };
enum InIdx { I_X = 0, I_C, I_POS, I_WADA, I_BADA, I_N1G, I_WIN, I_CONVW, I_CONVB, I_DTBIAS, I_ALOG, I_DSKIP, I_SSDG, I_QG, I_KG, I_WOUT, I_N2G, I_WRG, I_BRG, I_WRE, I_BRE, I_WG, I_WU, I_WD };

__device__ __forceinline__ int vcu_id() { const int G = gridDim.x, bx = blockIdx.x; return (G % 8 == 0) ? (bx % 8) * (G / 8) + bx / 8 : bx; }
__device__ __forceinline__ float wave_sum(float v) {
#pragma unroll
    for (int o = 1; o < 64; o <<= 1) v += __shfl_xor(v, o);
    return v;
}

__device__ __forceinline__ void p0_adaln(const float* c, const float* w_ada, const float* b_ada, float* mod, LAS float* lds) {
    const int tid = threadIdx.x;
    LAS float* sc = lds; LAS float* red = lds + 4096;
    { const f32x4 c0 = *(const f32x4*)(c + 8 * tid), c1 = *(const f32x4*)(c + 8 * tid + 4);
#pragma unroll
      for (int j = 0; j < 4; ++j) { sc[8 * tid + j] = silu_f(c0[j]); sc[8 * tid + 4 + j] = silu_f(c1[j]); } }
    __syncthreads();
    for (int cg = blockIdx.x; cg < 256; cg += gridDim.x) {
        if (tid < 504) {
            const int c4 = tid % 12, r0 = tid / 12;
            f32x4 a0 = {0.f, 0.f, 0.f, 0.f}, a1 = {0.f, 0.f, 0.f, 0.f};
            const float* wp = w_ada + 48 * cg + 4 * c4;
#pragma unroll 7
            for (int k = r0; k < D; k += 42) { const f32x4 w = __builtin_nontemporal_load((const f32x4*)(wp + (size_t)k * 12288)); a0 += w * sc[k]; a1 += w * sc[D + k]; }
            LAS float* rp = red + (r0 * 12 + c4) * 8;
            rp[0] = a0[0]; rp[1] = a0[1]; rp[2] = a0[2]; rp[3] = a0[3]; rp[4] = a1[0]; rp[5] = a1[1]; rp[6] = a1[2]; rp[7] = a1[3];
        }
        __syncthreads();
        if (tid < 96) {
            const int c4 = tid >> 3, j = tid & 7; float s = 0.f;
            for (int r = 0; r < 42; ++r) s += red[(r * 12 + c4) * 8 + j];
            const int col = 48 * cg + 4 * c4 + (j & 3);
            mod[(j >> 2) * 12288 + col] = s + b_ada[col];
        }
        __syncthreads();
    }
}
template <class RowMap>
__device__ __forceinline__ void transpose_item(const float* W, int ldw, int nvalid, bf16_t* WT, int ldt, int k0, int n0, LAS float* scr, int lane, RowMap rm) {
#pragma unroll 4
    for (int it = 0; it < 16; ++it) {
        const int kk = 4 * it + (lane >> 4), n = n0 + 4 * (lane & 15);
        f32x4 v = {0.f, 0.f, 0.f, 0.f};
        if (n < nvalid) v = __builtin_nontemporal_load((const f32x4*)(W + (size_t)(k0 + kk) * ldw + n));
        LAS float* s = scr + kk * 65 + 4 * (lane & 15);
        s[0] = v[0]; s[1] = v[1]; s[2] = v[2]; s[3] = v[3];
    }
    LDS_WAIT(); asm volatile("" ::: "memory");
    const int c = lane & 7;
#pragma unroll
    for (int j = 0; j < 8; ++j) {
        const int nn = (lane >> 3) + 8 * j, n = n0 + nn;
        const LAS float* s = scr + (8 * c) * 65 + nn;
        u32x4 o; o.x = pk2(s[0], s[65]); o.y = pk2(s[2 * 65], s[3 * 65]); o.z = pk2(s[4 * 65], s[5 * 65]); o.w = pk2(s[6 * 65], s[7 * 65]);
        if (n < nvalid) *(u32x4*)(WT + (size_t)rm(n) * ldt + k0 + 8 * c) = o;
    }
    LDS_WAIT(); asm volatile("" ::: "memory");
}
struct RmId { __device__ __forceinline__ int operator()(int n) const { return n; } };
struct RmIn { __device__ __forceinline__ int operator()(int c) const { if (c >= 2048) return c; const int blk = c & ~1023, hd = (c >> 6) & 15, i = c & 63;
    return blk + 256 * (hd >> 2) + 128 * ((i >> 4) & 1) + 32 * (hd & 3) + 8 * ((i >> 2) & 3) + 4 * (i >> 5) + (i & 3); } };
struct RmGU { int add; __device__ __forceinline__ int operator()(int n) const { return 8 * (n >> 2) + add + (n & 3); } };

__device__ __forceinline__ void p0_prologue(const Args& A, LAS unsigned char* lds) {
    const int tid = threadIdx.x, lane = tid & 63, wave = tid >> 6;
    unsigned char* ws = A.ws;
    p0_adaln((const float*)A.in[I_C], (const float*)A.in[I_WADA], (const float*)A.in[I_BADA], (float*)(ws + WS_MOD), (LAS float*)lds);
    const int gtid = blockIdx.x * 512 + tid, NT = gridDim.x * 512;
    { const int* pos = (const int*)A.in[I_POS]; float* rope = (float*)(ws + WS_ROPE);
      const int f = gtid & 31; const float invf = powf(10000.0f, -(float)f / 32.0f);
      for (int t0 = gtid >> 5; t0 < T; t0 += 4 * (NT >> 5)) { int pv[4];
#pragma unroll
          for (int u = 0; u < 4; ++u) { const int t = t0 + u * (NT >> 5); pv[u] = pos[t < T ? t : T - 1]; }
#pragma unroll
          for (int u = 0; u < 4; ++u) { const int t = t0 + u * (NT >> 5); if (t < T) { const float ang = (float)pv[u] * invf;
              const double rev = (double)ang * 0.15915494309189533577; const float fr = (float)(rev - rint(rev));
              f32x2 cs = {__builtin_amdgcn_cosf(fr), __builtin_amdgcn_sinf(fr)}; *(f32x2*)(rope + 2 * (t * 32 + f)) = cs; } } } }
    { const float* wrg = (const float*)A.in[I_WRG]; const float* wre = (const float*)A.in[I_WRE]; bf16_t* hi = (bf16_t*)(ws + WS_WRT);
      for (int i = gtid; i < NRT * D; i += NT) { const int n = i / D, k = i % D; float w = 0.f;
          if (n < 8) w = wrg[k * 8 + n]; else if (n >= 16) w = wre[k * 64 + (n - 16)];
          hi[i] = (bf16_t)f2bf(w); } }
    { u32x4* z = (u32x4*)(ws + WS_WINT + (size_t)NPROJ * D * 2); const int n16 = (NPROJ_PAD - NPROJ) * D * 2 / 16;
      for (int i = gtid; i < n16; i += NT) z[i] = (u32x4){0u, 0u, 0u, 0u}; }
    __syncthreads();
    LAS float* scr = (LAS float*)(lds) + wave * (64 * 65);
    const int gw = blockIdx.x * 8 + wave, NGW = gridDim.x * 8;
    constexpr int I_IN = 32 * 89;
    const float* W = (const float*)A.in[I_WIN]; bf16_t* WT = (bf16_t*)(ws + WS_WINT);
    f32x4 va[16], vb[16];
#define WIN_LOAD(it_, v_) do { const int k0_ = 64 * ((it_) / 89), n_ = 64 * ((it_) % 89) + 4 * (lane & 15); const float* p_ = W + (size_t)(k0_ + (lane >> 4)) * NPROJ + (n_ < NPROJ ? n_ : NPROJ - 4); \
        _Pragma("unroll") for (int i_ = 0; i_ < 16; ++i_) v_[i_] = __builtin_nontemporal_load((const f32x4*)(p_ + (size_t)(4 * i_) * NPROJ)); } while (0)
#define WIN_STORE(it_, v_) do { const int k0_ = 64 * ((it_) / 89), n0_ = 64 * ((it_) % 89); \
        _Pragma("unroll") for (int i_ = 0; i_ < 16; ++i_) { LAS float* sp_ = scr + (4 * i_ + (lane >> 4)) * 65 + 4 * (lane & 15); sp_[0] = v_[i_][0]; sp_[1] = v_[i_][1]; sp_[2] = v_[i_][2]; sp_[3] = v_[i_][3]; } \
        LDS_WAIT(); asm volatile("" ::: "memory"); const int c_ = lane & 7; \
        _Pragma("unroll") for (int j_ = 0; j_ < 8; ++j_) { const int nn_ = (lane >> 3) + 8 * j_, n_ = n0_ + nn_; const LAS float* sp_ = scr + (8 * c_) * 65 + nn_; \
            u32x4 o_; o_.x = pk2(sp_[0], sp_[65]); o_.y = pk2(sp_[2 * 65], sp_[3 * 65]); o_.z = pk2(sp_[4 * 65], sp_[5 * 65]); o_.w = pk2(sp_[6 * 65], sp_[7 * 65]); \
            if (n_ < NPROJ) *(u32x4*)(WT + (size_t)RmIn{}(n_) * D + k0_ + 8 * c_) = o_; } \
        LDS_WAIT(); asm volatile("" ::: "memory"); } while (0)
    int it = gw;
    if (it < I_IN) WIN_LOAD(it, va);
    while (it < I_IN) {
        const bool hb = it + NGW < I_IN;
        if (hb) WIN_LOAD(it + NGW, vb);
        WIN_STORE(it, va);
        if (!hb) break;
        const bool ha = it + 2 * NGW < I_IN;
        if (ha) WIN_LOAD(it + 2 * NGW, va);
        WIN_STORE(it + NGW, vb);
        if (!ha) break;
        it += 2 * NGW;
    }
#undef WIN_LOAD
#undef WIN_STORE
}
struct TItem { const float* src; bf16_t* dst; int ldw, ldt, gu, n0; };
__device__ __forceinline__ void late_item(const Args& A, int it, TItem& d) {
    unsigned char* ws = A.ws;
    constexpr int I_OUT = 32 * 32, I_E = 32 * 8, I_DN = 8 * 32;
    int r = it;
    if (r < I_OUT) { const int k0 = 64 * (r / 32), n0 = 64 * (r % 32); d.src = (const float*)A.in[I_WOUT] + (size_t)k0 * D + n0; d.dst = (bf16_t*)(ws + WS_WOUTT) + k0; d.ldw = D; d.ldt = D; d.gu = -1; d.n0 = n0; return; }
    r -= I_OUT;
    const int e = r / (2 * I_E + I_DN); r -= e * (2 * I_E + I_DN);
    if (r < 2 * I_E) { const int up = r >= I_E ? 1 : 0; r -= up * I_E; const int k0 = 64 * (r / 8), n0 = 64 * (r % 8);
        d.src = (const float*)A.in[up ? I_WU : I_WG] + (size_t)e * D * EH + (size_t)k0 * EH + n0; d.dst = (bf16_t*)(ws + WS_WGUT) + (size_t)e * 1024 * D + k0; d.ldw = EH; d.ldt = D; d.gu = 4 * up; d.n0 = n0; return; }
    r -= 2 * I_E;
    { const int k0 = 64 * (r / 32), n0 = 64 * (r % 32); d.src = (const float*)A.in[I_WD] + (size_t)e * EH * D + (size_t)k0 * D + n0; d.dst = (bf16_t*)(ws + WS_WDT) + (size_t)e * D * EH + k0; d.ldw = D; d.ldt = EH; d.gu = -1; d.n0 = n0; }
}
__device__ __forceinline__ void titem_load(const TItem& d, f32x4 (&v)[16], int lane) {
    const float* p = d.src + (size_t)(lane >> 4) * d.ldw + 4 * (lane & 15);
#pragma unroll
    for (int i = 0; i < 16; ++i) v[i] = __builtin_nontemporal_load((const f32x4*)(p + (size_t)(4 * i) * d.ldw));
}
__device__ __forceinline__ void titem_store(const TItem& d, const f32x4 (&v)[16], LAS float* scr, int lane) {
#pragma unroll
    for (int i = 0; i < 16; ++i) { LAS float* sp = scr + (4 * i + (lane >> 4)) * 65 + 4 * (lane & 15); sp[0] = v[i][0]; sp[1] = v[i][1]; sp[2] = v[i][2]; sp[3] = v[i][3]; }
    LDS_WAIT(); asm volatile("" ::: "memory");
    const int c = lane & 7;
#pragma unroll
    for (int j = 0; j < 8; ++j) { const int nn = (lane >> 3) + 8 * j, n = d.n0 + nn; const LAS float* sp = scr + (8 * c) * 65 + nn;
        u32x4 o; o.x = pk2(sp[0], sp[65]); o.y = pk2(sp[2 * 65], sp[3 * 65]); o.z = pk2(sp[4 * 65], sp[5 * 65]); o.w = pk2(sp[6 * 65], sp[7 * 65]);
        const int row = d.gu < 0 ? n : (8 * (n >> 2) + d.gu + (n & 3));
        __builtin_nontemporal_store(o, (u32x4*)(d.dst + (size_t)row * d.ldt + 8 * c)); }
    LDS_WAIT(); asm volatile("" ::: "memory");
}
__device__ __forceinline__ int claim_items(unsigned* ctr, unsigned n) { unsigned v = 0; if ((threadIdx.x & 63) == 0) v = __hip_atomic_fetch_add(ctr, n, __ATOMIC_RELAXED, __HIP_MEMORY_SCOPE_AGENT); return (int)__builtin_amdgcn_readfirstlane(v); }
__device__ __forceinline__ void p2_convert_late(const Args& A, LAS unsigned char* lds) {
    const int lane = threadIdx.x & 63, wave = threadIdx.x >> 6;
    LAS float* scr = (LAS float*)(lds) + wave * (64 * 65);
    unsigned* ctr = (unsigned*)(A.ws + WS_CTL) + CW_FLAG + 64;
    constexpr int NITEMS = 32 * 32 + NEXP * (2 * 32 * 8 + 8 * 32), CB = 16;
    int base = claim_items(ctr, CB), pos = 0;
#define CONV_NEXT() ({ if (pos == CB) { base = claim_items(ctr, CB); pos = 0; } const int r_ = base + pos; ++pos; r_; })
#define CONV_PROC(d_, v_, itn_) do { \
        _Pragma("unroll") for (int i = 0; i < 16; ++i) { LAS float* sp = scr + (4 * i + (lane >> 4)) * 65 + 4 * (lane & 15); sp[0] = v_[i][0]; sp[1] = v_[i][1]; sp[2] = v_[i][2]; sp[3] = v_[i][3]; } \
        const TItem dc_ = d_; late_item(A, (itn_) < NITEMS ? (itn_) : NITEMS - 1, d_); titem_load(d_, v_, lane); \
        LDS_WAIT(); asm volatile("" ::: "memory"); \
        const int c = lane & 7; \
        _Pragma("unroll") for (int j = 0; j < 8; ++j) { const int nn = (lane >> 3) + 8 * j, n = dc_.n0 + nn; const LAS float* sp = scr + (8 * c) * 65 + nn; \
            u32x4 o; o.x = pk2(sp[0], sp[65]); o.y = pk2(sp[2 * 65], sp[3 * 65]); o.z = pk2(sp[4 * 65], sp[5 * 65]); o.w = pk2(sp[6 * 65], sp[7 * 65]); \
            const int row = dc_.gu < 0 ? n : (8 * (n >> 2) + dc_.gu + (n & 3)); \
            __builtin_nontemporal_store(o, (u32x4*)(dc_.dst + (size_t)row * dc_.ldt + 8 * c)); } \
        LDS_WAIT(); asm volatile("" ::: "memory"); } while (0)
    TItem da, db; f32x4 va[16], vb[16];
    int ia = CONV_NEXT(), ib = CONV_NEXT();
    late_item(A, ia < NITEMS ? ia : NITEMS - 1, da); titem_load(da, va, lane);
    late_item(A, ib < NITEMS ? ib : NITEMS - 1, db); titem_load(db, vb, lane);
#pragma unroll 1
    for (;;) {
        if (ia >= NITEMS) break;
        { const int in = CONV_NEXT(); CONV_PROC(da, va, in); ia = in; }
        if (ib >= NITEMS) break;
        { const int in = CONV_NEXT(); CONV_PROC(db, vb, in); ib = in; }
    }
#undef CONV_NEXT
#undef CONV_PROC
}

__device__ __forceinline__ void p1_norm1(const Args& A) {
    const int tid = threadIdx.x, lane = tid & 63, wave = tid >> 6;
    const float* x = (const float*)A.in[I_X]; const float* g1 = (const float*)A.in[I_N1G]; const float* mod = (const float*)(A.ws + WS_MOD);
    bf16_t* hb = (bf16_t*)(A.ws + WS_HB);
    const int gw = blockIdx.x * 8 + wave, NGW = gridDim.x * 8, NB = NGW / BATCH, bsel = gw / NB, r0 = gw - bsel * NB;
    if (bsel >= BATCH) return;
    const float* mb = mod + bsel * 12288;
    f32x4 ca[8], cs[8];
#pragma unroll
    for (int j = 0; j < 8; ++j) { const int col = 4 * lane + 256 * j; const f32x4 g = *(const f32x4*)(g1 + col), sc = *(const f32x4*)(mb + D + col); ca[j] = g * (sc + 1.f); cs[j] = *(const f32x4*)(mb + col); }
    f32x4 v[8], vn[8];
    if (r0 < SEQ) { const f32x4* xr = (const f32x4*)(x + (size_t)(bsel * SEQ + r0) * D) + lane;
#pragma unroll
        for (int j = 0; j < 8; ++j) vn[j] = __builtin_nontemporal_load(xr + 64 * j); }
    for (int r = r0; r < SEQ; r += NB) { const int m = bsel * SEQ + r;
#pragma unroll
        for (int j = 0; j < 8; ++j) v[j] = vn[j];
        if (r + NB < SEQ) { const f32x4* xr = (const f32x4*)(x + (size_t)(m + NB) * D) + lane;
#pragma unroll
            for (int j = 0; j < 8; ++j) vn[j] = __builtin_nontemporal_load(xr + 64 * j); }
        float s = 0.f;
#pragma unroll
        for (int j = 0; j < 8; ++j) s += (v[j][0] * v[j][0] + v[j][1] * v[j][1]) + (v[j][2] * v[j][2] + v[j][3] * v[j][3]);
        const float rstd = rsqrtf(wave_sum(s) * (1.f / D) + RMS_EPS);
        u32x2* o = (u32x2*)(hb + (size_t)m * D) + lane;
#pragma unroll
        for (int j = 0; j < 8; ++j) { const f32x4 h = (v[j] * rstd) * ca[j] + cs[j];
            u32x2 w; w.x = pk2(h[0], h[1]); w.y = pk2(h[2], h[3]); o[64 * j] = w; }
    }
}

__device__ __forceinline__ void p3_post(const Args& A, int dryA, int repB) {
    const int tid = threadIdx.x, lane = tid & 63, wave = tid >> 6;
    unsigned char* ws = A.ws;
    bf16_t* proj = (bf16_t*)(ws + WS_PROJ);
    const int gw = blockIdx.x * 8 + wave, NGW = gridDim.x * 8;
    for (int rb = 0; rb < repB; ++rb) { const float* cw = (const float*)A.in[I_CONVW]; const float* cb = (const float*)A.in[I_CONVB]; bf16_t* xc = (bf16_t*)(ws + WS_HB);
      for (int tb = gw; tb < T / 8; tb += NGW) {
          const int t0 = tb * 8, s0 = t0 & (SEQ - 1), sb = t0 - s0;
          u32x4 ra[12]; f32x4 wa[5], wb[5], ba, bb;
#define P3_LOAD(c8_, r_, wa_, wb_, ba_, bb_) do { const bf16_t* pc_ = proj + OFF_XBC + (c8_); \
              _Pragma("unroll") for (int k = 0; k < 12; ++k) { int t_ = t0 + k - 2; t_ = t_ < sb ? sb : t_; t_ = t_ > sb + SEQ - 1 ? sb + SEQ - 1 : t_; r_[k] = *(const u32x4*)(pc_ + (size_t)t_ * NPROJ_PAD); } \
              _Pragma("unroll") for (int k = 0; k < 5; ++k) { wa_[k] = *(const f32x4*)(cw + k * XBCW + (c8_)); wb_[k] = *(const f32x4*)(cw + k * XBCW + (c8_) + 4); } \
              ba_ = *(const f32x4*)(cb + (c8_)); bb_ = *(const f32x4*)(cb + (c8_) + 4); } while (0)
#pragma unroll 1
          for (int st = 0; st < 3; ++st) { const int c8 = 8 * (lane + 64 * st);
              P3_LOAD(c8, ra, wa, wb, ba, bb);
              if (s0 == 0) { ra[0] = (u32x4){0u, 0u, 0u, 0u}; ra[1] = (u32x4){0u, 0u, 0u, 0u}; }
              if (s0 == SEQ - 8) { ra[10] = (u32x4){0u, 0u, 0u, 0u}; ra[11] = (u32x4){0u, 0u, 0u, 0u}; }
#pragma unroll
              for (int j = 0; j < 8; ++j) {
                  f32x4 a0 = ba, a1 = bb;
#pragma unroll
                  for (int k = 0; k < 5; ++k) { const u32x4 w = ra[j + k];
                      a0[0] += lo_f(w.x) * wa[k][0]; a0[1] += hi_f(w.x) * wa[k][1]; a0[2] += lo_f(w.y) * wa[k][2]; a0[3] += hi_f(w.y) * wa[k][3];
                      a1[0] += lo_f(w.z) * wb[k][0]; a1[1] += hi_f(w.z) * wb[k][1]; a1[2] += lo_f(w.w) * wb[k][2]; a1[3] += hi_f(w.w) * wb[k][3]; }
                  u32x4 o; o.x = pk2(silu_f(a0[0]), silu_f(a0[1])); o.y = pk2(silu_f(a0[2]), silu_f(a0[3])); o.z = pk2(silu_f(a1[0]), silu_f(a1[1])); o.w = pk2(silu_f(a1[2]), silu_f(a1[3]));
                  *(u32x4*)(xc + (size_t)(t0 + j) * XBCW + c8) = o; }
          }
#undef P3_LOAD
      } }
    { const float* dtraw = (const float*)(ws + WS_DTRAW); const float* dtbias = (const float*)A.in[I_DTBIAS]; const float* alog = (const float*)A.in[I_ALOG];
      float* dtf = (float*)(ws + WS_DTF); float* dtb = (float*)(ws + WS_DTB); float* acs = (float*)(ws + WS_ACS); float* rcs = (float*)(ws + WS_RCS); float* dec = (float*)(ws + WS_DEC);
      const int h = lane & 15, q = lane >> 4;
      for (int it = gw; it < BATCH * NCHUNK * 2; it += NGW) {
          const int dir = it & 1, bc = it >> 1; const int t0 = bc * CHUNK + 32 * q;
          const float aneg = -__expf(alog[dir * 16 + h]), bias = dtbias[dir * 16 + h];
          float d[32];
#pragma unroll
          for (int i = 0; i < 32; ++i) d[i] = dtraw[(size_t)(t0 + i) * 32 + dir * 16 + h];
          float tot = 0.f;
#pragma unroll
          for (int i = 0; i < 32; ++i) { const float r = d[i] + bias; d[i] = r > 20.f ? r : log1pf(__expf(r)); tot += d[i] * aneg; }
          const float t1 = __shfl_xor(tot, 16), t2 = __shfl_xor(tot, 32), t3 = __shfl_xor(tot, 48);
          float tq[4]; tq[q] = tot; tq[q ^ 1] = t1; tq[q ^ 2] = t2; tq[q ^ 3] = t3;
          float base = 0.f;
          if (dir == 0) { for (int j = 0; j < 4; ++j) if (j < q) base += tq[j]; } else { for (int j = 0; j < 4; ++j) if (j > q) base += tq[j]; }
          float* dd = dir ? dtb : dtf; float* cc = dir ? rcs : acs;
          if (dir == 0) { float run = base;
#pragma unroll
              for (int i = 0; i < 32; ++i) { run += d[i] * aneg; dd[(size_t)(t0 + i) * 16 + h] = d[i]; cc[(size_t)(t0 + i) * 16 + h] = run; } }
          else { float run = base;
#pragma unroll
              for (int i = 31; i >= 0; --i) { run += d[i] * aneg; dd[(size_t)(t0 + i) * 16 + h] = d[i]; cc[(size_t)(t0 + i) * 16 + h] = run; } }
          if (q == 0) dec[bc * 32 + dir * 16 + h] = __expf(tq[0] + tq[1] + tq[2] + tq[3]);
      } }
}

__device__ __forceinline__ bf16x8 mk_frag(u32x4 w) { return __builtin_bit_cast(bf16x8, w); }
__device__ __forceinline__ f32x4 mfma16(bf16x8 a, bf16x8 b, f32x4 c) { return __builtin_amdgcn_mfma_f32_16x16x32_bf16(a, b, c, 0, 0, 0); }

typedef short v4i16_t __attribute__((ext_vector_type(4)));
__device__ __forceinline__ u32x2 lds_tr16(const LAS bf16_t* p) { return __builtin_bit_cast(u32x2, __builtin_amdgcn_ds_read_tr16_b64_v4i16((LAS v4i16_t*)p)); }
__device__ __forceinline__ bf16x8 lds_tr16x2(const LAS bf16_t* p, int rowstep4) { const u32x2 a = lds_tr16(p), b = lds_tr16(p + rowstep4); u32x4 w; w.x = a.x; w.y = a.y; w.z = b.x; w.w = b.y; return mk_frag(w); }

constexpr int SP = 136;
constexpr int XP = 72;
__device__ __forceinline__ void p4_ssd_local(const Args& A, LAS unsigned char* lds, int rep) {
    const int tid = threadIdx.x, lane = tid & 63, w = __builtin_amdgcn_readfirstlane(tid >> 6), fr = lane & 15, fq = lane >> 4;
    unsigned char* ws = A.ws;
    const bf16_t* xc = (const bf16_t*)(ws + WS_HB);
    const float* DTF = (const float*)(ws + WS_DTF); const float* DTB = (const float*)(ws + WS_DTB); const float* ACS = (const float*)(ws + WS_ACS); const float* RCS = (const float*)(ws + WS_RCS);
    bf16_t* YD = (bf16_t*)(ws + WS_YD); bf16_t* ST = (bf16_t*)(ws + WS_ST);
    LAS bf16_t* Cs = (LAS bf16_t*)lds; LAS bf16_t* Bs = (LAS bf16_t*)(lds + 34816);
    LAS bf16_t* Xs = (LAS bf16_t*)(lds + 69632);
    LAS float* VEC = (LAS float*)(lds + 69632 + 36864);
    const int sl = tid >> 2, sq = tid & 3;
    for (int uu = vcu_id(); uu < BATCH * NCHUNK * 2 * rep; uu += gridDim.x) { const int u = uu & 255;
        const int b = u >> 7, c = (u >> 1) & 63, g = u & 1; const int t0 = b * SEQ + c * CHUNK;
        u32x4 xv[2]; float vv[6];
#define P4_XLOAD(h_) do { const bf16_t* src_ = xc + (size_t)(t0 + sl) * XBCW + 64 * (h_) + 16 * sq; xv[0] = *(const u32x4*)src_; xv[1] = *(const u32x4*)(src_ + 8); \
            if (tid < 128) { const size_t o_ = (size_t)(t0 + tid) * 16 + (h_); vv[0] = DTF[o_]; vv[1] = DTB[o_]; vv[2] = ACS[o_]; vv[3] = RCS[o_]; vv[4] = ACS[(size_t)(t0 + 127) * 16 + (h_)]; vv[5] = RCS[(size_t)t0 * 16 + (h_)]; } } while (0)
#define P4_XSTORE(buf_) do { *(LAS u32x4*)(Xs + (buf_) * (128 * XP) + sl * XP + 16 * sq) = xv[0]; *(LAS u32x4*)(Xs + (buf_) * (128 * XP) + sl * XP + 16 * sq + 8) = xv[1]; \
            if (tid < 128) { LAS float* v_ = VEC + (buf_) * 768; v_[tid] = vv[0]; v_[128 + tid] = vv[1]; v_[256 + tid] = vv[2]; v_[384 + tid] = vv[3]; v_[512 + tid] = __expf(vv[4] - vv[2]) * vv[0]; v_[640 + tid] = __expf(vv[5] - vv[3]) * vv[1]; } } while (0)
        { const bf16_t* src = xc + (size_t)(t0 + sl) * XBCW + 1024 + 128 * g + 32 * sq;
#pragma unroll
          for (int i = 0; i < 4; ++i) { *(LAS u32x4*)(Bs + sl * SP + 32 * sq + 8 * i) = *(const u32x4*)(src + 8 * i); *(LAS u32x4*)(Cs + sl * SP + 32 * sq + 8 * i) = *(const u32x4*)(src + 256 + 8 * i); } }
        P4_XLOAD(8 * g);
        __syncthreads();
        { bf16x8 cf[4];
#pragma unroll
          for (int ks = 0; ks < 4; ++ks) cf[ks] = *(const LAS bf16x8*)(Cs + (16 * w + fr) * SP + 32 * ks + 8 * fq);
          u32x2 cbw[8];
#pragma unroll
          for (int st = 0; st < 8; ++st) { f32x4 acc = {0.f, 0.f, 0.f, 0.f};
#pragma unroll
              for (int ks = 0; ks < 4; ++ks) acc = mfma16(*(const LAS bf16x8*)(Bs + (16 * st + fr) * SP + 32 * ks + 8 * fq), cf[ks], acc);
              cbw[st].x = pk2(acc[0], acc[1]); cbw[st].y = pk2(acc[2], acc[3]); }
#pragma unroll
          for (int st = 0; st < 8; ++st) *(LAS u32x2*)(Cs + (16 * w + fr) * SP + 16 * st + 4 * fq) = cbw[st]; }
        bf16x8 btf[4];
#pragma unroll
        for (int ks = 0; ks < 4; ++ks) btf[ks] = lds_tr16x2(Bs + (32 * ks + 8 * fq + (fr >> 2)) * SP + 16 * w + 4 * (fr & 3), 4 * SP);
        P4_XSTORE(0);
        __syncthreads();
        for (int hh = 0; hh < 8; ++hh) {
            const int h = 8 * g + hh, buf = hh & 1;
            if (hh < 7) P4_XLOAD(h + 1);
            const LAS bf16_t* Xb = Xs + buf * (128 * XP); const LAS float* V = VEC + buf * 768;
            { const int l = 16 * w + fr; const float ac_l = V[256 + l], rc_l = V[384 + l];
              f32x4 acc[4], sf[4], sb[4];
#pragma unroll
              for (int pt = 0; pt < 4; ++pt) { acc[pt] = (f32x4){0.f, 0.f, 0.f, 0.f}; sf[pt] = (f32x4){0.f, 0.f, 0.f, 0.f}; sb[pt] = (f32x4){0.f, 0.f, 0.f, 0.f}; }
#pragma unroll
              for (int ks = 0; ks < 4; ++ks) { const int s0 = 32 * ks + 8 * fq;
                  bf16x8 xf[4];
#pragma unroll
                  for (int pt = 0; pt < 4; ++pt) xf[pt] = lds_tr16x2(Xb + (s0 + (fr >> 2)) * XP + 16 * pt + 4 * (fr & 3), 4 * XP);
                  const u32x4 cb = *(const LAS u32x4*)(Cs + l * SP + s0); const unsigned cw[4] = {cb.x, cb.y, cb.z, cb.w};
                  f32x4 vd[6][2];
#pragma unroll
                  for (int a = 0; a < 6; ++a) { vd[a][0] = *(const LAS f32x4*)(V + 128 * a + s0); vd[a][1] = *(const LAS f32x4*)(V + 128 * a + s0 + 4); }
                  float mv[8];
#pragma unroll
                  for (int j = 0; j < 8; ++j) { const int s = s0 + j; const float cbj = (j & 1) ? hi_f(cw[j >> 1]) : lo_f(cw[j >> 1]);
                      const float df = vd[0][j >> 2][j & 3], db = vd[1][j >> 2][j & 3], ac = vd[2][j >> 2][j & 3], rc = vd[3][j >> 2][j & 3];
                      const float arg = (s < l) ? (ac_l - ac) : (rc_l - rc);
                      const float wg = (s < l) ? df : ((s > l) ? db : df + db);
                      mv[j] = cbj * __expf(arg) * wg; }
                  u32x4 mw; mw.x = pk2(mv[0], mv[1]); mw.y = pk2(mv[2], mv[3]); mw.z = pk2(mv[4], mv[5]); mw.w = pk2(mv[6], mv[7]);
                  const bf16x8 mfr = mk_frag(mw);
#pragma unroll
                  for (int pt = 0; pt < 4; ++pt) acc[pt] = mfma16(xf[pt], mfr, acc[pt]);
                  bf16x8 bff, bfb;
                  { const u32x4 bw = __builtin_bit_cast(u32x4, btf[ks]);
                    const float b0 = lo_f(bw.x), b1 = hi_f(bw.x), b2 = lo_f(bw.y), b3 = hi_f(bw.y), b4 = lo_f(bw.z), b5 = hi_f(bw.z), b6 = lo_f(bw.w), b7 = hi_f(bw.w);
                    const f32x4 f0 = vd[4][0], f1 = vd[4][1], g0 = vd[5][0], g1 = vd[5][1];
                    u32x4 aw; aw.x = pk2(b0 * f0[0], b1 * f0[1]); aw.y = pk2(b2 * f0[2], b3 * f0[3]); aw.z = pk2(b4 * f1[0], b5 * f1[1]); aw.w = pk2(b6 * f1[2], b7 * f1[3]); bff = mk_frag(aw);
                    aw.x = pk2(b0 * g0[0], b1 * g0[1]); aw.y = pk2(b2 * g0[2], b3 * g0[3]); aw.z = pk2(b4 * g1[0], b5 * g1[1]); aw.w = pk2(b6 * g1[2], b7 * g1[3]); bfb = mk_frag(aw); }
#pragma unroll
                  for (int pt = 0; pt < 4; ++pt) { sf[pt] = mfma16(bff, xf[pt], sf[pt]); sb[pt] = mfma16(bfb, xf[pt], sb[pt]); } }
              bf16_t* stf = ST + ((size_t)(((b * NCHUNK + c) * 2) * 16 + h)) * 8192; bf16_t* stb = stf + (size_t)16 * 8192;
#pragma unroll
              for (int pt = 0; pt < 4; ++pt) { u32x2 o; o.x = pk2(acc[pt][0], acc[pt][1]); o.y = pk2(acc[pt][2], acc[pt][3]);
                  *(u32x2*)(YD + (size_t)(t0 + l) * 1024 + 64 * h + 16 * pt + 4 * fq) = o;
                  o.x = pk2(sf[pt][0], sf[pt][1]); o.y = pk2(sf[pt][2], sf[pt][3]); *(u32x2*)(stf + (16 * pt + fr) * 128 + 16 * w + 4 * fq) = o;
                  o.x = pk2(sb[pt][0], sb[pt][1]); o.y = pk2(sb[pt][2], sb[pt][3]); *(u32x2*)(stb + (16 * pt + fr) * 128 + 16 * w + 4 * fq) = o; } }
            if (hh < 7) P4_XSTORE(buf ^ 1);
            __syncthreads();
        }
#undef P4_XLOAD
#undef P4_XSTORE
    }
}

__device__ __forceinline__ void p5_scan(const Args& A) {
    bf16_t* ST = (bf16_t*)(A.ws + WS_ST); const float* DEC = (const float*)(A.ws + WS_DEC);
    const int gtid = blockIdx.x * 512 + threadIdx.x, NT = gridDim.x * 512;
    for (int i = gtid; i < BATCH * 2 * 16 * 2048; i += NT) {
        const int e4 = i & 2047, h = (i >> 11) & 15, dir = (i >> 15) & 1, b = i >> 16;
        f32x4 st = {0.f, 0.f, 0.f, 0.f};
        for (int cc = 0; cc < NCHUNK; cc += 16) {
            u32x2 v[16]; float dc[16];
#pragma unroll
            for (int j = 0; j < 16; ++j) { const int c = dir ? (NCHUNK - 1 - (cc + j)) : (cc + j);
                v[j] = *(const u32x2*)(ST + ((size_t)(((b * NCHUNK + c) * 2 + dir) * 16 + h)) * 8192 + 4 * e4); dc[j] = DEC[(b * NCHUNK + c) * 32 + dir * 16 + h]; }
#pragma unroll
            for (int j = 0; j < 16; ++j) { const int c = dir ? (NCHUNK - 1 - (cc + j)) : (cc + j);
                u32x2 o; o.x = pk2(st[0], st[1]); o.y = pk2(st[2], st[3]);
                *(u32x2*)(ST + ((size_t)(((b * NCHUNK + c) * 2 + dir) * 16 + h)) * 8192 + 4 * e4) = o;
                const f32x4 sv = {lo_f(v[j].x), hi_f(v[j].x), lo_f(v[j].y), hi_f(v[j].y)}; st = st * dc[j] + sv; }
        }
    }
}

constexpr int KP = 72;
struct AttnRun { int br, b, h, d, cls, blk0, nblk, n; };
__device__ __forceinline__ void attn_run(int su, int q, AttnRun& a) { const int bh = su >> 3, r8 = su & 7; a.b = bh >> 4; a.h = bh & 15;
    if (q == 0) { a.br = 0; a.cls = 0; a.blk0 = 8 * r8; a.nblk = 8; } else if (q == 1) { a.br = 1; a.cls = r8 >> 1; a.blk0 = 8 * (r8 & 1); a.nblk = 8; } else { a.br = 2; a.cls = 2 * r8 + (q - 2); a.blk0 = 0; a.nblk = 4; }
    a.d = 1 << (2 * a.br); a.n = SEQ >> (2 * a.br); }
template <bool MERGE>
__device__ __forceinline__ void attn_compute(const AttnRun& cur, int blk, int par, bf16x8 (&qf)[2], unsigned qoff, const unsigned char* projb, const LAS bf16_t* Ks, const LAS bf16_t* Vs, bf16_t* AO, float* ML, bf16_t* mix, int w, int fr, int fq) {
    const int qi = 128 * blk + 16 * w + fr; const unsigned tq = (unsigned)(cur.b * SEQ + cur.cls + cur.d * qi); const int n = cur.n;
    const unsigned char* AOb = (const unsigned char*)AO; const unsigned char* MLb = (const unsigned char*)ML; unsigned char* mixb = (unsigned char*)mix; unsigned char* AOw = (unsigned char*)AO; unsigned char* MLw = (unsigned char*)ML;
    f32x4 st[9];
    {
        bf16x8 kf[9][2];
        const LAS bf16_t* kb = Ks + fr * KP + 8 * fq;
#pragma unroll
        for (int kt = 0; kt < 9; ++kt) { const int Tt = w + kt; const int srow = (((par + (Tt >> 3)) & 1) << 7) + ((Tt & 7) << 4);
#pragma unroll
            for (int ks = 0; ks < 2; ++ks) kf[kt][ks] = *(const LAS bf16x8*)(kb + srow * KP + 32 * ks); }
        __builtin_amdgcn_sched_barrier(0);
#pragma unroll
        for (int kt = 0; kt < 9; ++kt) { const f32x4 z = {0.f, 0.f, 0.f, 0.f}; st[kt] = mfma16(kf[kt][0], qf[0], z); }
#pragma unroll
        for (int kt = 0; kt < 9; ++kt) st[kt] = mfma16(kf[kt][1], qf[1], st[kt]);
        __builtin_amdgcn_sched_barrier(0);
    }
#pragma unroll
    for (int ks = 0; ks < 2; ++ks) qf[ks] = *(const bf16x8*)(projb + qoff + 256 * ks);
    f32x2 pm0 = {0.f, 0.f}, pm1 = {0.f, 0.f}; u32x2 po0[4], po1[4];
    if (MERGE) { pm0 = *(const f32x2*)(MLb + (unsigned)((tq * 16 + cur.h) * 8)); pm1 = *(const f32x2*)(MLb + (unsigned)(((T + tq) * 16 + cur.h) * 8));
#pragma unroll
        for (int et = 0; et < 4; ++et) { po0[et] = *(const u32x2*)(AOb + (unsigned)((tq * 1024 + 64 * cur.h + 4 * fq) * 2) + 32 * et); po1[et] = *(const u32x2*)(AOb + (unsigned)(((T + tq) * 1024 + 64 * cur.h + 4 * fq) * 2) + 32 * et); } }
#pragma unroll
    for (int r = 0; r < 4; ++r) { if (4 * fq + r < fr) st[0][r] = -1.0e30f; if (4 * fq + r > fr) st[8][r] = -1.0e30f; }
    if (blk == 0 || 128 * (blk + 1) >= n) {
#pragma unroll
        for (int kt = 0; kt < 9; ++kt)
#pragma unroll
            for (int r = 0; r < 4; ++r) { const int kj = qi + 16 * kt + 4 * fq + r - 64 - fr; if (kj < 0 || kj >= n) st[kt][r] = -1.0e30f; } }
    float mx = fmaxf(fmaxf(st[0][0], st[0][1]), fmaxf(st[0][2], st[0][3]));
#pragma unroll
    for (int kt = 1; kt < 9; ++kt) { mx = __builtin_fmaxf(__builtin_fmaxf(mx, st[kt][0]), st[kt][1]); mx = __builtin_fmaxf(__builtin_fmaxf(mx, st[kt][2]), st[kt][3]); }
    mx = fmaxf(mx, __shfl_xor(mx, 16)); mx = fmaxf(mx, __shfl_xor(mx, 32));
    f32x2 s2 = {0.f, 0.f}; const f32x2 m2 = {mx, mx};
#pragma unroll
    for (int kt = 0; kt < 9; ++kt) { f32x2 a = {st[kt][0], st[kt][1]}, c = {st[kt][2], st[kt][3]}; a -= m2; c -= m2;
        a[0] = __builtin_amdgcn_exp2f(a[0]); a[1] = __builtin_amdgcn_exp2f(a[1]); c[0] = __builtin_amdgcn_exp2f(c[0]); c[1] = __builtin_amdgcn_exp2f(c[1]);
        s2 += a; s2 += c; st[kt][0] = a[0]; st[kt][1] = a[1]; st[kt][2] = c[0]; st[kt][3] = c[1]; }
    float sum = s2[0] + s2[1];
    sum += __shfl_xor(sum, 16); sum += __shfl_xor(sum, 32);
    bf16x8 pf[5];
#pragma unroll
    for (int k2 = 0; k2 < 5; ++k2) { u32x4 pw; pw.x = pk2(st[2 * k2][0], st[2 * k2][1]); pw.y = pk2(st[2 * k2][2], st[2 * k2][3]);
        if (k2 < 4) { pw.z = pk2(st[2 * k2 + 1][0], st[2 * k2 + 1][1]); pw.w = pk2(st[2 * k2 + 1][2], st[2 * k2 + 1][3]); } else { pw.z = 0u; pw.w = 0u; }
        pf[k2] = mk_frag(pw); }
    float inv = 1.f / sum, w0 = 0.f, w1 = 0.f;
    if (MERGE) { const float M = fmaxf(mx, fmaxf(pm0[0], pm1[0])); w0 = pm0[1] * __builtin_amdgcn_exp2f(pm0[0] - M); w1 = pm1[1] * __builtin_amdgcn_exp2f(pm1[0] - M);
        const float e2 = __builtin_amdgcn_exp2f(mx - M); const float iw = 1.f / (w0 + w1 + e2 * sum); inv = e2 * iw; w0 *= iw; w1 *= iw; }
    const LAS bf16_t* vb = Vs + (4 * fq + (fr >> 2)) * KP + 4 * (fr & 3);
    const LAS bf16_t* vp[9];
#pragma unroll
    for (int kt = 0; kt < 9; ++kt) { const int Tt = w + kt; vp[kt] = vb + ((((par + (Tt >> 3)) & 1) << 7) + ((Tt & 7) << 4)) * KP; }
    u32x2 vf[2][9];
#pragma unroll
    for (int kt = 0; kt < 9; ++kt) vf[0][kt] = lds_tr16(vp[kt]);
#pragma unroll
    for (int et = 0; et < 4; ++et) {
        if (et < 3) {
#pragma unroll
            for (int kt = 0; kt < 9; ++kt) vf[(et + 1) & 1][kt] = lds_tr16(vp[kt] + 16 * (et + 1)); }
        __builtin_amdgcn_sched_barrier(0);
        f32x4 acc = {0.f, 0.f, 0.f, 0.f};
#pragma unroll
        for (int k2 = 0; k2 < 5; ++k2) { const u32x2 lo = vf[et & 1][2 * k2]; u32x2 hi = {0u, 0u}; if (k2 < 4) hi = vf[et & 1][2 * k2 + 1];
            u32x4 vw; vw.x = lo.x; vw.y = lo.y; vw.z = hi.x; vw.w = hi.y;
            acc = mfma16(mk_frag(vw), pf[k2], acc); }
        if (MERGE) { u32x2 o; o.x = pk2(acc[0] * inv + w0 * lo_f(po0[et].x) + w1 * lo_f(po1[et].x), acc[1] * inv + w0 * hi_f(po0[et].x) + w1 * hi_f(po1[et].x));
            o.y = pk2(acc[2] * inv + w0 * lo_f(po0[et].y) + w1 * lo_f(po1[et].y), acc[3] * inv + w0 * hi_f(po0[et].y) + w1 * hi_f(po1[et].y));
            *(u32x2*)(mixb + (unsigned)((tq * D + 1024 + 64 * cur.h + 4 * fq) * 2) + 32 * et) = o; }
        else { u32x2 o; o.x = pk2(acc[0] * inv, acc[1] * inv); o.y = pk2(acc[2] * inv, acc[3] * inv);
            *(u32x2*)(AOw + (unsigned)(((cur.br * T + tq) * 1024 + 64 * cur.h + 4 * fq) * 2) + 32 * et) = o; }
        __builtin_amdgcn_sched_barrier(0);
    }
    if (!MERGE && fq == 0) { f32x2 ml = {mx, sum}; *(f32x2*)(MLw + (unsigned)(((cur.br * T + tq) * 16 + cur.h) * 8)) = ml; }
}
template <int Q0, int Q1, bool MERGE>
__device__ __forceinline__ void p4_attn(const Args& A, LAS unsigned char* lds, int rep) {
    const int tid = threadIdx.x, lane = tid & 63, w = __builtin_amdgcn_readfirstlane(tid >> 6), fr = lane & 15, fq = lane >> 4;
    unsigned char* ws = A.ws;
    const unsigned char* projb = (const unsigned char*)(ws + WS_PROJ);
    bf16_t* AO = (bf16_t*)(ws + WS_AO); float* ML = (float*)(ws + WS_ML); bf16_t* mix = (bf16_t*)(ws + WS_MIX);
    LAS bf16_t* Ks = (LAS bf16_t*)lds; LAS bf16_t* Vs = (LAS bf16_t*)(lds + 36864);
    const int sr = tid >> 2, sq4 = tid & 3;
#define ATT_SEG_LOAD(d_, cls_, n_, s_, vk_, vv_) do { int kj_ = 128 * (s_) - 64 + sr; kj_ = kj_ < 0 ? 0 : kj_; kj_ = kj_ >= (n_) ? (n_) - 1 : kj_; \
        const unsigned ro_ = (unsigned)(rowb + (cls_) + (d_) * kj_) * (unsigned)(NPROJ_PAD * 2); \
        _Pragma("unroll") for (int i_ = 0; i_ < 2; ++i_) { vk_[i_] = *(const u32x4*)(projb + ro_ + kcol + 16 * i_); vv_[i_] = *(const u32x4*)(projb + ro_ + vcol + 16 * i_); } } while (0)
#define ATT_SEG_STORE(half_, vk_, vv_) do { _Pragma("unroll") for (int i_ = 0; i_ < 2; ++i_) { *(LAS u32x4*)(Ks + (128 * (half_) + sr) * KP + 16 * sq4 + 8 * i_) = vk_[i_]; *(LAS u32x4*)(Vs + (128 * (half_) + sr) * KP + 16 * sq4 + 8 * i_) = vv_[i_]; } } while (0)
#define ATT_Q_OFF(d_, cls_, n_, blk_) ({ int qi_ = 128 * (blk_) + 16 * w + fr; qi_ = qi_ >= (n_) ? (n_) - 1 : qi_; (unsigned)(rowb + (cls_) + (d_) * qi_) * (unsigned)(NPROJ_PAD * 2) + qcol; })
    u32x4 vk0[2], vv0[2], vk1[2], vv1[2]; bf16x8 qf[2];
#define ATT_STEP(P_, VKL_, VVL_, VKS_, VVS_) do { const int i_s = i + (P_); \
        { const bool in_ = (i_s + 3 <= cur.nblk); const int d_ = in_ ? cur.d : nxt.d, c_ = in_ ? cur.cls : nxt.cls, n_ = in_ ? cur.n : nxt.n, s_ = in_ ? cur.blk0 + i_s + 3 : nxt.blk0 + (P_); ATT_SEG_LOAD(d_, c_, n_, s_, VKL_, VVL_); } \
        const bool qmore_ = (i_s + 1 < cur.nblk); \
        const unsigned qoff_ = ATT_Q_OFF(qmore_ ? cur.d : nxt.d, qmore_ ? cur.cls : nxt.cls, qmore_ ? cur.n : nxt.n, qmore_ ? cur.blk0 + i_s + 1 : nxt.blk0); \
        attn_compute<MERGE>(cur, cur.blk0 + i_s, (P_), qf, qoff_, projb, Ks, Vs, AO, ML, mix, w, fr, fq); \
        __syncthreads(); \
        if (i_s + 2 <= cur.nblk) ATT_SEG_STORE((P_), VKS_, VVS_); \
        else if (hasn) { ATT_SEG_STORE(0, vk1, vv1); ATT_SEG_STORE(1, vk0, vv0); ATT_SEG_LOAD(nxt.d, nxt.cls, nxt.n, nxt.blk0 + 2, vk0, vv0); ATT_SEG_LOAD(nxt.d, nxt.cls, nxt.n, nxt.blk0 + 3, vk1, vv1); } \
        __syncthreads(); } while (0)
    for (int su0 = vcu_id(); su0 < 256 * rep; su0 += gridDim.x) { const int su = su0 & 255;
        AttnRun cur, nxt;
        attn_run(su, Q0, cur); nxt = cur;
        const int rowb = cur.b * SEQ, hq = 256 * (cur.h >> 2) + 32 * (cur.h & 3);
        const unsigned kcol = (unsigned)((OFF_K + hq + 128 * (sq4 >> 1) + 16 * (sq4 & 1)) * 2), vcol = (unsigned)((OFF_V + 64 * cur.h + 16 * sq4) * 2), qcol = (unsigned)((OFF_Q + hq + 8 * fq) * 2);
        ATT_SEG_LOAD(cur.d, cur.cls, cur.n, cur.blk0, vk0, vv0); ATT_SEG_LOAD(cur.d, cur.cls, cur.n, cur.blk0 + 1, vk1, vv1);
        { const unsigned qo = ATT_Q_OFF(cur.d, cur.cls, cur.n, cur.blk0); qf[0] = *(const bf16x8*)(projb + qo); qf[1] = *(const bf16x8*)(projb + qo + 256); }
        ATT_SEG_STORE(0, vk0, vv0); ATT_SEG_STORE(1, vk1, vv1);
        ATT_SEG_LOAD(cur.d, cur.cls, cur.n, cur.blk0 + 2, vk0, vv0); ATT_SEG_LOAD(cur.d, cur.cls, cur.n, cur.blk0 + 3, vk1, vv1);
        __syncthreads();
#pragma unroll 1
        for (int q = Q0; q < Q1; ++q) {
            const bool hasn = q < Q1 - 1;
            if (hasn) attn_run(su, q + 1, nxt);
#pragma unroll 1
            for (int i = 0; i < cur.nblk; i += 2) {
                ATT_STEP(0, vk1, vv1, vk0, vv0);
                ATT_STEP(1, vk0, vv0, vk1, vv1);
            }
            cur = nxt;
        }
    }
#undef ATT_STEP
#undef ATT_SEG_LOAD
#undef ATT_SEG_STORE
#undef ATT_Q_OFF
}

__device__ __forceinline__ void p6_ssd_final(const Args& A, LAS unsigned char* lds, int rep) {
    const int tid = threadIdx.x, lane = tid & 63, w = __builtin_amdgcn_readfirstlane(tid >> 6), fr = lane & 15, fq = lane >> 4;
    unsigned char* ws = A.ws;
    const bf16_t* xc = (const bf16_t*)(ws + WS_HB); const bf16_t* proj = (const bf16_t*)(ws + WS_PROJ);
    const float* ACS = (const float*)(ws + WS_ACS); const float* RCS = (const float*)(ws + WS_RCS);
    const bf16_t* YD = (const bf16_t*)(ws + WS_YD); const bf16_t* ST = (const bf16_t*)(ws + WS_ST);
    const float* dskip = (const float*)A.in[I_DSKIP]; const float* sg = (const float*)A.in[I_SSDG];
    bf16_t* mix = (bf16_t*)(ws + WS_MIX);
    LAS bf16_t* Cs = (LAS bf16_t*)lds;
    LAS float* EF = (LAS float*)(lds + 34816);
    LAS float* RED = (LAS float*)(lds + 34816 + 8192);
    for (int uu = vcu_id(); uu < BATCH * NCHUNK * 2 * rep; uu += gridDim.x) { const int u = uu & 255;
        const int b = u >> 7, c = (u >> 1) & 63, hf = u & 1; const int t0 = b * SEQ + c * CHUNK + 64 * hf;
        { const int row = tid >> 3, part = tid & 7, grp = part >> 2, q = part & 3; const bf16_t* src = xc + (size_t)(t0 + row) * XBCW + 1280 + 128 * grp + 32 * q;
#pragma unroll
          for (int i = 0; i < 4; ++i) *(LAS u32x4*)(Cs + grp * 64 * SP + row * SP + 32 * q + 8 * i) = *(const u32x4*)(src + 8 * i);
#pragma unroll
          for (int k = 0; k < 4; ++k) { const int idx = tid + 512 * k, dir = idx >> 10, hh = (idx >> 6) & 15, row2 = idx & 63;
              EF[idx] = __expf((dir ? RCS : ACS)[(size_t)(t0 + row2) * 16 + hh]); } }
        __syncthreads();
        const int grp = w >> 2;
        float ssr[4] = {0.f, 0.f, 0.f, 0.f};
        u32x2 gpk[4][4];
        LAS bf16_t* GT = (LAS bf16_t*)(lds + 45056) + w * (64 * 68);
#pragma unroll 1
        for (int hx = 0; hx < 2; ++hx) {
            const int h = 2 * w + hx;
            f32x4 y[4][4];
#pragma unroll
            for (int rt = 0; rt < 4; ++rt)
#pragma unroll
                for (int pt = 0; pt < 4; ++pt) y[rt][pt] = (f32x4){0.f, 0.f, 0.f, 0.f};
            const bf16_t* stb = ST + ((size_t)((b * NCHUNK + c) * 2) * 16 + h) * 8192 + (size_t)fr * 128 + 8 * fq;
#define P6_LOAD(dk_, hf_) do { const bf16_t* p_ = stb + (size_t)((dk_) >> 2) * (16 * 8192) + 32 * ((dk_) & 3); \
                _Pragma("unroll") for (int pt = 0; pt < 4; ++pt) hf_[pt] = *(const bf16x8*)(p_ + pt * (16 * 128)); } while (0)
#define P6_COMP(dk_, hf_) do { const int dir_ = (dk_) >> 2, ks_ = (dk_) & 3; \
                _Pragma("unroll") for (int rt = 0; rt < 4; ++rt) { \
                    const u32x4 cw = *(const LAS u32x4*)(Cs + grp * 64 * SP + (16 * rt + fr) * SP + 32 * ks_ + 8 * fq); \
                    const float ev = EF[dir_ * 1024 + h * 64 + 16 * rt + fr]; \
                    u32x4 aw; aw.x = pk2(lo_f(cw.x) * ev, hi_f(cw.x) * ev); aw.y = pk2(lo_f(cw.y) * ev, hi_f(cw.y) * ev); aw.z = pk2(lo_f(cw.z) * ev, hi_f(cw.z) * ev); aw.w = pk2(lo_f(cw.w) * ev, hi_f(cw.w) * ev); \
                    const bf16x8 af = mk_frag(aw); \
                    _Pragma("unroll") for (int pt = 0; pt < 4; ++pt) y[rt][pt] = mfma16(hf_[pt], af, y[rt][pt]); } } while (0)
            { bf16x8 hfa[4], hfb[4];
              P6_LOAD(0, hfa);
#pragma unroll 1
              for (int dk = 0; dk < 8; dk += 2) { P6_LOAD(dk + 1, hfb); P6_COMP(dk, hfa); if (dk + 2 < 8) P6_LOAD(dk + 2, hfa); P6_COMP(dk + 1, hfb); } }
#undef P6_LOAD
#undef P6_COMP
            asm volatile("" ::: "memory");
            const float dsk = dskip[h];
            u32x2 ea[12], eb[12];
#define P6_ELOAD(rt_, e_) do { const size_t tok_ = (size_t)(t0 + 16 * (rt_) + fr); const int col_ = 64 * h + 4 * fq; \
                _Pragma("unroll") for (int pt = 0; pt < 4; ++pt) { e_[3 * pt] = *(const u32x2*)(YD + tok_ * 1024 + col_ + 16 * pt); e_[3 * pt + 1] = *(const u32x2*)(xc + tok_ * XBCW + col_ + 16 * pt); e_[3 * pt + 2] = *(const u32x2*)(proj + tok_ * NPROJ_PAD + OFF_Z + col_ + 16 * pt); } } while (0)
#define P6_ECOMP(rt_, e_) do { \
                _Pragma("unroll") for (int pt = 0; pt < 4; ++pt) { const f32x4 yy = y[rt_][pt]; const u32x2 yd_ = e_[3 * pt], xv_ = e_[3 * pt + 1], zv_ = e_[3 * pt + 2]; \
                    const float g0 = (yy[0] + lo_f(yd_.x) + dsk * lo_f(xv_.x)) * silu_f(lo_f(zv_.x)), g1 = (yy[1] + hi_f(yd_.x) + dsk * hi_f(xv_.x)) * silu_f(hi_f(zv_.x)); \
                    const float g2 = (yy[2] + lo_f(yd_.y) + dsk * lo_f(xv_.y)) * silu_f(lo_f(zv_.y)), g3 = (yy[3] + hi_f(yd_.y) + dsk * hi_f(xv_.y)) * silu_f(hi_f(zv_.y)); \
                    ssr[rt_] += (g0 * g0 + g1 * g1) + (g2 * g2 + g3 * g3); \
                    u32x2 gp; gp.x = pk2(g0, g1); gp.y = pk2(g2, g3); \
                    if (hx == 0) *(LAS u32x2*)(GT + (16 * (rt_) + fr) * 68 + 16 * pt + 4 * fq) = gp; else gpk[rt_][pt] = gp; } \
                asm volatile("" ::: "memory"); } while (0)
            P6_ELOAD(0, ea);
            P6_ELOAD(1, eb); P6_ECOMP(0, ea);
            P6_ELOAD(2, ea); P6_ECOMP(1, eb);
            P6_ELOAD(3, eb); P6_ECOMP(2, ea);
            P6_ECOMP(3, eb);
#undef P6_ELOAD
#undef P6_ECOMP
        }
#pragma unroll
        for (int rt = 0; rt < 4; ++rt) { float v = ssr[rt]; v += __shfl_xor(v, 16); v += __shfl_xor(v, 32); if (fq == 0) RED[(16 * rt + fr) * 8 + w] = v; }
        f32x4 gnv[2][4];
#pragma unroll
        for (int hx = 0; hx < 2; ++hx)
#pragma unroll
            for (int pt = 0; pt < 4; ++pt) gnv[hx][pt] = *(const f32x4*)(sg + 64 * (2 * w + hx) + 16 * pt + 4 * fq);
        __syncthreads();
#pragma unroll
        for (int rt = 0; rt < 4; ++rt) { const LAS float* rp = RED + (16 * rt + fr) * 8; const f32x4 a = *(const LAS f32x4*)rp, bb = *(const LAS f32x4*)(rp + 4);
            ssr[rt] = rsqrtf(((a[0] + a[1]) + (a[2] + a[3]) + (bb[0] + bb[1]) + (bb[2] + bb[3])) * (1.f / 1024.f) + RMS_EPS); }
#pragma unroll
        for (int hx = 0; hx < 2; ++hx) { const int h = 2 * w + hx;
#pragma unroll
            for (int pt = 0; pt < 4; ++pt) { const int col = 64 * h + 16 * pt + 4 * fq; const f32x4 gn = gnv[hx][pt];
#pragma unroll
                for (int rt = 0; rt < 4; ++rt) { const u32x2 gv = (hx == 0) ? *(const LAS u32x2*)(GT + (16 * rt + fr) * 68 + 16 * pt + 4 * fq) : gpk[rt][pt]; const float rs = ssr[rt];
                    u32x2 o; o.x = pk2(lo_f(gv.x) * rs * gn[0], hi_f(gv.x) * rs * gn[1]); o.y = pk2(lo_f(gv.y) * rs * gn[2], hi_f(gv.y) * rs * gn[3]);
                    *(u32x2*)(mix + (size_t)(t0 + 16 * rt + fr) * D + col) = o; }
                asm volatile("" ::: "memory"); } }
        __syncthreads();
    }
}

__device__ __forceinline__ void p6_attn_merge(const Args& A) {
    unsigned char* ws = A.ws;
    const bf16_t* AO = (const bf16_t*)(ws + WS_AO); const float* ML = (const float*)(ws + WS_ML); bf16_t* mix = (bf16_t*)(ws + WS_MIX);
    const int gtid = blockIdx.x * 512 + threadIdx.x, NT = gridDim.x * 512;
    for (int i = gtid; i < T * 16 * 8; i += NT) {
        const int e8 = i & 7, h = (i >> 3) & 15, t = i >> 7;
        float m[3], l[3];
#pragma unroll
        for (int r = 0; r < 3; ++r) { const f32x2 v = *(const f32x2*)(ML + (((size_t)r * T + t) * 16 + h) * 2); m[r] = v[0]; l[r] = v[1]; }
        const float M = fmaxf(m[0], fmaxf(m[1], m[2]));
        float wgt[3], W = 0.f;
#pragma unroll
        for (int r = 0; r < 3; ++r) { wgt[r] = l[r] * __builtin_amdgcn_exp2f(m[r] - M); W += wgt[r]; }
        const float iw = 1.f / W; float o[8];
#pragma unroll
        for (int j = 0; j < 8; ++j) o[j] = 0.f;
#pragma unroll
        for (int r = 0; r < 3; ++r) { const u32x4 v = *(const u32x4*)(AO + ((size_t)r * T + t) * 1024 + 64 * h + 8 * e8); const float ww = wgt[r] * iw;
            o[0] += ww * lo_f(v.x); o[1] += ww * hi_f(v.x); o[2] += ww * lo_f(v.y); o[3] += ww * hi_f(v.y); o[4] += ww * lo_f(v.z); o[5] += ww * hi_f(v.z); o[6] += ww * lo_f(v.w); o[7] += ww * hi_f(v.w); }
        u32x4 ow; ow.x = pk2(o[0], o[1]); ow.y = pk2(o[2], o[3]); ow.z = pk2(o[4], o[5]); ow.w = pk2(o[6], o[7]);
        *(u32x4*)(mix + (size_t)t * D + 1024 + 64 * h + 8 * e8) = ow;
    }
}

constexpr int RP = 264;
__device__ __forceinline__ void p8_router(const Args& A, LAS unsigned char* lds, int dry) {
    const int tid = threadIdx.x, lane = tid & 63, w = __builtin_amdgcn_readfirstlane(tid >> 6), fr = lane & 15, fq = lane >> 4;
    unsigned char* ws = A.ws;
    const bf16_t* x1 = (const bf16_t*)(ws + WS_X1); const float* mod = (const float*)(ws + WS_MOD); const float* g2 = (const float*)A.in[I_N2G]; const float* rss = (const float*)(ws + WS_RSS);
    const bf16_t* wrt = (const bf16_t*)(ws + WS_WRT);
    const float* brg = (const float*)A.in[I_BRG]; const float* bre = (const float*)A.in[I_BRE];
    bf16_t* h2 = (bf16_t*)(ws + WS_HB);
    unsigned* cnt = (unsigned*)(ws + WS_CTL) + CW_CNT; int* elist = (int*)(ws + WS_ELIST); float* gates = (float*)(ws + WS_GATES);
    LAS float* A2 = (LAS float*)lds; LAS float* SH2 = A2 + D;
    LAS bf16_t* Bs = (LAS bf16_t*)(lds + 16384);
    LAS float* LG = (LAS float*)(lds + 16384 + 2 * 42240);
    if (blockIdx.x == 0 && tid < 256) ((u32x4*)(ws + WS_MIX))[tid] = (u32x4){0u, 0u, 0u, 0u};
    for (int tt0 = vcu_id(); tt0 < (T / 64) * (1 + dry); tt0 += gridDim.x) { const int tt = tt0 & (T / 64 - 1); const bool isdry = tt0 >= T / 64;
        const int b = (tt * 64) >= SEQ ? 1 : 0; const float* mb = mod + b * 12288;
        for (int i = tid; i < D; i += 512) { A2[i] = g2[i] * (1.f + mb[4 * D + i]); SH2[i] = mb[3 * D + i]; }
        const int tk = tt * 64 + 8 * w + (fr & 7); const bf16_t* xr = x1 + (size_t)tk * D + 8 * fq;
        float rstd; { const f32x4* rp = (const f32x4*)(rss + (size_t)tk * 32); float sacc = 0.f;
#pragma unroll
            for (int i = 0; i < 8; ++i) { const f32x4 v = rp[i]; sacc += (v[0] + v[1]) + (v[2] + v[3]); }
            rstd = rsqrtf(sacc * (1.f / D) + RMS_EPS); }
        u32x4 bst[5];
#define P8_BLOAD(c_) do { _Pragma("unroll") for (int i = 0; i < 5; ++i) { const int p = tid + 512 * i, row = p >> 5, c16 = p & 31; \
            bst[i] = *(const u32x4*)(wrt + (size_t)row * D + 256 * (c_) + 8 * c16); } } while (0)
#define P8_BSTORE(buf_) do { _Pragma("unroll") for (int i = 0; i < 5; ++i) { const int p = tid + 512 * i, row = p >> 5, c16 = p & 31; \
            *(LAS u32x4*)(Bs + (buf_) * 21120 + row * RP + 8 * c16) = bst[i]; } } while (0)
        u32x4 xa[8], xna[8];
#define P8_XLOAD(c_, xa_) do { _Pragma("unroll") for (int ks = 0; ks < 8; ++ks) xa_[ks] = *(const u32x4*)(xr + 256 * (c_) + 32 * ks); } while (0)
        P8_BLOAD(0); P8_XLOAD(0, xa);
        P8_BSTORE(0);
        __syncthreads();
        f32x4 acc[5];
#pragma unroll
        for (int ct = 0; ct < 5; ++ct) acc[ct] = (f32x4){0.f, 0.f, 0.f, 0.f};
#pragma unroll 1
        for (int c = 0; c < 8; ++c) {
            { const int cn = c + 1 < 8 ? c + 1 : 7; P8_BLOAD(cn); P8_XLOAD(cn, xna); }
            const LAS bf16_t* bb = Bs + (c & 1) * 21120 + fr * RP + 8 * fq;
#pragma unroll
            for (int ks = 0; ks < 8; ++ks) { const int col = 256 * c + 32 * ks + 8 * fq;
                const f32x4 m0 = *(const LAS f32x4*)(A2 + col), m1 = *(const LAS f32x4*)(A2 + col + 4), s0 = *(const LAS f32x4*)(SH2 + col), s1 = *(const LAS f32x4*)(SH2 + col + 4);
                const f32x4 xf0 = {lo_f(xa[ks].x), hi_f(xa[ks].x), lo_f(xa[ks].y), hi_f(xa[ks].y)}, xf1 = {lo_f(xa[ks].z), hi_f(xa[ks].z), lo_f(xa[ks].w), hi_f(xa[ks].w)};
                const f32x4 v0 = (xf0 * rstd) * m0 + s0, v1 = (xf1 * rstd) * m1 + s1;
                u32x4 hw; hw.x = pk2(v0[0], v0[1]); hw.y = pk2(v0[2], v0[3]); hw.z = pk2(v1[0], v1[1]); hw.w = pk2(v1[2], v1[3]);
                if (fr < 8) *(u32x4*)(h2 + (size_t)tk * D + col) = hw;
                const bf16x8 ah = mk_frag(hw);
#pragma unroll
                for (int ct = 0; ct < 5; ++ct) acc[ct] = mfma16(ah, *(const LAS bf16x8*)(bb + (16 * ct) * RP + 32 * ks), acc[ct]); }
            P8_BSTORE((c + 1) & 1);
#pragma unroll
            for (int ks = 0; ks < 8; ++ks) xa[ks] = xna[ks];
            __syncthreads();
        }
#undef P8_BLOAD
#undef P8_BSTORE
#undef P8_XLOAD
        if (fq < 2) {
#pragma unroll
            for (int ct = 0; ct < 5; ++ct)
#pragma unroll
                for (int r = 0; r < 4; ++r) LG[(8 * w + 4 * fq + r) * NRT + 16 * ct + fr] = acc[ct][r]; }
        __syncthreads();
        LAS int* lcnt = (LAS int*)(lds + 16384); LAS int* lbase = lcnt + 64;
        if (tid < 64) lcnt[tid] = 0;
        __syncthreads();
        int ea = 0, eb = 0, ra = 0, rb = 0; float g1v = 0.f, g2v = 0.f;
        if (lane < 8) {
            const LAS float* lg = LG + (8 * w + lane) * NRT;
            float gmx = -3.0e38f; int gi = 0;
#pragma unroll
            for (int j = 0; j < 8; ++j) { const float v = lg[j] + brg[j]; if (v > gmx) { gmx = v; gi = j; } }
            float gse = 0.f;
#pragma unroll
            for (int j = 0; j < 8; ++j) gse += __expf(lg[j] + brg[j] - gmx);
            const float pgroup = 1.f / gse;
            const LAS float* el = lg + 16 + 8 * gi; const float* be = bre + 8 * gi;
            float emx = -3.0e38f; int i1 = 0;
#pragma unroll
            for (int j = 0; j < 8; ++j) { const float v = el[j] + be[j]; if (v > emx) { emx = v; i1 = j; } }
            float e2 = -3.0e38f; int i2 = 0; float ese = 0.f;
#pragma unroll
            for (int j = 0; j < 8; ++j) { const float v = el[j] + be[j]; ese += __expf(v - emx); if (j != i1 && v > e2) { e2 = v; i2 = j; } }
            const float p1 = 1.f / ese, p2 = __expf(e2 - emx) / ese; const float ps = p1 + p2;
            g1v = pgroup * p1 / ps; g2v = pgroup * p2 / ps;
            ea = 8 * gi + i1; eb = 8 * gi + i2;
            if (!isdry) { ra = __hip_atomic_fetch_add(lcnt + ea, 1, __ATOMIC_RELAXED, __HIP_MEMORY_SCOPE_WORKGROUP); rb = __hip_atomic_fetch_add(lcnt + eb, 1, __ATOMIC_RELAXED, __HIP_MEMORY_SCOPE_WORKGROUP); }
        }
        __syncthreads();
        if (tid < 64 && !isdry) { const int c = lcnt[tid]; if (c > 0) lbase[tid] = (int)atomicAdd(cnt + 32 * tid, (unsigned)c); }
        __syncthreads();
        if (lane < 8 && !isdry) { const int tok = tt * 64 + 8 * w + lane;
            elist[(size_t)ea * ECAP + lbase[ea] + ra] = 2 * tok; elist[(size_t)eb * ECAP + lbase[eb] + rb] = 2 * tok + 1;
            gates[2 * tok] = g1v; gates[2 * tok + 1] = g2v; }
        __syncthreads();
    }
}

__device__ __forceinline__ int moe_tables(const Args& A, LAS unsigned char* lds, int npn, bool down) {
    const int tid = threadIdx.x;
    unsigned char* ws = A.ws;
    const unsigned* cnt = (const unsigned*)(ws + WS_CTL) + CW_CNT; const int* elist = (const int*)(ws + WS_ELIST); const float* gates = (const float*)(ws + WS_GATES);
    LAS int* tb = (LAS int*)(lds + ETAB_OFF); LAS int* cn = tb + 80;
    if (tid < 64) cn[tid] = (int)__hip_atomic_load(cnt + 32 * tid, __ATOMIC_RELAXED, __HIP_MEMORY_SCOPE_AGENT);
    __syncthreads();
    if (tid <= 64) { int s = 0; for (int j = 0; j < tid; ++j) s += (cn[j] + 255) >> 8; tb[tid] = s; }
    __syncthreads();
    const int ntiles = tb[64];
    LAS int* tab = (LAS int*)(lds + TAB_OFF);
    const int cap = down ? 6 : 12;
    for (int li = 0; li < cap; ++li) {
        const long L = (long)li * gridDim.x + vcu_id(); if (L >= (long)ntiles * npn) break;
        const int tau = (int)(L / npn); int e = 0;
        for (int j = 1; j < NEXP; ++j) e += (tb[j] <= tau) ? 1 : 0;
        const int mt = tau - tb[e], ce = cn[e];
        if (tid < 256) { const int pos = 256 * mt + tid; const bool ok = pos < ce; const int a = ok ? elist[(size_t)e * ECAP + pos] : -1;
            if (down) { tab[li * 512 + 2 * tid] = a; tab[li * 512 + 2 * tid + 1] = ok ? __float_as_int(gates[a]) : 0; }
            else tab[li * 256 + tid] = ok ? (a >> 1) * (D * 2) : (int)(unsigned)(WS_MIX - WS_HB); }
    }
    __syncthreads();
    return ntiles;
}

__device__ __forceinline__ void p11_combine(const Args& A) {
    unsigned char* ws = A.ws;
    const bf16_t* x1 = (const bf16_t*)(ws + WS_X1); const float* mod = (const float*)(ws + WS_MOD); const bf16_t* Y = (const bf16_t*)(ws + WS_YSLOT);
    const int gtid = blockIdx.x * 512 + threadIdx.x, NR = (gridDim.x * 512) >> 8, c8 = (gtid & 255) * 8;
    f32x4 gt[2][2];
#pragma unroll
    for (int bb = 0; bb < 2; ++bb) { gt[bb][0] = *(const f32x4*)(mod + bb * 12288 + 5 * D + c8); gt[bb][1] = *(const f32x4*)(mod + bb * 12288 + 5 * D + c8 + 4); }
    for (int t0 = gtid >> 8; t0 < T; t0 += 4 * NR) {
        u32x4 xw[4], ya[4], yb[4];
#pragma unroll
        for (int u = 0; u < 4; ++u) { int t = t0 + u * NR; t = t < T ? t : T - 1;
            xw[u] = *(const u32x4*)(x1 + (size_t)t * D + c8); ya[u] = *(const u32x4*)(Y + (size_t)(2 * t) * D + c8); yb[u] = *(const u32x4*)(Y + (size_t)(2 * t + 1) * D + c8); }
        __builtin_amdgcn_sched_barrier(0);
#pragma unroll
        for (int u = 0; u < 4; ++u) { const int t = t0 + u * NR; if (t < T) { const int bb = t >= SEQ ? 1 : 0;
            const f32x4 g0 = bb ? gt[1][0] : gt[0][0], g1 = bb ? gt[1][1] : gt[0][1];
            const f32x4 a0 = {lo_f(xw[u].x), hi_f(xw[u].x), lo_f(xw[u].y), hi_f(xw[u].y)}, a1 = {lo_f(xw[u].z), hi_f(xw[u].z), lo_f(xw[u].w), hi_f(xw[u].w)};
            f32x4 s0, s1;
            s0[0] = lo_f(ya[u].x) + lo_f(yb[u].x); s0[1] = hi_f(ya[u].x) + hi_f(yb[u].x); s0[2] = lo_f(ya[u].y) + lo_f(yb[u].y); s0[3] = hi_f(ya[u].y) + hi_f(yb[u].y);
            s1[0] = lo_f(ya[u].z) + lo_f(yb[u].z); s1[1] = hi_f(ya[u].z) + hi_f(yb[u].z); s1[2] = lo_f(ya[u].w) + lo_f(yb[u].w); s1[3] = hi_f(ya[u].w) + hi_f(yb[u].w);
            __builtin_nontemporal_store(a0 + g0 * s0, (f32x4*)(A.out + (size_t)t * D + c8)); __builtin_nontemporal_store(a1 + g1 * s1, (f32x4*)(A.out + (size_t)t * D + c8 + 4)); } }
    }
}

constexpr int NPH = 12;
#ifndef DUP_PH
#define DUP_PH -1
#endif
#define REP(k) for (int _rep = 0; _rep < ((DUP_PH) == (k) ? 2 : 1); ++_rep)
__global__ void __launch_bounds__(512, 2) hyb_fwd(Args args) {
    extern __shared__ __attribute__((aligned(16))) unsigned char lds_raw[];
    LAS unsigned char* lds = (LAS unsigned char*)lds_raw;
    const int tid = threadIdx.x;
    volatile LAS unsigned* MISC = (volatile LAS unsigned*)(lds + MISC_OFF);
    for (int u = tid; u < 128; u += 512) MISC[u] = 0u;
    __syncthreads();
    unsigned char* ws = args.ws;
    unsigned* ctl = (unsigned*)(ws + WS_CTL);
    const int lo = args.ph_lo, hi = args.ph_hi;
    XcdBarrier bar; bar.bar = ctl + CW_BAR; bar.x = 0; bar.st = nullptr;
    if (hi - lo > 1) bar = xcd_barrier_post(ctl + CW_BAR, MISC + 8);
#ifndef PH_MASK
#define PH_MASK 0xFFF
#endif
#define IN(k) ((((PH_MASK) >> (k)) & 1) && lo <= (k) && (k) < hi)
#ifndef TPROBE_A
#define TPROBE_A -1
#define TPROBE_B -1
#endif
#define SEAM(k) do { if (IN(k) && IN((k) + 1)) xcd_barrier(bar); if (TPROBE_A >= 0 && blockIdx.x == 0 && tid == 0) ctl[CW_FLAG + 1 + (k)] = (unsigned)wall_clock64(); } while (0)
    if (TPROBE_A >= 0 && blockIdx.x == 0 && tid == 0) ctl[CW_FLAG] = (unsigned)wall_clock64();

    if (IN(0)) { REP(0) { p0_prologue(args, lds); __syncthreads(); } } SEAM(0);
    if (IN(1)) { REP(1) p1_norm1(args); } SEAM(1);
    if (IN(2)) {
        const int G2 = (gridDim.x == 256) ? 184 : (int)gridDim.x;
        if ((int)blockIdx.x < G2) {
            pg8::Gemm g{(const bf16_t*)(ws + WS_HB), (const bf16_t*)(ws + WS_WINT), D, 0};
            pg8::StaticOrder S; S.init(T, NPROJ_PAD, G2, (int)blockIdx.x, (DUP_PH) == 2 ? 2 : 1);
            EpiProj E{(bf16_t*)(ws + WS_PROJ), (float*)(ws + WS_DTRAW), (const float*)args.in[I_QG], (const float*)args.in[I_KG], (const float*)(ws + WS_ROPE)};
            pg8::gemm_phase<EpiProj, pg8::StaticOrder, true, false>(lds, g, S, E);
            p2_convert_late(args, lds);
        } else p2_convert_late(args, lds);
    } SEAM(2);
    if (IN(3)) { p3_post(args, (DUP_PH) == 13 ? 1 : 0, (DUP_PH) == 3 ? 2 : 1); } SEAM(3);
    if (IN(4)) { p4_ssd_local(args, lds, (DUP_PH) == 4 ? 2 : 1); p4_attn<0, 2, false>(args, lds, (DUP_PH) == 14 ? 2 : 1); } SEAM(4);
    if (IN(5)) { p5_scan(args); } SEAM(5);
    if (IN(6)) { p6_ssd_final(args, lds, (DUP_PH) == 6 ? 2 : 1); p4_attn<2, 4, true>(args, lds, (DUP_PH) == 16 ? 2 : 1); } SEAM(6);
    if (IN(7)) {
        pg8::Gemm g{(const bf16_t*)(ws + WS_MIX), (const bf16_t*)(ws + WS_WOUTT), D, 0};
        pg8::StaticOrder S; S.init(T, D, (int)gridDim.x, (int)blockIdx.x, (DUP_PH) == 7 ? 2 : 1);
        EpiOut E{(const float*)args.in[I_X], (const float*)(ws + WS_MOD), (bf16_t*)(ws + WS_X1), (float*)(ws + WS_RSS)};
        pg8::gemm_phase<EpiOut, pg8::StaticOrder, true, false>(lds, g, S, E);
    } SEAM(7);
    if (IN(8)) { p8_router(args, lds, (DUP_PH) == 8 ? 1 : 0); } SEAM(8);
    if (IN(9)) {
        const int ntiles = moe_tables(args, lds, 4, false);
        pg8::Gemm g{(const bf16_t*)(ws + WS_HB), (const bf16_t*)(ws + WS_WGUT), D, (size_t)1024 * D * 2};
        MoeOrder S{(const LAS int*)(lds + ETAB_OFF), ntiles, 4, (int)gridDim.x, vcu_id(), (const LAS unsigned*)(lds + TAB_OFF)};
        EpiGU E{(bf16_t*)(ws + WS_HMOE)};
        _Pragma("unroll 1") REP(9) pg8::gemm_phase<EpiGU, MoeOrder, true, true>(lds, g, S, E);
    } SEAM(9);
    if (IN(10)) {
        const int ntiles = moe_tables(args, lds, 8, true);
        pg8::Gemm g{(const bf16_t*)(ws + WS_HMOE), (const bf16_t*)(ws + WS_WDT), EH, (size_t)D * EH * 2};
        MoeOrder S{(const LAS int*)(lds + ETAB_OFF), ntiles, 8, (int)gridDim.x, vcu_id(), (const LAS unsigned*)(lds + TAB_OFF)};
        EpiDown E{(bf16_t*)(ws + WS_YSLOT), (const LAS int*)(lds + TAB_OFF)};
        _Pragma("unroll 1") REP(10) pg8::gemm_phase<EpiDown, MoeOrder, true, false>(lds, g, S, E);
    } SEAM(10);
    if (IN(11)) { REP(11) p11_combine(args); }
    if (TPROBE_A >= 0) {
        xcd_barrier(bar);
        if (blockIdx.x == 0 && tid == 0) ctl[CW_FLAG + 1 + 11] = (unsigned)wall_clock64();
        __syncthreads();
        const unsigned ea = __hip_atomic_load(ctl + CW_FLAG + 1 + TPROBE_A, __ATOMIC_RELAXED, __HIP_MEMORY_SCOPE_AGENT), sa = __hip_atomic_load(ctl + CW_FLAG + TPROBE_A, __ATOMIC_RELAXED, __HIP_MEMORY_SCOPE_AGENT);
        const unsigned eb = __hip_atomic_load(ctl + CW_FLAG + 1 + TPROBE_B, __ATOMIC_RELAXED, __HIP_MEMORY_SCOPE_AGENT), sb = __hip_atomic_load(ctl + CW_FLAG + TPROBE_B, __ATOMIC_RELAXED, __HIP_MEMORY_SCOPE_AGENT);
        xcd_barrier(bar);
        const float ta = (float)(ea - sa) * 0.01f, tb = (float)(eb - sb) * 0.01f;
        const float sfac = sqrtf(ta * 0.01f); const float* xin = (const float*)args.in[I_X];
        for (size_t i = (size_t)blockIdx.x * 512 + tid; i < (size_t)T * D; i += (size_t)gridDim.x * 512) args.out[i] += xin[i] * sfac + (i == 0 ? tb : 0.f);
    }
#undef IN
#undef SEAM
}

extern "C" void kernel_launch(void* const* d_in, const int* in_sizes, int n_in, void* d_out, int out_size, void* d_ws, size_t ws_size, hipStream_t stream) {
    static int grid = 0;
    if (grid == 0) {
        if (n_in != 24 || in_sizes[0] != T * D || out_size != T * D || ws_size < WS_END) { fprintf(stderr, "kernel_launch: unexpected shapes (n_in %d, in0 %d, out %d, ws %zu < %zu); nothing launched\n", n_in, n_in > 0 ? in_sizes[0] : -1, out_size, ws_size, (size_t)WS_END); grid = -1; return; }
        int dev = 0, cus = 0, per_cu = 0;
        if (hipGetDevice(&dev) != hipSuccess || hipDeviceGetAttribute(&cus, hipDeviceAttributeMultiprocessorCount, dev) != hipSuccess) { grid = -1; return; }
        if (hipFuncSetAttribute((const void*)hyb_fwd, hipFuncAttributeMaxDynamicSharedMemorySize, LDS_BYTES) != hipSuccess) { fprintf(stderr, "kernel_launch: hipFuncSetAttribute failed\n"); grid = -1; return; }
        if (hipOccupancyMaxActiveBlocksPerMultiprocessor(&per_cu, (const void*)hyb_fwd, 512, LDS_BYTES) != hipSuccess || per_cu < 1) fprintf(stderr, "kernel_launch: occupancy query reports %d\n", per_cu);
        (void)hipGetLastError();
        grid = cus;
    }
    if (grid < 0) return;
    (void)hipMemsetAsync((char*)d_ws + WS_CTL, 0, CTL_BYTES, stream);
    Args a{};
    for (int i = 0; i < 24; ++i) a.in[i] = d_in[i];
    a.out = (float*)d_out; a.ws = (unsigned char*)d_ws;
#if MK_ONE_LAUNCH
    a.ph_lo = 0; a.ph_hi = NPH;
    hipLaunchKernelGGL(hyb_fwd, dim3(grid), dim3(512), LDS_BYTES, stream, a);
#else
    for (int p = 0; p < NPH; ++p) { a.ph_lo = p; a.ph_hi = p + 1; hipLaunchKernelGGL(hyb_fwd, dim3(grid), dim3(512), LDS_BYTES, stream, a); }
#endif
}
```

```cpp
#include <hip/hip_runtime.h>
#include <cstdio>
#include <cstdint>

#ifndef MK_ONE_LAUNCH
#define MK_ONE_LAUNCH 1
#endif

#define LAS __attribute__((address_space(3)))
#define GAS __attribute__((address_space(1)))
typedef unsigned short bf16_t;
typedef short bf16x8 __attribute__((ext_vector_type(8)));
typedef float f32x4 __attribute__((ext_vector_type(4)));
typedef float f32x2 __attribute__((ext_vector_type(2)));
typedef unsigned u32x4 __attribute__((ext_vector_type(4)));
typedef unsigned u32x2 __attribute__((ext_vector_type(2)));

constexpr int BATCH = 2, SEQ = 8192, T = BATCH * SEQ, D = 2048;
constexpr int NPROJ = 5664, NPROJ_PAD = 5888;
constexpr int OFF_Q = 0, OFF_K = 1024, OFF_V = 2048, OFF_Z = 3072, OFF_XBC = 4096, OFF_DT = 5632;
constexpr int XBCW = 1536, NHEAD = 16, CHUNK = 128, NCHUNK = SEQ / CHUNK;
constexpr int NEXP = 64, EH = 512;
constexpr int ECAP = T;
constexpr int NRT = 80;
constexpr float RMS_EPS = 1e-6f;
constexpr float LOG2E = 1.4426950408889634f;

constexpr size_t MiB = 1u << 20;
constexpr size_t WS_CTL = 0, CTL_BYTES = 1 * MiB;
constexpr size_t WS_MOD = 1 * MiB;
constexpr size_t WS_ROPE = 2 * MiB;
constexpr size_t WS_WRT = 6 * MiB;
constexpr size_t WS_SMALL = 7 * MiB;
constexpr size_t WS_DTRAW = WS_SMALL, WS_DTF = WS_SMALL + 2 * MiB, WS_DTB = WS_SMALL + 3 * MiB, WS_ACS = WS_SMALL + 4 * MiB, WS_RCS = WS_SMALL + 5 * MiB, WS_DEC = WS_SMALL + 6 * MiB;
constexpr size_t WS_ML = 14 * MiB;
constexpr size_t WS_ELIST = 20 * MiB;
constexpr size_t WS_GATES = 24 * MiB;
constexpr size_t WS_WINT = 25 * MiB;
constexpr size_t WS_WOUTT = 48 * MiB;
constexpr size_t WS_WGUT = 56 * MiB;
constexpr size_t WS_WDT = 312 * MiB;
constexpr size_t WS_HB = 440 * MiB;
constexpr size_t WS_PROJ = 504 * MiB;
constexpr size_t WS_YSLOT = WS_PROJ, WS_HMOE = WS_PROJ + 128 * MiB;
constexpr size_t WS_ST = 688 * MiB;
constexpr size_t WS_X1 = WS_ST;
constexpr size_t WS_YD = 816 * MiB;
constexpr size_t WS_AO = 880 * MiB;
constexpr size_t WS_RSS = WS_AO;
constexpr size_t WS_MIX = 976 * MiB;
constexpr size_t WS_END = 1040 * MiB;

constexpr int CW_BAR = 4096;
constexpr int CW_CNT = 16384;
constexpr int CW_FLAG = 16384 + 4096;

constexpr int RING_BYTES = 131072;
constexpr int MISC_OFF = 133120;
constexpr int TAB_OFF = MISC_OFF + 512;
constexpr int ETAB_OFF = TAB_OFF + 12288;
constexpr int LDS_BYTES = 147456;
static_assert(ETAB_OFF + 1024 <= LDS_BYTES, "LDS map");

__device__ __forceinline__ float bf2f(unsigned v) { return __uint_as_float(v << 16); }
__device__ __forceinline__ unsigned f2bf(float f) { unsigned u = __float_as_uint(f); return (u + 0x7fffu + ((u >> 16) & 1u)) >> 16; }
typedef __bf16 bf16v2_t __attribute__((ext_vector_type(2)));
__device__ __forceinline__ unsigned pk2(float lo, float hi) { const f32x2 v = {lo, hi}; return __builtin_bit_cast(unsigned, __builtin_convertvector(v, bf16v2_t)); }
__device__ __forceinline__ float lo_f(unsigned w) { return __uint_as_float(w << 16); }
__device__ __forceinline__ float hi_f(unsigned w) { return __uint_as_float(w & 0xffff0000u); }
__device__ __forceinline__ float silu_f(float v) { return v / (1.f + __expf(-v)); }
#define LDS_WAIT() asm volatile("s_waitcnt lgkmcnt(0)" ::: "memory")
#define VM_WAIT() asm volatile("s_waitcnt vmcnt(0)" ::: "memory")

#define XB_TMO      128
#define XB_XCNT(j)  (256  + 64 * (j))
#define XB_XSUB(j)  (1280 + 64 * (j))
#define XB_XGEN(j)  (2304 + 64 * (j))
#define XB_TOP      3328
#define XB_TOPGEN   3392
#define XCD_BAR_WORDS 3456
#define XB_SPIN_CAP (1u << 18)
__device__ __forceinline__ unsigned xb_ld(unsigned* p)              { return __hip_atomic_load(p, __ATOMIC_RELAXED, __HIP_MEMORY_SCOPE_AGENT); }
__device__ __forceinline__ unsigned xb_add(unsigned* p, unsigned v) { return __hip_atomic_fetch_add(p, v, __ATOMIC_RELAXED, __HIP_MEMORY_SCOPE_AGENT); }
__device__ __forceinline__ unsigned xb_xcc_id() { return (unsigned)__builtin_amdgcn_s_getreg((3 << 11) | 20) & 0xFu; }
#define XB_SPIN(cond, bar) do { unsigned _sp = 0; while (cond) { __builtin_amdgcn_s_sleep(1); \
    if ((++_sp & 255u) == 0u) { if (xb_ld(&(bar)[XB_TMO])) break; if (_sp > XB_SPIN_CAP) { atomicAdd(&(bar)[XB_TMO], 1u); break; } } } } while (0)
struct XcdBarrier { unsigned* bar; unsigned x; volatile LAS unsigned* st; };
__device__ __forceinline__ XcdBarrier xcd_barrier_post(unsigned* bar, volatile LAS unsigned* st) {
    XcdBarrier b; b.bar = bar; b.x = xb_xcc_id(); b.st = st;
    if (threadIdx.x == 0) (void)xb_add(&bar[XB_XCNT(b.x)], 1u);
    return b;
}
__device__ __forceinline__ void xcd_barrier_complete(unsigned* bar, unsigned x, unsigned& nloc, unsigned& nx) {
    const unsigned G = gridDim.x * gridDim.y * gridDim.z;
    unsigned sum, cnt, mine, sp = 0u;
    for (;;) {
        sum = 0u; cnt = 0u; mine = 0u;
#pragma unroll
        for (unsigned j = 0; j < 16; ++j) { const unsigned c = xb_ld(&bar[XB_XCNT(j)]); sum += c; cnt += (c > 0u) ? 1u : 0u; mine = (j == x) ? c : mine; }
        if (sum == G) break;
        __builtin_amdgcn_s_sleep(1);
        if ((++sp & 255u) == 0u) { if (xb_ld(&bar[XB_TMO])) break; if (sp > XB_SPIN_CAP) { atomicAdd(&bar[XB_TMO], 1u); break; } }
    }
    nloc = mine > 0u ? mine : 1u; nx = cnt > 0u ? cnt : 1u;
}
__device__ __forceinline__ void xcd_barrier(const XcdBarrier& b) {
    asm volatile("s_waitcnt vmcnt(0)" ::: "memory");
    __syncthreads();
    if (threadIdx.x == 0) {
        unsigned* bar = b.bar;
        __builtin_amdgcn_s_waitcnt(0);
        unsigned nloc = b.st[0], nx = b.st[1];
        if (nloc == 0u) { xcd_barrier_complete(bar, b.x, nloc, nx); b.st[0] = nloc; b.st[1] = nx; }
        const unsigned old = xb_add(&bar[XB_XSUB(b.x)], 1u);
        const unsigned gen = old / nloc;
        if (old + 1u == (gen + 1u) * nloc) {
            __builtin_amdgcn_fence(__ATOMIC_RELEASE, "agent");
            asm volatile("s_waitcnt vmcnt(0)" ::: "memory");
            const unsigned og = xb_add(&bar[XB_TOP], 1u);
            const unsigned tg = og / nx;
            if (og + 1u == (tg + 1u) * nx) xb_add(&bar[XB_TOPGEN], 1u);
            else XB_SPIN(xb_ld(&bar[XB_TOPGEN]) == tg, bar);
            __builtin_amdgcn_fence(__ATOMIC_ACQUIRE, "agent");
            xb_add(&bar[XB_XGEN(b.x)], 1u);
            asm volatile("s_waitcnt vmcnt(0)" ::: "memory");
        } else {
            XB_SPIN(xb_ld(&bar[XB_XGEN(b.x)]) == gen, bar);
            __builtin_amdgcn_fence(__ATOMIC_ACQUIRE, "agent");
            asm volatile("s_waitcnt vmcnt(0)" ::: "memory");
        }
    }
    __syncthreads();
}

namespace pg8 {
constexpr int BM = 256, BK = 64, HALF = 128, HTB = HALF * BK * 2, STAGE_BYTES = 8 * HTB, NXCD = 8, WGM = 8;
__device__ __forceinline__ int lds_byte(int r, int c) { const int st = (r >> 4) * 2 + (c >> 5), rr = r & 15, cc = c & 31, ob = rr * 64 + cc * 2; return st * 1024 + (ob ^ (((ob >> 9) & 1) << 5)); }
__device__ __forceinline__ void stage_rc(int b, int& R, int& C) { const int st = b / 1024, sb = b % 1024, swz = sb ^ (((sb >> 9) & 1) << 5); R = (st >> 1) * 16 + swz / 64; C = (st & 1) * 32 + (swz % 64) / 2; }
__device__ __forceinline__ int perm32(int rho) { const int n = rho >> 4, i = rho & 15; return 8 * (i >> 2) + 4 * n + (i & 3); }

struct Unit { int pm, pn, e, li; };
struct Gemm { const bf16_t* A; const bf16_t* Bt; int K; size_t bstride; };

struct StaticOrder {
    int nM, nN, nwg, G, c, rep;
    __device__ void init(int M, int N, int G_, int c_, int rep_ = 1) { nM = M / BM; nN = N / BM; nwg = nM * nN; G = G_; c = c_; rep = rep_; }
    __device__ bool next(int i, Unit& u) const {
        const long L = (long)i * G + c; if (L >= (long)nwg * rep) return false;
        int wgid = (int)(L % nwg); { const int q = nwg / NXCD, r = nwg % NXCD, xcd = wgid % NXCD, off = wgid / NXCD; wgid = (xcd < r ? xcd * (q + 1) : r * (q + 1) + (xcd - r) * q) + off; }
        const int nig = WGM * nN, gid = wgid / nig, fm = gid * WGM, gsz = (nM - fm) < WGM ? (nM - fm) : WGM;
        u.pm = fm + ((wgid % nig) % gsz); u.pn = (wgid % nig) / gsz; u.e = 0; u.li = i; return true;
    }
    __device__ __forceinline__ void a_ready(const Unit&) const {}
    __device__ __forceinline__ void done(const Unit&) const {}
    __device__ __forceinline__ void load_goff(const Unit&, unsigned (&)[2][2], const int (&)[2], const int (&)[2]) const {}
};

template <class Epi, class Sched, bool ALIGN_EPI, bool GATHER>
__device__ __forceinline__ void gemm_phase(LAS unsigned char* lds, const Gemm g, const Sched& S, const Epi& E) {
    const int tid = threadIdx.x, wid = __builtin_amdgcn_readfirstlane(tid >> 6), lane = tid & 63, wr = wid >> 2, wc = wid & 3, fr = lane & 15, fq = lane >> 4;
    const int K = g.K, nt = K / BK;
    unsigned voffA[2], voffB[2]; int RA[2], CA[2];
#pragma unroll
    for (int i = 0; i < 2; ++i) { int R, C; stage_rc(tid * 16 + i * 8192, R, C); const int Rb = Epi::PERM ? ((R & ~31) + perm32(R & 31)) : R; RA[i] = R; CA[i] = C;
        voffA[i] = (unsigned)(R * K + C) * 2u; voffB[i] = (unsigned)(Rb * K + C) * 2u; }
    unsigned goff[2][2] = {{0u, 0u}, {0u, 0u}};
    const size_t kstep = (size_t)(BK * 2);
    const size_t hstep = (size_t)HALF * K * 2;
    const size_t tstep = 2 * hstep;
    const unsigned ldsw = (unsigned)wid * 1024u;
    const int aoff = lds_byte(wr * 64 + fr, fq * 8), boff = lds_byte(wc * 32 + fr, fq * 8);
#define PG8_SA(b, h) (((b) * 2 + (h)) * HTB)
#define PG8_SB(b, h) ((4 + (b) * 2 + (h)) * HTB)
#define PG8_STAGE(bufoff, gbase, voff) do { _Pragma("unroll") for (int _i = 0; _i < 2; ++_i) \
        __builtin_amdgcn_global_load_lds((const unsigned*)((const char*)(gbase) + (voff)[_i]), (LAS unsigned*)(lds + (bufoff) + ldsw + _i * 8192), 16, 0, 0); } while (0)
#define PG8_STAGE_A(bufoff, cptr, kb, h) do { if constexpr (GATHER) { PG8_STAGE(bufoff, (const char*)g.A + (kb), goff[h]); } else { PG8_STAGE(bufoff, (cptr) + (kb) + ((h) ? hstep : 0), voffA); } } while (0)
#define PG8_LDA(dst, b, h) do { _Pragma("unroll") for (int m = 0; m < 4; ++m) _Pragma("unroll") for (int k = 0; k < 2; ++k) dst[m][k] = *(const LAS bf16x8*)(lds + PG8_SA(b, h) + aoff + m * 2048 + k * 1024); } while (0)
#define PG8_LDB(dst, b, h) do { _Pragma("unroll") for (int n = 0; n < 2; ++n) _Pragma("unroll") for (int k = 0; k < 2; ++k) dst[n][k] = *(const LAS bf16x8*)(lds + PG8_SB(b, h) + boff + n * 2048 + k * 1024); } while (0)
#define PG8_MMA(ai, bj, At, Bt) do { __builtin_amdgcn_s_setprio(1); _Pragma("unroll") for (int m = 0; m < 4; ++m) _Pragma("unroll") for (int n = 0; n < 2; ++n) _Pragma("unroll") for (int k = 0; k < 2; ++k) \
        acc[ai][bj][m][n] = __builtin_amdgcn_mfma_f32_16x16x32_bf16(Bt[n][k], At[m][k], acc[ai][bj][m][n], 0, 0, 0); __builtin_amdgcn_s_setprio(0); } while (0)
#define PG8_WAIT_V(n) asm volatile("s_waitcnt vmcnt(" #n ")" ::: "memory")
#define PG8_WAIT_L(n) asm volatile("s_waitcnt lgkmcnt(" #n ")" ::: "memory")
#define PG8_BAR __builtin_amdgcn_s_barrier()
#define PG8_SCHED __builtin_amdgcn_sched_barrier(0)
    Unit cur, nxt; int ui = 0;
    if (!S.next(0, cur)) return;
    f32x4 acc[2][2][4][2];
#pragma unroll
    for (int a = 0; a < 2; ++a)
#pragma unroll
        for (int b = 0; b < 2; ++b)
#pragma unroll
            for (int m = 0; m < 4; ++m)
#pragma unroll
                for (int n = 0; n < 2; ++n) acc[a][b][m][n] = (f32x4){0.f, 0.f, 0.f, 0.f};
    bf16x8 At[4][2], B0[2][2], B1[2][2];
    const char* cA = GATHER ? (const char*)g.A : (const char*)g.A + (size_t)cur.pm * tstep;
    const char* cB = (const char*)g.Bt + (size_t)cur.e * g.bstride + (size_t)cur.pn * tstep;
    S.a_ready(cur);
    if constexpr (GATHER) { S.load_goff(cur, goff, RA, CA); }
    PG8_STAGE(PG8_SB(0, 0), cB, voffB); PG8_STAGE(PG8_SB(0, 1), cB + hstep, voffB); PG8_STAGE_A(PG8_SA(0, 0), cA, 0, 0); PG8_STAGE_A(PG8_SA(0, 1), cA, 0, 1);
    if (wr == 1) PG8_BAR;
    PG8_WAIT_V(2); PG8_BAR;
    PG8_STAGE(PG8_SB(1, 0), cB + kstep, voffB); PG8_STAGE_A(PG8_SA(1, 0), cA, kstep, 0); PG8_STAGE(PG8_SB(1, 1), cB + hstep + kstep, voffB);
    PG8_WAIT_V(6); PG8_BAR;
    for (;;) {
        const bool has_next = S.next(ui + 1, nxt);
        const char* nA = GATHER ? cA : (has_next ? (const char*)g.A + (size_t)nxt.pm * tstep : cA);
        const char* nB = has_next ? (const char*)g.Bt + (size_t)nxt.e * g.bstride + (size_t)nxt.pn * tstep : cB;
        for (int t = 0; t < nt; t += 2) {
            const bool last = (t == nt - 2);
            const size_t kb1 = (size_t)(t + 1) * kstep;
            const char* a2 = last ? nA : cA; const size_t kb2 = last ? 0 : (size_t)(t + 2) * kstep; const char* b2 = last ? nB : cB + (size_t)(t + 2) * kstep;
            const size_t kb3 = kb2 + kstep; const char* b3 = b2 + kstep;
            if (last && has_next) S.a_ready(nxt);
            PG8_LDB(B0, 0, 0); PG8_LDB(B1, 0, 1); PG8_SCHED; PG8_LDA(At, 0, 0); PG8_STAGE_A(PG8_SA(1, 1), cA, kb1, 1);
            PG8_WAIT_V(8); PG8_WAIT_L(0); PG8_BAR; PG8_MMA(0, 0, At, B0); PG8_MMA(0, 1, At, B1); PG8_BAR; PG8_SCHED;
            if constexpr (GATHER) { if (last && has_next) S.load_goff(nxt, goff, RA, CA); }
            PG8_LDA(At, 0, 1); PG8_STAGE(PG8_SB(0, 0), b2, voffB); PG8_STAGE(PG8_SB(0, 1), b2 + hstep, voffB); PG8_STAGE_A(PG8_SA(0, 0), a2, kb2, 0);
            PG8_WAIT_V(8); PG8_WAIT_L(0); PG8_BAR; PG8_MMA(1, 0, At, B0); PG8_MMA(1, 1, At, B1); PG8_BAR; PG8_SCHED;
            PG8_LDB(B0, 1, 0); PG8_LDB(B1, 1, 1); PG8_SCHED; PG8_LDA(At, 1, 0); PG8_STAGE_A(PG8_SA(0, 1), a2, kb2, 1);
            PG8_WAIT_V(8); PG8_WAIT_L(0); PG8_BAR; PG8_MMA(0, 0, At, B0); PG8_MMA(0, 1, At, B1); PG8_BAR; PG8_SCHED;
            PG8_LDA(At, 1, 1); PG8_STAGE(PG8_SB(1, 0), b3, voffB); PG8_STAGE(PG8_SB(1, 1), b3 + hstep, voffB); PG8_STAGE_A(PG8_SA(1, 0), a2, kb3, 0);
            PG8_WAIT_V(8); PG8_WAIT_L(0); PG8_BAR; PG8_MMA(1, 0, At, B0); PG8_MMA(1, 1, At, B1); PG8_BAR; PG8_SCHED;
        }
        if constexpr (ALIGN_EPI) { if (wr == 0) PG8_BAR; }
        E(acc, cur, wr, wc, fr, fq); S.done(cur);
        if (!has_next) break;
#pragma unroll
        for (int a = 0; a < 2; ++a)
#pragma unroll
            for (int b = 0; b < 2; ++b)
#pragma unroll
                for (int m = 0; m < 4; ++m)
#pragma unroll
                    for (int n = 0; n < 2; ++n) acc[a][b][m][n] = (f32x4){0.f, 0.f, 0.f, 0.f};
        cur = nxt; cA = nA; cB = nB; ++ui;
        if constexpr (ALIGN_EPI) { if (wr == 1) PG8_BAR; }
    }
    PG8_WAIT_V(0);
    if constexpr (!ALIGN_EPI) { if (wr == 0) PG8_BAR; }
    PG8_BAR;
#undef PG8_SA
#undef PG8_SB
#undef PG8_STAGE
#undef PG8_STAGE_A
#undef PG8_LDA
#undef PG8_LDB
#undef PG8_MMA
#undef PG8_WAIT_V
#undef PG8_WAIT_L
#undef PG8_BAR
#undef PG8_SCHED
}
}

struct EpiProj {
    static constexpr bool PERM = true;
    bf16_t* O; float* dtraw; const float* qg; const float* kg; const float* rope;
    __device__ __forceinline__ void operator()(const f32x4 (&acc)[2][2][4][2], const pg8::Unit& u, int wr, int wc, int fr, int fq) const {
        const int row0 = u.pm * 256 + wr * 64 + fr, col0 = u.pn * 256 + wc * 32 + 8 * fq;
        if (u.pn < 8) {
            const float* gp = (u.pn < 4 ? qg : kg) + 4 * fq; const float sc = u.pn < 4 ? 0.125f * LOG2E : 1.f;
            f32x4 gn[2][2];
#pragma unroll
            for (int bj = 0; bj < 2; ++bj)
#pragma unroll
                for (int n = 0; n < 2; ++n) gn[bj][n] = *(const f32x4*)(gp + 32 * n + 16 * bj);
#pragma unroll
            for (int ai = 0; ai < 2; ++ai)
#pragma unroll
                for (int m = 0; m < 4; ++m) { const int row = row0 + ai * 128 + m * 16;
                    float ss = 0.f;
#pragma unroll
                    for (int bj = 0; bj < 2; ++bj)
#pragma unroll
                        for (int n = 0; n < 2; ++n) { const f32x4 v = acc[ai][bj][m][n]; ss += (v[0] * v[0] + v[1] * v[1]) + (v[2] * v[2] + v[3] * v[3]); }
                    ss += __shfl_xor(ss, 16); ss += __shfl_xor(ss, 32);
                    const float rstd = rsqrtf(ss * (1.f / 64.f) + RMS_EPS);
                    bf16_t* rowp = O + (size_t)row * NPROJ_PAD + col0; const float* rp = rope + (size_t)row * 64 + 8 * fq;
#pragma unroll
                    for (int bj = 0; bj < 2; ++bj) { const f32x4 c0 = *(const f32x4*)(rp + 32 * bj), c1 = *(const f32x4*)(rp + 32 * bj + 4);
                        const f32x4 t1 = acc[ai][bj][m][0] * rstd * gn[bj][0], t2 = acc[ai][bj][m][1] * rstd * gn[bj][1];
                        f32x4 o1, o2;
                        o1[0] = (t1[0] * c0[0] - t2[0] * c0[1]) * sc; o2[0] = (t1[0] * c0[1] + t2[0] * c0[0]) * sc;
                        o1[1] = (t1[1] * c0[2] - t2[1] * c0[3]) * sc; o2[1] = (t1[1] * c0[3] + t2[1] * c0[2]) * sc;
                        o1[2] = (t1[2] * c1[0] - t2[2] * c1[1]) * sc; o2[2] = (t1[2] * c1[1] + t2[2] * c1[0]) * sc;
                        o1[3] = (t1[3] * c1[2] - t2[3] * c1[3]) * sc; o2[3] = (t1[3] * c1[3] + t2[3] * c1[2]) * sc;
                        u32x4 w; w.x = pk2(o1[0], o1[1]); w.y = pk2(o1[2], o1[3]); w.z = pk2(o2[0], o2[1]); w.w = pk2(o2[2], o2[3]);
                        *(u32x4*)(rowp + bj * 128) = w; } }
            return;
        }
#pragma unroll
        for (int ai = 0; ai < 2; ++ai)
#pragma unroll
            for (int m = 0; m < 4; ++m) { bf16_t* rowp = O + (size_t)(row0 + ai * 128 + m * 16) * NPROJ_PAD + col0;
#pragma unroll
                for (int bj = 0; bj < 2; ++bj) { const f32x4 v0 = acc[ai][bj][m][0], v1 = acc[ai][bj][m][1];
                    u32x4 w; w.x = pk2(v0[0], v0[1]); w.y = pk2(v0[2], v0[3]); w.z = pk2(v1[0], v1[1]); w.w = pk2(v1[2], v1[3]);
                    *(u32x4*)(rowp + bj * 128) = w; } }
        if (u.pn == 22 && wc == 0) {
#pragma unroll
            for (int ai = 0; ai < 2; ++ai)
#pragma unroll
                for (int m = 0; m < 4; ++m) { float* p = dtraw + (size_t)(row0 + ai * 128 + m * 16) * 32 + 8 * fq;
                    *(f32x4*)p = acc[ai][0][m][0]; *(f32x4*)(p + 4) = acc[ai][0][m][1]; }
        }
    }
};
struct EpiOut {
    static constexpr bool PERM = true;
    const float* x; const float* mod; bf16_t* x1; float* rss;
    __device__ __forceinline__ void operator()(const f32x4 (&acc)[2][2][4][2], const pg8::Unit& u, int wr, int wc, int fr, int fq) const {
        const int row0 = u.pm * 256 + wr * 64 + fr, col0 = u.pn * 256 + wc * 32 + 8 * fq;
        const float* gp = mod + (size_t)(u.pm >= 32 ? 1 : 0) * 12288 + 2 * D + col0;
        f32x4 gv[2][2];
#pragma unroll
        for (int bj = 0; bj < 2; ++bj)
#pragma unroll
            for (int n = 0; n < 2; ++n) gv[bj][n] = *(const f32x4*)(gp + bj * 128 + n * 4);
        f32x4 xa[2][2][2], xb[2][2][2];
#define EO_LOAD(ch_, buf_) do { _Pragma("unroll") for (int mm = 0; mm < 2; ++mm) { const float* p_ = x + (size_t)(row0 + ((ch_) >> 1) * 128 + (2 * ((ch_) & 1) + mm) * 16) * D + col0; \
            _Pragma("unroll") for (int bj = 0; bj < 2; ++bj) { buf_[mm][bj][0] = __builtin_nontemporal_load((const f32x4*)(p_ + bj * 128)); buf_[mm][bj][1] = __builtin_nontemporal_load((const f32x4*)(p_ + bj * 128 + 4)); } } } while (0)
#define EO_PROC(ch_, buf_) do { _Pragma("unroll") for (int mm = 0; mm < 2; ++mm) { const int ai_ = (ch_) >> 1, m_ = 2 * ((ch_) & 1) + mm; const size_t off = (size_t)(row0 + ai_ * 128 + m_ * 16) * D + col0; float ss = 0.f; \
            _Pragma("unroll") for (int bj = 0; bj < 2; ++bj) { const f32x4 o0 = buf_[mm][bj][0] + gv[bj][0] * acc[ai_][bj][m_][0], o1 = buf_[mm][bj][1] + gv[bj][1] * acc[ai_][bj][m_][1]; \
                ss += (o0[0] * o0[0] + o0[1] * o0[1]) + (o0[2] * o0[2] + o0[3] * o0[3]) + (o1[0] * o1[0] + o1[1] * o1[1]) + (o1[2] * o1[2] + o1[3] * o1[3]); \
                u32x4 w; w.x = pk2(o0[0], o0[1]); w.y = pk2(o0[2], o0[3]); w.z = pk2(o1[0], o1[1]); w.w = pk2(o1[2], o1[3]); \
                *(u32x4*)(x1 + off + bj * 128) = w; } \
            ss += __shfl_xor(ss, 16); ss += __shfl_xor(ss, 32); \
            if (fq == 0) rss[(size_t)(row0 + ai_ * 128 + m_ * 16) * 32 + 4 * u.pn + wc] = ss; } } while (0)
        EO_LOAD(0, xa); EO_LOAD(1, xb); asm volatile("" ::: "memory");
        EO_PROC(0, xa); asm volatile("" ::: "memory"); EO_LOAD(2, xa); asm volatile("" ::: "memory");
        EO_PROC(1, xb); asm volatile("" ::: "memory"); EO_LOAD(3, xb); asm volatile("" ::: "memory");
        EO_PROC(2, xa); EO_PROC(3, xb);
#undef EO_LOAD
#undef EO_PROC
    }
};
struct EpiGU {
    static constexpr bool PERM = true;
    bf16_t* H;
    __device__ __forceinline__ void operator()(const f32x4 (&acc)[2][2][4][2], const pg8::Unit& u, int wr, int wc, int fr, int fq) const {
        const int row0 = u.pm * 256 + wr * 64 + fr, col0 = u.pn * 128 + wc * 16 + 4 * fq;
#pragma unroll
        for (int ai = 0; ai < 2; ++ai)
#pragma unroll
            for (int m = 0; m < 4; ++m) { bf16_t* rowp = H + (size_t)(row0 + ai * 128 + m * 16) * EH + col0;
#pragma unroll
                for (int bj = 0; bj < 2; ++bj) { const f32x4 gt = acc[ai][bj][m][0], up = acc[ai][bj][m][1];
                    u32x2 w; w.x = pk2(silu_f(gt[0]) * up[0], silu_f(gt[1]) * up[1]); w.y = pk2(silu_f(gt[2]) * up[2], silu_f(gt[3]) * up[3]);
                    *(u32x2*)(rowp + bj * 64) = w; } }
    }
};
struct EpiDown {
    static constexpr bool PERM = true;
    bf16_t* Y; const LAS int* tab;
    __device__ __forceinline__ void operator()(const f32x4 (&acc)[2][2][4][2], const pg8::Unit& u, int wr, int wc, int fr, int fq) const {
        const int col0 = u.pn * 256 + wc * 32 + 8 * fq;
        const LAS int* tb = tab + u.li * 512;
#pragma unroll
        for (int ai = 0; ai < 2; ++ai)
#pragma unroll
            for (int m = 0; m < 4; ++m) { const int r = ai * 128 + wr * 64 + m * 16 + fr; const int a = tb[2 * r]; const float gt = __int_as_float(tb[2 * r + 1]);
                if (a >= 0) { bf16_t* rowp = Y + (size_t)a * D + col0;
#pragma unroll
                    for (int bj = 0; bj < 2; ++bj) { const f32x4 v0 = acc[ai][bj][m][0] * gt, v1 = acc[ai][bj][m][1] * gt;
                        u32x4 w; w.x = pk2(v0[0], v0[1]); w.y = pk2(v0[2], v0[3]); w.z = pk2(v1[0], v1[1]); w.w = pk2(v1[2], v1[3]);
                        *(u32x4*)(rowp + bj * 128) = w; } } }
    }
};
struct MoeOrder {
    const LAS int* tilebase; int ntiles, npn, G, c; const LAS unsigned* goff_tab;
    __device__ __forceinline__ bool next(int i, pg8::Unit& u) const {
        const long L = (long)i * G + c; if (L >= (long)ntiles * npn) return false;
        const int tau = (int)(L / npn); u.pn = (int)(L % npn); u.pm = tau; u.li = i;
        int e = 0;
        for (int j = 1; j < NEXP; ++j) e += (tilebase[j] <= tau) ? 1 : 0;
        u.e = e; return true;
    }
    __device__ __forceinline__ void a_ready(const pg8::Unit&) const {}
    __device__ __forceinline__ void done(const pg8::Unit&) const {}
    __device__ __forceinline__ void load_goff(const pg8::Unit& u, unsigned (&goff)[2][2], const int (&RA)[2], const int (&CA)[2]) const {
        const LAS unsigned* tb = goff_tab + u.li * 256;
#pragma unroll
        for (int h = 0; h < 2; ++h)
#pragma unroll
            for (int i = 0; i < 2; ++i) goff[h][i] = tb[h * 128 + RA[i]] + (unsigned)CA[i] * 2u;
    }
};

struct Args { const void* in[24]; float* out; unsigned char* ws; int ph_lo, ph_hi; };
enum InIdx { I_X = 0, I_C, I_POS, I_WADA, I_BADA, I_N1G, I_WIN, I_CONVW, I_CONVB, I_DTBIAS, I_ALOG, I_DSKIP, I_SSDG, I_QG, I_KG, I_WOUT, I_N2G, I_WRG, I_BRG, I_WRE, I_BRE, I_WG, I_WU, I_WD };

__device__ __forceinline__ int vcu_id() { const int G = gridDim.x, bx = blockIdx.x; return (G % 8 == 0) ? (bx % 8) * (G / 8) + bx / 8 : bx; }
__device__ __forceinline__ float wave_sum(float v) {
#pragma unroll
    for (int o = 1; o < 64; o <<= 1) v += __shfl_xor(v, o);
    return v;
}

__device__ __forceinline__ void p0_adaln(const float* c, const float* w_ada, const float* b_ada, float* mod, LAS float* lds) {
    const int tid = threadIdx.x;
    LAS float* sc = lds; LAS float* red = lds + 4096;
    { const f32x4 c0 = *(const f32x4*)(c + 8 * tid), c1 = *(const f32x4*)(c + 8 * tid + 4);
#pragma unroll
      for (int j = 0; j < 4; ++j) { sc[8 * tid + j] = silu_f(c0[j]); sc[8 * tid + 4 + j] = silu_f(c1[j]); } }
    __syncthreads();
    for (int cg = blockIdx.x; cg < 256; cg += gridDim.x) {
        if (tid < 504) {
            const int c4 = tid % 12, r0 = tid / 12;
            f32x4 a0 = {0.f, 0.f, 0.f, 0.f}, a1 = {0.f, 0.f, 0.f, 0.f};
            const float* wp = w_ada + 48 * cg + 4 * c4;
#pragma unroll 7
            for (int k = r0; k < D; k += 42) { const f32x4 w = __builtin_nontemporal_load((const f32x4*)(wp + (size_t)k * 12288)); a0 += w * sc[k]; a1 += w * sc[D + k]; }
            LAS float* rp = red + (r0 * 12 + c4) * 8;
            rp[0] = a0[0]; rp[1] = a0[1]; rp[2] = a0[2]; rp[3] = a0[3]; rp[4] = a1[0]; rp[5] = a1[1]; rp[6] = a1[2]; rp[7] = a1[3];
        }
        __syncthreads();
        if (tid < 96) {
            const int c4 = tid >> 3, j = tid & 7; float s = 0.f;
            for (int r = 0; r < 42; ++r) s += red[(r * 12 + c4) * 8 + j];
            const int col = 48 * cg + 4 * c4 + (j & 3);
            mod[(j >> 2) * 12288 + col] = s + b_ada[col];
        }
        __syncthreads();
    }
}
template <class RowMap>
__device__ __forceinline__ void transpose_item(const float* W, int ldw, int nvalid, bf16_t* WT, int ldt, int k0, int n0, LAS float* scr, int lane, RowMap rm) {
#pragma unroll 4
    for (int it = 0; it < 16; ++it) {
        const int kk = 4 * it + (lane >> 4), n = n0 + 4 * (lane & 15);
        f32x4 v = {0.f, 0.f, 0.f, 0.f};
        if (n < nvalid) v = __builtin_nontemporal_load((const f32x4*)(W + (size_t)(k0 + kk) * ldw + n));
        LAS float* s = scr + kk * 65 + 4 * (lane & 15);
        s[0] = v[0]; s[1] = v[1]; s[2] = v[2]; s[3] = v[3];
    }
    LDS_WAIT(); asm volatile("" ::: "memory");
    const int c = lane & 7;
#pragma unroll
    for (int j = 0; j < 8; ++j) {
        const int nn = (lane >> 3) + 8 * j, n = n0 + nn;
        const LAS float* s = scr + (8 * c) * 65 + nn;
        u32x4 o; o.x = pk2(s[0], s[65]); o.y = pk2(s[2 * 65], s[3 * 65]); o.z = pk2(s[4 * 65], s[5 * 65]); o.w = pk2(s[6 * 65], s[7 * 65]);
        if (n < nvalid) *(u32x4*)(WT + (size_t)rm(n) * ldt + k0 + 8 * c) = o;
    }
    LDS_WAIT(); asm volatile("" ::: "memory");
}
struct RmId { __device__ __forceinline__ int operator()(int n) const { return n; } };
struct RmIn { __device__ __forceinline__ int operator()(int c) const { if (c >= 2048) return c; const int blk = c & ~1023, hd = (c >> 6) & 15, i = c & 63;
    return blk + 256 * (hd >> 2) + 128 * ((i >> 4) & 1) + 32 * (hd & 3) + 8 * ((i >> 2) & 3) + 4 * (i >> 5) + (i & 3); } };
struct RmGU { int add; __device__ __forceinline__ int operator()(int n) const { return 8 * (n >> 2) + add + (n & 3); } };

__device__ __forceinline__ void p0_prologue(const Args& A, LAS unsigned char* lds) {
    const int tid = threadIdx.x, lane = tid & 63, wave = tid >> 6;
    unsigned char* ws = A.ws;
    p0_adaln((const float*)A.in[I_C], (const float*)A.in[I_WADA], (const float*)A.in[I_BADA], (float*)(ws + WS_MOD), (LAS float*)lds);
    const int gtid = blockIdx.x * 512 + tid, NT = gridDim.x * 512;
    { const int* pos = (const int*)A.in[I_POS]; float* rope = (float*)(ws + WS_ROPE);
      const int f = gtid & 31; const float invf = powf(10000.0f, -(float)f / 32.0f);
      for (int t0 = gtid >> 5; t0 < T; t0 += 4 * (NT >> 5)) { int pv[4];
#pragma unroll
          for (int u = 0; u < 4; ++u) { const int t = t0 + u * (NT >> 5); pv[u] = pos[t < T ? t : T - 1]; }
#pragma unroll
          for (int u = 0; u < 4; ++u) { const int t = t0 + u * (NT >> 5); if (t < T) { const float ang = (float)pv[u] * invf;
              const double rev = (double)ang * 0.15915494309189533577; const float fr = (float)(rev - rint(rev));
              f32x2 cs = {__builtin_amdgcn_cosf(fr), __builtin_amdgcn_sinf(fr)}; *(f32x2*)(rope + 2 * (t * 32 + f)) = cs; } } } }
    { const float* wrg = (const float*)A.in[I_WRG]; const float* wre = (const float*)A.in[I_WRE]; bf16_t* hi = (bf16_t*)(ws + WS_WRT);
      for (int i = gtid; i < NRT * D; i += NT) { const int n = i / D, k = i % D; float w = 0.f;
          if (n < 8) w = wrg[k * 8 + n]; else if (n >= 16) w = wre[k * 64 + (n - 16)];
          hi[i] = (bf16_t)f2bf(w); } }
    { u32x4* z = (u32x4*)(ws + WS_WINT + (size_t)NPROJ * D * 2); const int n16 = (NPROJ_PAD - NPROJ) * D * 2 / 16;
      for (int i = gtid; i < n16; i += NT) z[i] = (u32x4){0u, 0u, 0u, 0u}; }
    __syncthreads();
    LAS float* scr = (LAS float*)(lds) + wave * (64 * 65);
    const int gw = blockIdx.x * 8 + wave, NGW = gridDim.x * 8;
    constexpr int I_IN = 32 * 89;
    const float* W = (const float*)A.in[I_WIN]; bf16_t* WT = (bf16_t*)(ws + WS_WINT);
    f32x4 va[16], vb[16];
#define WIN_LOAD(it_, v_) do { const int k0_ = 64 * ((it_) / 89), n_ = 64 * ((it_) % 89) + 4 * (lane & 15); const float* p_ = W + (size_t)(k0_ + (lane >> 4)) * NPROJ + (n_ < NPROJ ? n_ : NPROJ - 4); \
        _Pragma("unroll") for (int i_ = 0; i_ < 16; ++i_) v_[i_] = __builtin_nontemporal_load((const f32x4*)(p_ + (size_t)(4 * i_) * NPROJ)); } while (0)
#define WIN_STORE(it_, v_) do { const int k0_ = 64 * ((it_) / 89), n0_ = 64 * ((it_) % 89); \
        _Pragma("unroll") for (int i_ = 0; i_ < 16; ++i_) { LAS float* sp_ = scr + (4 * i_ + (lane >> 4)) * 65 + 4 * (lane & 15); sp_[0] = v_[i_][0]; sp_[1] = v_[i_][1]; sp_[2] = v_[i_][2]; sp_[3] = v_[i_][3]; } \
        LDS_WAIT(); asm volatile("" ::: "memory"); const int c_ = lane & 7; \
        _Pragma("unroll") for (int j_ = 0; j_ < 8; ++j_) { const int nn_ = (lane >> 3) + 8 * j_, n_ = n0_ + nn_; const LAS float* sp_ = scr + (8 * c_) * 65 + nn_; \
            u32x4 o_; o_.x = pk2(sp_[0], sp_[65]); o_.y = pk2(sp_[2 * 65], sp_[3 * 65]); o_.z = pk2(sp_[4 * 65], sp_[5 * 65]); o_.w = pk2(sp_[6 * 65], sp_[7 * 65]); \
            if (n_ < NPROJ) *(u32x4*)(WT + (size_t)RmIn{}(n_) * D + k0_ + 8 * c_) = o_; } \
        LDS_WAIT(); asm volatile("" ::: "memory"); } while (0)
    int it = gw;
    if (it < I_IN) WIN_LOAD(it, va);
    while (it < I_IN) {
        const bool hb = it + NGW < I_IN;
        if (hb) WIN_LOAD(it + NGW, vb);
        WIN_STORE(it, va);
        if (!hb) break;
        const bool ha = it + 2 * NGW < I_IN;
        if (ha) WIN_LOAD(it + 2 * NGW, va);
        WIN_STORE(it + NGW, vb);
        if (!ha) break;
        it += 2 * NGW;
    }
#undef WIN_LOAD
#undef WIN_STORE
}
struct TItem { const float* src; bf16_t* dst; int ldw, ldt, gu, n0; };
__device__ __forceinline__ void late_item(const Args& A, int it, TItem& d) {
    unsigned char* ws = A.ws;
    constexpr int I_OUT = 32 * 32, I_E = 32 * 8, I_DN = 8 * 32;
    int r = it;
    if (r < I_OUT) { const int k0 = 64 * (r / 32), n0 = 64 * (r % 32); d.src = (const float*)A.in[I_WOUT] + (size_t)k0 * D + n0; d.dst = (bf16_t*)(ws + WS_WOUTT) + k0; d.ldw = D; d.ldt = D; d.gu = -1; d.n0 = n0; return; }
    r -= I_OUT;
    const int e = r / (2 * I_E + I_DN); r -= e * (2 * I_E + I_DN);
    if (r < 2 * I_E) { const int up = r >= I_E ? 1 : 0; r -= up * I_E; const int k0 = 64 * (r / 8), n0 = 64 * (r % 8);
        d.src = (const float*)A.in[up ? I_WU : I_WG] + (size_t)e * D * EH + (size_t)k0 * EH + n0; d.dst = (bf16_t*)(ws + WS_WGUT) + (size_t)e * 1024 * D + k0; d.ldw = EH; d.ldt = D; d.gu = 4 * up; d.n0 = n0; return; }
    r -= 2 * I_E;
    { const int k0 = 64 * (r / 32), n0 = 64 * (r % 32); d.src = (const float*)A.in[I_WD] + (size_t)e * EH * D + (size_t)k0 * D + n0; d.dst = (bf16_t*)(ws + WS_WDT) + (size_t)e * D * EH + k0; d.ldw = D; d.ldt = EH; d.gu = -1; d.n0 = n0; }
}
__device__ __forceinline__ void titem_load(const TItem& d, f32x4 (&v)[16], int lane) {
    const float* p = d.src + (size_t)(lane >> 4) * d.ldw + 4 * (lane & 15);
#pragma unroll
    for (int i = 0; i < 16; ++i) v[i] = __builtin_nontemporal_load((const f32x4*)(p + (size_t)(4 * i) * d.ldw));
}
__device__ __forceinline__ void titem_store(const TItem& d, const f32x4 (&v)[16], LAS float* scr, int lane) {
#pragma unroll
    for (int i = 0; i < 16; ++i) { LAS float* sp = scr + (4 * i + (lane >> 4)) * 65 + 4 * (lane & 15); sp[0] = v[i][0]; sp[1] = v[i][1]; sp[2] = v[i][2]; sp[3] = v[i][3]; }
    LDS_WAIT(); asm volatile("" ::: "memory");
    const int c = lane & 7;
#pragma unroll
    for (int j = 0; j < 8; ++j) { const int nn = (lane >> 3) + 8 * j, n = d.n0 + nn; const LAS float* sp = scr + (8 * c) * 65 + nn;
        u32x4 o; o.x = pk2(sp[0], sp[65]); o.y = pk2(sp[2 * 65], sp[3 * 65]); o.z = pk2(sp[4 * 65], sp[5 * 65]); o.w = pk2(sp[6 * 65], sp[7 * 65]);
        const int row = d.gu < 0 ? n : (8 * (n >> 2) + d.gu + (n & 3));
        __builtin_nontemporal_store(o, (u32x4*)(d.dst + (size_t)row * d.ldt + 8 * c)); }
    LDS_WAIT(); asm volatile("" ::: "memory");
}
__device__ __forceinline__ int claim_items(unsigned* ctr, unsigned n) { unsigned v = 0; if ((threadIdx.x & 63) == 0) v = __hip_atomic_fetch_add(ctr, n, __ATOMIC_RELAXED, __HIP_MEMORY_SCOPE_AGENT); return (int)__builtin_amdgcn_readfirstlane(v); }
__device__ __forceinline__ void p2_convert_late(const Args& A, LAS unsigned char* lds) {
    const int lane = threadIdx.x & 63, wave = threadIdx.x >> 6;
    LAS float* scr = (LAS float*)(lds) + wave * (64 * 65);
    unsigned* ctr = (unsigned*)(A.ws + WS_CTL) + CW_FLAG + 64;
    constexpr int NITEMS = 32 * 32 + NEXP * (2 * 32 * 8 + 8 * 32), CB = 16;
    int base = claim_items(ctr, CB), pos = 0;
#define CONV_NEXT() ({ if (pos == CB) { base = claim_items(ctr, CB); pos = 0; } const int r_ = base + pos; ++pos; r_; })
#define CONV_PROC(d_, v_, itn_) do { \
        _Pragma("unroll") for (int i = 0; i < 16; ++i) { LAS float* sp = scr + (4 * i + (lane >> 4)) * 65 + 4 * (lane & 15); sp[0] = v_[i][0]; sp[1] = v_[i][1]; sp[2] = v_[i][2]; sp[3] = v_[i][3]; } \
        const TItem dc_ = d_; late_item(A, (itn_) < NITEMS ? (itn_) : NITEMS - 1, d_); titem_load(d_, v_, lane); \
        LDS_WAIT(); asm volatile("" ::: "memory"); \
        const int c = lane & 7; \
        _Pragma("unroll") for (int j = 0; j < 8; ++j) { const int nn = (lane >> 3) + 8 * j, n = dc_.n0 + nn; const LAS float* sp = scr + (8 * c) * 65 + nn; \
            u32x4 o; o.x = pk2(sp[0], sp[65]); o.y = pk2(sp[2 * 65], sp[3 * 65]); o.z = pk2(sp[4 * 65], sp[5 * 65]); o.w = pk2(sp[6 * 65], sp[7 * 65]); \
            const int row = dc_.gu < 0 ? n : (8 * (n >> 2) + dc_.gu + (n & 3)); \
            __builtin_nontemporal_store(o, (u32x4*)(dc_.dst + (size_t)row * dc_.ldt + 8 * c)); } \
        LDS_WAIT(); asm volatile("" ::: "memory"); } while (0)
    TItem da, db; f32x4 va[16], vb[16];
    int ia = CONV_NEXT(), ib = CONV_NEXT();
    late_item(A, ia < NITEMS ? ia : NITEMS - 1, da); titem_load(da, va, lane);
    late_item(A, ib < NITEMS ? ib : NITEMS - 1, db); titem_load(db, vb, lane);
#pragma unroll 1
    for (;;) {
        if (ia >= NITEMS) break;
        { const int in = CONV_NEXT(); CONV_PROC(da, va, in); ia = in; }
        if (ib >= NITEMS) break;
        { const int in = CONV_NEXT(); CONV_PROC(db, vb, in); ib = in; }
    }
#undef CONV_NEXT
#undef CONV_PROC
}

__device__ __forceinline__ void p1_norm1(const Args& A) {
    const int tid = threadIdx.x, lane = tid & 63, wave = tid >> 6;
    const float* x = (const float*)A.in[I_X]; const float* g1 = (const float*)A.in[I_N1G]; const float* mod = (const float*)(A.ws + WS_MOD);
    bf16_t* hb = (bf16_t*)(A.ws + WS_HB);
    const int gw = blockIdx.x * 8 + wave, NGW = gridDim.x * 8, NB = NGW / BATCH, bsel = gw / NB, r0 = gw - bsel * NB;
    if (bsel >= BATCH) return;
    const float* mb = mod + bsel * 12288;
    f32x4 ca[8], cs[8];
#pragma unroll
    for (int j = 0; j < 8; ++j) { const int col = 4 * lane + 256 * j; const f32x4 g = *(const f32x4*)(g1 + col), sc = *(const f32x4*)(mb + D + col); ca[j] = g * (sc + 1.f); cs[j] = *(const f32x4*)(mb + col); }
    f32x4 v[8], vn[8];
    if (r0 < SEQ) { const f32x4* xr = (const f32x4*)(x + (size_t)(bsel * SEQ + r0) * D) + lane;
#pragma unroll
        for (int j = 0; j < 8; ++j) vn[j] = __builtin_nontemporal_load(xr + 64 * j); }
    for (int r = r0; r < SEQ; r += NB) { const int m = bsel * SEQ + r;
#pragma unroll
        for (int j = 0; j < 8; ++j) v[j] = vn[j];
        if (r + NB < SEQ) { const f32x4* xr = (const f32x4*)(x + (size_t)(m + NB) * D) + lane;
#pragma unroll
            for (int j = 0; j < 8; ++j) vn[j] = __builtin_nontemporal_load(xr + 64 * j); }
        float s = 0.f;
#pragma unroll
        for (int j = 0; j < 8; ++j) s += (v[j][0] * v[j][0] + v[j][1] * v[j][1]) + (v[j][2] * v[j][2] + v[j][3] * v[j][3]);
        const float rstd = rsqrtf(wave_sum(s) * (1.f / D) + RMS_EPS);
        u32x2* o = (u32x2*)(hb + (size_t)m * D) + lane;
#pragma unroll
        for (int j = 0; j < 8; ++j) { const f32x4 h = (v[j] * rstd) * ca[j] + cs[j];
            u32x2 w; w.x = pk2(h[0], h[1]); w.y = pk2(h[2], h[3]); o[64 * j] = w; }
    }
}

__device__ __forceinline__ void p3_post(const Args& A, int dryA, int repB) {
    const int tid = threadIdx.x, lane = tid & 63, wave = tid >> 6;
    unsigned char* ws = A.ws;
    bf16_t* proj = (bf16_t*)(ws + WS_PROJ);
    const int gw = blockIdx.x * 8 + wave, NGW = gridDim.x * 8;
    for (int rb = 0; rb < repB; ++rb) { const float* cw = (const float*)A.in[I_CONVW]; const float* cb = (const float*)A.in[I_CONVB]; bf16_t* xc = (bf16_t*)(ws + WS_HB);
      for (int tb = gw; tb < T / 8; tb += NGW) {
          const int t0 = tb * 8, s0 = t0 & (SEQ - 1), sb = t0 - s0;
          u32x4 ra[12]; f32x4 wa[5], wb[5], ba, bb;
#define P3_LOAD(c8_, r_, wa_, wb_, ba_, bb_) do { const bf16_t* pc_ = proj + OFF_XBC + (c8_); \
              _Pragma("unroll") for (int k = 0; k < 12; ++k) { int t_ = t0 + k - 2; t_ = t_ < sb ? sb : t_; t_ = t_ > sb + SEQ - 1 ? sb + SEQ - 1 : t_; r_[k] = *(const u32x4*)(pc_ + (size_t)t_ * NPROJ_PAD); } \
              _Pragma("unroll") for (int k = 0; k < 5; ++k) { wa_[k] = *(const f32x4*)(cw + k * XBCW + (c8_)); wb_[k] = *(const f32x4*)(cw + k * XBCW + (c8_) + 4); } \
              ba_ = *(const f32x4*)(cb + (c8_)); bb_ = *(const f32x4*)(cb + (c8_) + 4); } while (0)
#pragma unroll 1
          for (int st = 0; st < 3; ++st) { const int c8 = 8 * (lane + 64 * st);
              P3_LOAD(c8, ra, wa, wb, ba, bb);
              if (s0 == 0) { ra[0] = (u32x4){0u, 0u, 0u, 0u}; ra[1] = (u32x4){0u, 0u, 0u, 0u}; }
              if (s0 == SEQ - 8) { ra[10] = (u32x4){0u, 0u, 0u, 0u}; ra[11] = (u32x4){0u, 0u, 0u, 0u}; }
#pragma unroll
              for (int j = 0; j < 8; ++j) {
                  f32x4 a0 = ba, a1 = bb;
#pragma unroll
                  for (int k = 0; k < 5; ++k) { const u32x4 w = ra[j + k];
                      a0[0] += lo_f(w.x) * wa[k][0]; a0[1] += hi_f(w.x) * wa[k][1]; a0[2] += lo_f(w.y) * wa[k][2]; a0[3] += hi_f(w.y) * wa[k][3];
                      a1[0] += lo_f(w.z) * wb[k][0]; a1[1] += hi_f(w.z) * wb[k][1]; a1[2] += lo_f(w.w) * wb[k][2]; a1[3] += hi_f(w.w) * wb[k][3]; }
                  u32x4 o; o.x = pk2(silu_f(a0[0]), silu_f(a0[1])); o.y = pk2(silu_f(a0[2]), silu_f(a0[3])); o.z = pk2(silu_f(a1[0]), silu_f(a1[1])); o.w = pk2(silu_f(a1[2]), silu_f(a1[3]));
                  *(u32x4*)(xc + (size_t)(t0 + j) * XBCW + c8) = o; }
          }
#undef P3_LOAD
      } }
    { const float* dtraw = (const float*)(ws + WS_DTRAW); const float* dtbias = (const float*)A.in[I_DTBIAS]; const float* alog = (const float*)A.in[I_ALOG];
      float* dtf = (float*)(ws + WS_DTF); float* dtb = (float*)(ws + WS_DTB); float* acs = (float*)(ws + WS_ACS); float* rcs = (float*)(ws + WS_RCS); float* dec = (float*)(ws + WS_DEC);
      const int h = lane & 15, q = lane >> 4;
      for (int it = gw; it < BATCH * NCHUNK * 2; it += NGW) {
          const int dir = it & 1, bc = it >> 1; const int t0 = bc * CHUNK + 32 * q;
          const float aneg = -__expf(alog[dir * 16 + h]), bias = dtbias[dir * 16 + h];
          float d[32];
#pragma unroll
          for (int i = 0; i < 32; ++i) d[i] = dtraw[(size_t)(t0 + i) * 32 + dir * 16 + h];
          float tot = 0.f;
#pragma unroll
          for (int i = 0; i < 32; ++i) { const float r = d[i] + bias; d[i] = r > 20.f ? r : log1pf(__expf(r)); tot += d[i] * aneg; }
          const float t1 = __shfl_xor(tot, 16), t2 = __shfl_xor(tot, 32), t3 = __shfl_xor(tot, 48);
          float tq[4]; tq[q] = tot; tq[q ^ 1] = t1; tq[q ^ 2] = t2; tq[q ^ 3] = t3;
          float base = 0.f;
          if (dir == 0) { for (int j = 0; j < 4; ++j) if (j < q) base += tq[j]; } else { for (int j = 0; j < 4; ++j) if (j > q) base += tq[j]; }
          float* dd = dir ? dtb : dtf; float* cc = dir ? rcs : acs;
          if (dir == 0) { float run = base;
#pragma unroll
              for (int i = 0; i < 32; ++i) { run += d[i] * aneg; dd[(size_t)(t0 + i) * 16 + h] = d[i]; cc[(size_t)(t0 + i) * 16 + h] = run; } }
          else { float run = base;
#pragma unroll
              for (int i = 31; i >= 0; --i) { run += d[i] * aneg; dd[(size_t)(t0 + i) * 16 + h] = d[i]; cc[(size_t)(t0 + i) * 16 + h] = run; } }
          if (q == 0) dec[bc * 32 + dir * 16 + h] = __expf(tq[0] + tq[1] + tq[2] + tq[3]);
      } }
}

__device__ __forceinline__ bf16x8 mk_frag(u32x4 w) { return __builtin_bit_cast(bf16x8, w); }
__device__ __forceinline__ f32x4 mfma16(bf16x8 a, bf16x8 b, f32x4 c) { return __builtin_amdgcn_mfma_f32_16x16x32_bf16(a, b, c, 0, 0, 0); }

typedef short v4i16_t __attribute__((ext_vector_type(4)));
__device__ __forceinline__ u32x2 lds_tr16(const LAS bf16_t* p) { return __builtin_bit_cast(u32x2, __builtin_amdgcn_ds_read_tr16_b64_v4i16((LAS v4i16_t*)p)); }
__device__ __forceinline__ bf16x8 lds_tr16x2(const LAS bf16_t* p, int rowstep4) { const u32x2 a = lds_tr16(p), b = lds_tr16(p + rowstep4); u32x4 w; w.x = a.x; w.y = a.y; w.z = b.x; w.w = b.y; return mk_frag(w); }

constexpr int SP = 136;
constexpr int XP = 72;
__device__ __forceinline__ void p4_ssd_local(const Args& A, LAS unsigned char* lds, int rep) {
    const int tid = threadIdx.x, lane = tid & 63, w = __builtin_amdgcn_readfirstlane(tid >> 6), fr = lane & 15, fq = lane >> 4;
    unsigned char* ws = A.ws;
    const bf16_t* xc = (const bf16_t*)(ws + WS_HB);
    const float* DTF = (const float*)(ws + WS_DTF); const float* DTB = (const float*)(ws + WS_DTB); const float* ACS = (const float*)(ws + WS_ACS); const float* RCS = (const float*)(ws + WS_RCS);
    bf16_t* YD = (bf16_t*)(ws + WS_YD); bf16_t* ST = (bf16_t*)(ws + WS_ST);
    LAS bf16_t* Cs = (LAS bf16_t*)lds; LAS bf16_t* Bs = (LAS bf16_t*)(lds + 34816);
    LAS bf16_t* Xs = (LAS bf16_t*)(lds + 69632);
    LAS float* VEC = (LAS float*)(lds + 69632 + 36864);
    const int sl = tid >> 2, sq = tid & 3;
    for (int uu = vcu_id(); uu < BATCH * NCHUNK * 2 * rep; uu += gridDim.x) { const int u = uu & 255;
        const int b = u >> 7, c = (u >> 1) & 63, g = u & 1; const int t0 = b * SEQ + c * CHUNK;
        u32x4 xv[2]; float vv[6];
#define P4_XLOAD(h_) do { const bf16_t* src_ = xc + (size_t)(t0 + sl) * XBCW + 64 * (h_) + 16 * sq; xv[0] = *(const u32x4*)src_; xv[1] = *(const u32x4*)(src_ + 8); \
            if (tid < 128) { const size_t o_ = (size_t)(t0 + tid) * 16 + (h_); vv[0] = DTF[o_]; vv[1] = DTB[o_]; vv[2] = ACS[o_]; vv[3] = RCS[o_]; vv[4] = ACS[(size_t)(t0 + 127) * 16 + (h_)]; vv[5] = RCS[(size_t)t0 * 16 + (h_)]; } } while (0)
#define P4_XSTORE(buf_) do { *(LAS u32x4*)(Xs + (buf_) * (128 * XP) + sl * XP + 16 * sq) = xv[0]; *(LAS u32x4*)(Xs + (buf_) * (128 * XP) + sl * XP + 16 * sq + 8) = xv[1]; \
            if (tid < 128) { LAS float* v_ = VEC + (buf_) * 768; v_[tid] = vv[0]; v_[128 + tid] = vv[1]; v_[256 + tid] = vv[2]; v_[384 + tid] = vv[3]; v_[512 + tid] = __expf(vv[4] - vv[2]) * vv[0]; v_[640 + tid] = __expf(vv[5] - vv[3]) * vv[1]; } } while (0)
        { const bf16_t* src = xc + (size_t)(t0 + sl) * XBCW + 1024 + 128 * g + 32 * sq;
#pragma unroll
          for (int i = 0; i < 4; ++i) { *(LAS u32x4*)(Bs + sl * SP + 32 * sq + 8 * i) = *(const u32x4*)(src + 8 * i); *(LAS u32x4*)(Cs + sl * SP + 32 * sq + 8 * i) = *(const u32x4*)(src + 256 + 8 * i); } }
        P4_XLOAD(8 * g);
        __syncthreads();
        { bf16x8 cf[4];
#pragma unroll
          for (int ks = 0; ks < 4; ++ks) cf[ks] = *(const LAS bf16x8*)(Cs + (16 * w + fr) * SP + 32 * ks + 8 * fq);
          u32x2 cbw[8];
#pragma unroll
          for (int st = 0; st < 8; ++st) { f32x4 acc = {0.f, 0.f, 0.f, 0.f};
#pragma unroll
              for (int ks = 0; ks < 4; ++ks) acc = mfma16(*(const LAS bf16x8*)(Bs + (16 * st + fr) * SP + 32 * ks + 8 * fq), cf[ks], acc);
              cbw[st].x = pk2(acc[0], acc[1]); cbw[st].y = pk2(acc[2], acc[3]); }
#pragma unroll
          for (int st = 0; st < 8; ++st) *(LAS u32x2*)(Cs + (16 * w + fr) * SP + 16 * st + 4 * fq) = cbw[st]; }
        bf16x8 btf[4];
#pragma unroll
        for (int ks = 0; ks < 4; ++ks) btf[ks] = lds_tr16x2(Bs + (32 * ks + 8 * fq + (fr >> 2)) * SP + 16 * w + 4 * (fr & 3), 4 * SP);
        P4_XSTORE(0);
        __syncthreads();
        for (int hh = 0; hh < 8; ++hh) {
            const int h = 8 * g + hh, buf = hh & 1;
            P4_XLOAD(hh < 7 ? h + 1 : h);
            const LAS bf16_t* Xb = Xs + buf * (128 * XP); const LAS float* V = VEC + buf * 768;
            { const int l = 16 * w + fr; const float ac_l = V[256 + l], rc_l = V[384 + l];
              f32x4 acc[4], sf[4], sb[4];
#pragma unroll
              for (int pt = 0; pt < 4; ++pt) { acc[pt] = (f32x4){0.f, 0.f, 0.f, 0.f}; sf[pt] = (f32x4){0.f, 0.f, 0.f, 0.f}; sb[pt] = (f32x4){0.f, 0.f, 0.f, 0.f}; }
#pragma unroll
              for (int ks = 0; ks < 4; ++ks) { const int s0 = 32 * ks + 8 * fq;
                  bf16x8 xf[4];
#pragma unroll
                  for (int pt = 0; pt < 4; ++pt) xf[pt] = lds_tr16x2(Xb + (s0 + (fr >> 2)) * XP + 16 * pt + 4 * (fr & 3), 4 * XP);
                  const u32x4 cb = *(const LAS u32x4*)(Cs + l * SP + s0); const unsigned cw[4] = {cb.x, cb.y, cb.z, cb.w};
                  f32x4 vd[6][2];
#pragma unroll
                  for (int a = 0; a < 6; ++a) { vd[a][0] = *(const LAS f32x4*)(V + 128 * a + s0); vd[a][1] = *(const LAS f32x4*)(V + 128 * a + s0 + 4); }
                  float mv[8];
#pragma unroll
                  for (int j = 0; j < 8; ++j) { const int s = s0 + j; const float cbj = (j & 1) ? hi_f(cw[j >> 1]) : lo_f(cw[j >> 1]);
                      const float df = vd[0][j >> 2][j & 3], db = vd[1][j >> 2][j & 3], ac = vd[2][j >> 2][j & 3], rc = vd[3][j >> 2][j & 3];
                      const float arg = (s < l) ? (ac_l - ac) : (rc_l - rc);
                      const float wg = (s < l) ? df : ((s > l) ? db : df + db);
                      mv[j] = cbj * __expf(arg) * wg; }
                  u32x4 mw; mw.x = pk2(mv[0], mv[1]); mw.y = pk2(mv[2], mv[3]); mw.z = pk2(mv[4], mv[5]); mw.w = pk2(mv[6], mv[7]);
                  const bf16x8 mfr = mk_frag(mw);
#pragma unroll
                  for (int pt = 0; pt < 4; ++pt) acc[pt] = mfma16(xf[pt], mfr, acc[pt]);
                  bf16x8 bff, bfb;
                  { const u32x4 bw = __builtin_bit_cast(u32x4, btf[ks]);
                    const float b0 = lo_f(bw.x), b1 = hi_f(bw.x), b2 = lo_f(bw.y), b3 = hi_f(bw.y), b4 = lo_f(bw.z), b5 = hi_f(bw.z), b6 = lo_f(bw.w), b7 = hi_f(bw.w);
                    const f32x4 f0 = vd[4][0], f1 = vd[4][1], g0 = vd[5][0], g1 = vd[5][1];
                    u32x4 aw; aw.x = pk2(b0 * f0[0], b1 * f0[1]); aw.y = pk2(b2 * f0[2], b3 * f0[3]); aw.z = pk2(b4 * f1[0], b5 * f1[1]); aw.w = pk2(b6 * f1[2], b7 * f1[3]); bff = mk_frag(aw);
                    aw.x = pk2(b0 * g0[0], b1 * g0[1]); aw.y = pk2(b2 * g0[2], b3 * g0[3]); aw.z = pk2(b4 * g1[0], b5 * g1[1]); aw.w = pk2(b6 * g1[2], b7 * g1[3]); bfb = mk_frag(aw); }
#pragma unroll
                  for (int pt = 0; pt < 4; ++pt) { sf[pt] = mfma16(bff, xf[pt], sf[pt]); sb[pt] = mfma16(bfb, xf[pt], sb[pt]); } }
              bf16_t* stf = ST + ((size_t)(((b * NCHUNK + c) * 2) * 16 + h)) * 8192; bf16_t* stb = stf + (size_t)16 * 8192;
#pragma unroll
              for (int pt = 0; pt < 4; ++pt) { u32x2 o; o.x = pk2(acc[pt][0], acc[pt][1]); o.y = pk2(acc[pt][2], acc[pt][3]);
                  *(u32x2*)(YD + (size_t)(t0 + l) * 1024 + 64 * h + 16 * pt + 4 * fq) = o;
                  o.x = pk2(sf[pt][0], sf[pt][1]); o.y = pk2(sf[pt][2], sf[pt][3]); *(u32x2*)(stf + (16 * pt + fr) * 128 + 16 * w + 4 * fq) = o;
                  o.x = pk2(sb[pt][0], sb[pt][1]); o.y = pk2(sb[pt][2], sb[pt][3]); *(u32x2*)(stb + (16 * pt + fr) * 128 + 16 * w + 4 * fq) = o; } }
            if (hh < 7) P4_XSTORE(buf ^ 1);
            __syncthreads();
        }
#undef P4_XLOAD
#undef P4_XSTORE
    }
}

__device__ __forceinline__ void p5_scan(const Args& A) {
    bf16_t* ST = (bf16_t*)(A.ws + WS_ST); const float* DEC = (const float*)(A.ws + WS_DEC);
    const int gtid = blockIdx.x * 512 + threadIdx.x, NT = gridDim.x * 512;
    for (int i = gtid; i < BATCH * 2 * 16 * 2048; i += NT) {
        const int e4 = i & 2047, h = (i >> 11) & 15, dir = (i >> 15) & 1, b = i >> 16;
        f32x4 st = {0.f, 0.f, 0.f, 0.f};
        for (int cc = 0; cc < NCHUNK; cc += 16) {
            u32x2 v[16]; float dc[16];
#pragma unroll
            for (int j = 0; j < 16; ++j) { const int c = dir ? (NCHUNK - 1 - (cc + j)) : (cc + j);
                v[j] = *(const u32x2*)(ST + ((size_t)(((b * NCHUNK + c) * 2 + dir) * 16 + h)) * 8192 + 4 * e4); dc[j] = DEC[(b * NCHUNK + c) * 32 + dir * 16 + h]; }
#pragma unroll
            for (int j = 0; j < 16; ++j) { const int c = dir ? (NCHUNK - 1 - (cc + j)) : (cc + j);
                u32x2 o; o.x = pk2(st[0], st[1]); o.y = pk2(st[2], st[3]);
                *(u32x2*)(ST + ((size_t)(((b * NCHUNK + c) * 2 + dir) * 16 + h)) * 8192 + 4 * e4) = o;
                const f32x4 sv = {lo_f(v[j].x), hi_f(v[j].x), lo_f(v[j].y), hi_f(v[j].y)}; st = st * dc[j] + sv; }
        }
    }
}

constexpr int KP = 72;
struct AttnRun { int br, b, h, d, cls, blk0, nblk, n; };
__device__ __forceinline__ void attn_run(int su, int q, AttnRun& a) { const int bh = su >> 3, r8 = su & 7; a.b = bh >> 4; a.h = bh & 15;
    if (q == 0) { a.br = 0; a.cls = 0; a.blk0 = 8 * r8; a.nblk = 8; } else if (q == 1) { a.br = 1; a.cls = r8 >> 1; a.blk0 = 8 * (r8 & 1); a.nblk = 8; } else { a.br = 2; a.cls = 2 * r8 + (q - 2); a.blk0 = 0; a.nblk = 4; }
    a.d = 1 << (2 * a.br); a.n = SEQ >> (2 * a.br); }
template <bool MERGE>
__device__ __forceinline__ void attn_compute(const AttnRun& cur, int blk, int par, bf16x8 (&qf)[2], unsigned qoff, const unsigned char* projb, const LAS bf16_t* Ks, const LAS bf16_t* Vs, bf16_t* AO, float* ML, bf16_t* mix, int w, int fr, int fq) {
    const int qi = 128 * blk + 16 * w + fr; const unsigned tq = (unsigned)(cur.b * SEQ + cur.cls + cur.d * qi); const int n = cur.n;
    const unsigned char* AOb = (const unsigned char*)AO; const unsigned char* MLb = (const unsigned char*)ML; unsigned char* mixb = (unsigned char*)mix; unsigned char* AOw = (unsigned char*)AO; unsigned char* MLw = (unsigned char*)ML;
    f32x4 st[9];
    {
        bf16x8 kf[9][2];
        const LAS bf16_t* kb = Ks + fr * KP + 8 * fq;
#pragma unroll
        for (int kt = 0; kt < 9; ++kt) { const int Tt = w + kt; const int srow = (((par + (Tt >> 3)) & 1) << 7) + ((Tt & 7) << 4);
#pragma unroll
            for (int ks = 0; ks < 2; ++ks) kf[kt][ks] = *(const LAS bf16x8*)(kb + srow * KP + 32 * ks); }
        __builtin_amdgcn_sched_barrier(0);
#pragma unroll
        for (int kt = 0; kt < 9; ++kt) { const f32x4 z = {0.f, 0.f, 0.f, 0.f}; st[kt] = mfma16(kf[kt][0], qf[0], z); }
#pragma unroll
        for (int kt = 0; kt < 9; ++kt) st[kt] = mfma16(kf[kt][1], qf[1], st[kt]);
        __builtin_amdgcn_sched_barrier(0);
    }
#pragma unroll
    for (int ks = 0; ks < 2; ++ks) qf[ks] = *(const bf16x8*)(projb + qoff + 256 * ks);
    f32x2 pm0 = {0.f, 0.f}, pm1 = {0.f, 0.f}; u32x2 po0[4], po1[4];
    if (MERGE) { pm0 = *(const f32x2*)(MLb + (unsigned)((tq * 16 + cur.h) * 8)); pm1 = *(const f32x2*)(MLb + (unsigned)(((T + tq) * 16 + cur.h) * 8));
#pragma unroll
        for (int et = 0; et < 4; ++et) { po0[et] = *(const u32x2*)(AOb + (unsigned)((tq * 1024 + 64 * cur.h + 4 * fq) * 2) + 32 * et); po1[et] = *(const u32x2*)(AOb + (unsigned)(((T + tq) * 1024 + 64 * cur.h + 4 * fq) * 2) + 32 * et); } }
#pragma unroll
    for (int r = 0; r < 4; ++r) { if (4 * fq + r < fr) st[0][r] = -1.0e30f; if (4 * fq + r > fr) st[8][r] = -1.0e30f; }
    if (blk == 0 || 128 * (blk + 1) >= n) {
#pragma unroll
        for (int kt = 0; kt < 9; ++kt)
#pragma unroll
            for (int r = 0; r < 4; ++r) { const int kj = qi + 16 * kt + 4 * fq + r - 64 - fr; if (kj < 0 || kj >= n) st[kt][r] = -1.0e30f; } }
    float mx = fmaxf(fmaxf(st[0][0], st[0][1]), fmaxf(st[0][2], st[0][3]));
#pragma unroll
    for (int kt = 1; kt < 9; ++kt) { mx = __builtin_fmaxf(__builtin_fmaxf(mx, st[kt][0]), st[kt][1]); mx = __builtin_fmaxf(__builtin_fmaxf(mx, st[kt][2]), st[kt][3]); }
    mx = fmaxf(mx, __shfl_xor(mx, 16)); mx = fmaxf(mx, __shfl_xor(mx, 32));
    f32x2 s2 = {0.f, 0.f}; const f32x2 m2 = {mx, mx};
#pragma unroll
    for (int kt = 0; kt < 9; ++kt) { f32x2 a = {st[kt][0], st[kt][1]}, c = {st[kt][2], st[kt][3]}; a -= m2; c -= m2;
        a[0] = __builtin_amdgcn_exp2f(a[0]); a[1] = __builtin_amdgcn_exp2f(a[1]); c[0] = __builtin_amdgcn_exp2f(c[0]); c[1] = __builtin_amdgcn_exp2f(c[1]);
        s2 += a; s2 += c; st[kt][0] = a[0]; st[kt][1] = a[1]; st[kt][2] = c[0]; st[kt][3] = c[1]; }
    float sum = s2[0] + s2[1];
    sum += __shfl_xor(sum, 16); sum += __shfl_xor(sum, 32);
    bf16x8 pf[5];
#pragma unroll
    for (int k2 = 0; k2 < 5; ++k2) { u32x4 pw; pw.x = pk2(st[2 * k2][0], st[2 * k2][1]); pw.y = pk2(st[2 * k2][2], st[2 * k2][3]);
        if (k2 < 4) { pw.z = pk2(st[2 * k2 + 1][0], st[2 * k2 + 1][1]); pw.w = pk2(st[2 * k2 + 1][2], st[2 * k2 + 1][3]); } else { pw.z = 0u; pw.w = 0u; }
        pf[k2] = mk_frag(pw); }
    float inv = 1.f / sum, w0 = 0.f, w1 = 0.f;
    if (MERGE) { const float M = fmaxf(mx, fmaxf(pm0[0], pm1[0])); w0 = pm0[1] * __builtin_amdgcn_exp2f(pm0[0] - M); w1 = pm1[1] * __builtin_amdgcn_exp2f(pm1[0] - M);
        const float e2 = __builtin_amdgcn_exp2f(mx - M); const float iw = 1.f / (w0 + w1 + e2 * sum); inv = e2 * iw; w0 *= iw; w1 *= iw; }
    const LAS bf16_t* vb = Vs + (4 * fq + (fr >> 2)) * KP + 4 * (fr & 3);
    const LAS bf16_t* vp[9];
#pragma unroll
    for (int kt = 0; kt < 9; ++kt) { const int Tt = w + kt; vp[kt] = vb + ((((par + (Tt >> 3)) & 1) << 7) + ((Tt & 7) << 4)) * KP; }
    u32x2 vf[2][9];
#pragma unroll
    for (int kt = 0; kt < 9; ++kt) vf[0][kt] = lds_tr16(vp[kt]);
#pragma unroll
    for (int et = 0; et < 4; ++et) {
        if (et < 3) {
#pragma unroll
            for (int kt = 0; kt < 9; ++kt) vf[(et + 1) & 1][kt] = lds_tr16(vp[kt] + 16 * (et + 1)); }
        __builtin_amdgcn_sched_barrier(0);
        f32x4 acc = {0.f, 0.f, 0.f, 0.f};
#pragma unroll
        for (int k2 = 0; k2 < 5; ++k2) { const u32x2 lo = vf[et & 1][2 * k2]; u32x2 hi = {0u, 0u}; if (k2 < 4) hi = vf[et & 1][2 * k2 + 1];
            u32x4 vw; vw.x = lo.x; vw.y = lo.y; vw.z = hi.x; vw.w = hi.y;
            acc = mfma16(mk_frag(vw), pf[k2], acc); }
        if (MERGE) { u32x2 o; o.x = pk2(acc[0] * inv + w0 * lo_f(po0[et].x) + w1 * lo_f(po1[et].x), acc[1] * inv + w0 * hi_f(po0[et].x) + w1 * hi_f(po1[et].x));
            o.y = pk2(acc[2] * inv + w0 * lo_f(po0[et].y) + w1 * lo_f(po1[et].y), acc[3] * inv + w0 * hi_f(po0[et].y) + w1 * hi_f(po1[et].y));
            *(u32x2*)(mixb + (unsigned)((tq * D + 1024 + 64 * cur.h + 4 * fq) * 2) + 32 * et) = o; }
        else { u32x2 o; o.x = pk2(acc[0] * inv, acc[1] * inv); o.y = pk2(acc[2] * inv, acc[3] * inv);
            *(u32x2*)(AOw + (unsigned)(((cur.br * T + tq) * 1024 + 64 * cur.h + 4 * fq) * 2) + 32 * et) = o; }
        __builtin_amdgcn_sched_barrier(0);
    }
    if (!MERGE && fq == 0) { f32x2 ml = {mx, sum}; *(f32x2*)(MLw + (unsigned)(((cur.br * T + tq) * 16 + cur.h) * 8)) = ml; }
}
template <int Q0, int Q1, bool MERGE>
__device__ __forceinline__ void p4_attn(const Args& A, LAS unsigned char* lds, int rep) {
    const int tid = threadIdx.x, lane = tid & 63, w = __builtin_amdgcn_readfirstlane(tid >> 6), fr = lane & 15, fq = lane >> 4;
    unsigned char* ws = A.ws;
    const unsigned char* projb = (const unsigned char*)(ws + WS_PROJ);
    bf16_t* AO = (bf16_t*)(ws + WS_AO); float* ML = (float*)(ws + WS_ML); bf16_t* mix = (bf16_t*)(ws + WS_MIX);
    LAS bf16_t* Ks = (LAS bf16_t*)lds; LAS bf16_t* Vs = (LAS bf16_t*)(lds + 36864);
    const int sr = tid >> 2, sq4 = tid & 3;
#define ATT_SEG_LOAD(d_, cls_, n_, s_, vk_, vv_) do { int kj_ = 128 * (s_) - 64 + sr; kj_ = kj_ < 0 ? 0 : kj_; kj_ = kj_ >= (n_) ? (n_) - 1 : kj_; \
        const unsigned ro_ = (unsigned)(rowb + (cls_) + (d_) * kj_) * (unsigned)(NPROJ_PAD * 2); \
        _Pragma("unroll") for (int i_ = 0; i_ < 2; ++i_) { vk_[i_] = *(const u32x4*)(projb + ro_ + kcol + 16 * i_); vv_[i_] = *(const u32x4*)(projb + ro_ + vcol + 16 * i_); } } while (0)
#define ATT_SEG_STORE(half_, vk_, vv_) do { _Pragma("unroll") for (int i_ = 0; i_ < 2; ++i_) { *(LAS u32x4*)(Ks + (128 * (half_) + sr) * KP + 16 * sq4 + 8 * i_) = vk_[i_]; *(LAS u32x4*)(Vs + (128 * (half_) + sr) * KP + 16 * sq4 + 8 * i_) = vv_[i_]; } } while (0)
#define ATT_Q_OFF(d_, cls_, n_, blk_) ({ int qi_ = 128 * (blk_) + 16 * w + fr; qi_ = qi_ >= (n_) ? (n_) - 1 : qi_; (unsigned)(rowb + (cls_) + (d_) * qi_) * (unsigned)(NPROJ_PAD * 2) + qcol; })
    u32x4 vk0[2], vv0[2], vk1[2], vv1[2]; bf16x8 qf[2];
#define ATT_STEP(P_, VKL_, VVL_, VKS_, VVS_) do { const int i_s = i + (P_); \
        { const bool in_ = (i_s + 3 <= cur.nblk); const int d_ = in_ ? cur.d : nxt.d, c_ = in_ ? cur.cls : nxt.cls, n_ = in_ ? cur.n : nxt.n, s_ = in_ ? cur.blk0 + i_s + 3 : nxt.blk0 + (P_); ATT_SEG_LOAD(d_, c_, n_, s_, VKL_, VVL_); } \
        const bool qmore_ = (i_s + 1 < cur.nblk); \
        const unsigned qoff_ = ATT_Q_OFF(qmore_ ? cur.d : nxt.d, qmore_ ? cur.cls : nxt.cls, qmore_ ? cur.n : nxt.n, qmore_ ? cur.blk0 + i_s + 1 : nxt.blk0); \
        attn_compute<MERGE>(cur, cur.blk0 + i_s, (P_), qf, qoff_, projb, Ks, Vs, AO, ML, mix, w, fr, fq); \
        __syncthreads(); \
        if (i_s + 2 <= cur.nblk) ATT_SEG_STORE((P_), VKS_, VVS_); \
        else if (hasn) { ATT_SEG_STORE(0, vk1, vv1); ATT_SEG_STORE(1, vk0, vv0); ATT_SEG_LOAD(nxt.d, nxt.cls, nxt.n, nxt.blk0 + 2, vk0, vv0); ATT_SEG_LOAD(nxt.d, nxt.cls, nxt.n, nxt.blk0 + 3, vk1, vv1); } \
        __syncthreads(); } while (0)
    for (int su0 = vcu_id(); su0 < 256 * rep; su0 += gridDim.x) { const int su = su0 & 255;
        AttnRun cur, nxt;
        attn_run(su, Q0, cur); nxt = cur;
        const int rowb = cur.b * SEQ, hq = 256 * (cur.h >> 2) + 32 * (cur.h & 3);
        const unsigned kcol = (unsigned)((OFF_K + hq + 128 * (sq4 >> 1) + 16 * (sq4 & 1)) * 2), vcol = (unsigned)((OFF_V + 64 * cur.h + 16 * sq4) * 2), qcol = (unsigned)((OFF_Q + hq + 8 * fq) * 2);
        ATT_SEG_LOAD(cur.d, cur.cls, cur.n, cur.blk0, vk0, vv0); ATT_SEG_LOAD(cur.d, cur.cls, cur.n, cur.blk0 + 1, vk1, vv1);
        { const unsigned qo = ATT_Q_OFF(cur.d, cur.cls, cur.n, cur.blk0); qf[0] = *(const bf16x8*)(projb + qo); qf[1] = *(const bf16x8*)(projb + qo + 256); }
        ATT_SEG_STORE(0, vk0, vv0); ATT_SEG_STORE(1, vk1, vv1);
        ATT_SEG_LOAD(cur.d, cur.cls, cur.n, cur.blk0 + 2, vk0, vv0); ATT_SEG_LOAD(cur.d, cur.cls, cur.n, cur.blk0 + 3, vk1, vv1);
        __syncthreads();
#pragma unroll 1
        for (int q = Q0; q < Q1; ++q) {
            const bool hasn = q < Q1 - 1;
            if (hasn) attn_run(su, q + 1, nxt);
#pragma unroll 1
            for (int i = 0; i < cur.nblk; i += 2) {
                ATT_STEP(0, vk1, vv1, vk0, vv0);
                ATT_STEP(1, vk0, vv0, vk1, vv1);
            }
            cur = nxt;
        }
    }
#undef ATT_STEP
#undef ATT_SEG_LOAD
#undef ATT_SEG_STORE
#undef ATT_Q_OFF
}

__device__ __forceinline__ void p6_ssd_final(const Args& A, LAS unsigned char* lds, int rep) {
    const int tid = threadIdx.x, lane = tid & 63, w = __builtin_amdgcn_readfirstlane(tid >> 6), fr = lane & 15, fq = lane >> 4;
    unsigned char* ws = A.ws;
    const bf16_t* xc = (const bf16_t*)(ws + WS_HB); const bf16_t* proj = (const bf16_t*)(ws + WS_PROJ);
    const float* ACS = (const float*)(ws + WS_ACS); const float* RCS = (const float*)(ws + WS_RCS);
    const bf16_t* YD = (const bf16_t*)(ws + WS_YD); const bf16_t* ST = (const bf16_t*)(ws + WS_ST);
    const float* dskip = (const float*)A.in[I_DSKIP]; const float* sg = (const float*)A.in[I_SSDG];
    bf16_t* mix = (bf16_t*)(ws + WS_MIX);
    LAS bf16_t* Cs = (LAS bf16_t*)lds;
    LAS float* EF = (LAS float*)(lds + 34816);
    LAS float* RED = (LAS float*)(lds + 34816 + 8192);
    for (int uu = vcu_id(); uu < BATCH * NCHUNK * 2 * rep; uu += gridDim.x) { const int u = uu & 255;
        const int b = u >> 7, c = (u >> 1) & 63, hf = u & 1; const int t0 = b * SEQ + c * CHUNK + 64 * hf;
        { const int row = tid >> 3, part = tid & 7, grp = part >> 2, q = part & 3; const bf16_t* src = xc + (size_t)(t0 + row) * XBCW + 1280 + 128 * grp + 32 * q;
#pragma unroll
          for (int i = 0; i < 4; ++i) *(LAS u32x4*)(Cs + grp * 64 * SP + row * SP + 32 * q + 8 * i) = *(const u32x4*)(src + 8 * i);
#pragma unroll
          for (int k = 0; k < 4; ++k) { const int idx = tid + 512 * k, dir = idx >> 10, hh = (idx >> 6) & 15, row2 = idx & 63;
              EF[idx] = __expf((dir ? RCS : ACS)[(size_t)(t0 + row2) * 16 + hh]); } }
        __syncthreads();
        const int grp = w >> 2;
        float ssr[4] = {0.f, 0.f, 0.f, 0.f};
        u32x2 gpk[4][4];
        LAS bf16_t* GT = (LAS bf16_t*)(lds + 45056) + w * (64 * 68);
#pragma unroll 1
        for (int hx = 0; hx < 2; ++hx) {
            const int h = 2 * w + hx;
            f32x4 y[4][4];
#pragma unroll
            for (int rt = 0; rt < 4; ++rt)
#pragma unroll
                for (int pt = 0; pt < 4; ++pt) y[rt][pt] = (f32x4){0.f, 0.f, 0.f, 0.f};
            const bf16_t* stb = ST + ((size_t)((b * NCHUNK + c) * 2) * 16 + h) * 8192 + (size_t)fr * 128 + 8 * fq;
#define P6_LOAD(dk_, hf_) do { const bf16_t* p_ = stb + (size_t)((dk_) >> 2) * (16 * 8192) + 32 * ((dk_) & 3); \
                _Pragma("unroll") for (int pt = 0; pt < 4; ++pt) hf_[pt] = *(const bf16x8*)(p_ + pt * (16 * 128)); } while (0)
#define P6_COMP(dk_, hf_) do { const int dir_ = (dk_) >> 2, ks_ = (dk_) & 3; \
                _Pragma("unroll") for (int rt = 0; rt < 4; ++rt) { \
                    const u32x4 cw = *(const LAS u32x4*)(Cs + grp * 64 * SP + (16 * rt + fr) * SP + 32 * ks_ + 8 * fq); \
                    const float ev = EF[dir_ * 1024 + h * 64 + 16 * rt + fr]; \
                    u32x4 aw; aw.x = pk2(lo_f(cw.x) * ev, hi_f(cw.x) * ev); aw.y = pk2(lo_f(cw.y) * ev, hi_f(cw.y) * ev); aw.z = pk2(lo_f(cw.z) * ev, hi_f(cw.z) * ev); aw.w = pk2(lo_f(cw.w) * ev, hi_f(cw.w) * ev); \
                    const bf16x8 af = mk_frag(aw); \
                    _Pragma("unroll") for (int pt = 0; pt < 4; ++pt) y[rt][pt] = mfma16(hf_[pt], af, y[rt][pt]); } } while (0)
            { bf16x8 hfa[4], hfb[4];
              P6_LOAD(0, hfa);
#pragma unroll 1
              for (int dk = 0; dk < 8; dk += 2) { P6_LOAD(dk + 1, hfb); P6_COMP(dk, hfa); P6_LOAD(dk + 2 < 8 ? dk + 2 : 7, hfa); P6_COMP(dk + 1, hfb); } }
#undef P6_LOAD
#undef P6_COMP
            asm volatile("" ::: "memory");
            const float dsk = dskip[h];
            u32x2 ea[12], eb[12];
#define P6_ELOAD(rt_, e_) do { const size_t tok_ = (size_t)(t0 + 16 * (rt_) + fr); const int col_ = 64 * h + 4 * fq; \
                _Pragma("unroll") for (int pt = 0; pt < 4; ++pt) { e_[3 * pt] = *(const u32x2*)(YD + tok_ * 1024 + col_ + 16 * pt); e_[3 * pt + 1] = *(const u32x2*)(xc + tok_ * XBCW + col_ + 16 * pt); e_[3 * pt + 2] = *(const u32x2*)(proj + tok_ * NPROJ_PAD + OFF_Z + col_ + 16 * pt); } } while (0)
#define P6_ECOMP(rt_, e_) do { \
                _Pragma("unroll") for (int pt = 0; pt < 4; ++pt) { const f32x4 yy = y[rt_][pt]; const u32x2 yd_ = e_[3 * pt], xv_ = e_[3 * pt + 1], zv_ = e_[3 * pt + 2]; \
                    const float g0 = (yy[0] + lo_f(yd_.x) + dsk * lo_f(xv_.x)) * silu_f(lo_f(zv_.x)), g1 = (yy[1] + hi_f(yd_.x) + dsk * hi_f(xv_.x)) * silu_f(hi_f(zv_.x)); \
                    const float g2 = (yy[2] + lo_f(yd_.y) + dsk * lo_f(xv_.y)) * silu_f(lo_f(zv_.y)), g3 = (yy[3] + hi_f(yd_.y) + dsk * hi_f(xv_.y)) * silu_f(hi_f(zv_.y)); \
                    ssr[rt_] += (g0 * g0 + g1 * g1) + (g2 * g2 + g3 * g3); \
                    u32x2 gp; gp.x = pk2(g0, g1); gp.y = pk2(g2, g3); \
                    if (hx == 0) *(LAS u32x2*)(GT + (16 * (rt_) + fr) * 68 + 16 * pt + 4 * fq) = gp; else gpk[rt_][pt] = gp; } \
                asm volatile("" ::: "memory"); } while (0)
            P6_ELOAD(0, ea);
            P6_ELOAD(1, eb); P6_ECOMP(0, ea);
            P6_ELOAD(2, ea); P6_ECOMP(1, eb);
            P6_ELOAD(3, eb); P6_ECOMP(2, ea);
            P6_ECOMP(3, eb);
#undef P6_ELOAD
#undef P6_ECOMP
        }
#pragma unroll
        for (int rt = 0; rt < 4; ++rt) { float v = ssr[rt]; v += __shfl_xor(v, 16); v += __shfl_xor(v, 32); if (fq == 0) RED[(16 * rt + fr) * 8 + w] = v; }
        f32x4 gnv[2][4];
#pragma unroll
        for (int hx = 0; hx < 2; ++hx)
#pragma unroll
            for (int pt = 0; pt < 4; ++pt) gnv[hx][pt] = *(const f32x4*)(sg + 64 * (2 * w + hx) + 16 * pt + 4 * fq);
        __syncthreads();
#pragma unroll
        for (int rt = 0; rt < 4; ++rt) { const LAS float* rp = RED + (16 * rt + fr) * 8; const f32x4 a = *(const LAS f32x4*)rp, bb = *(const LAS f32x4*)(rp + 4);
            ssr[rt] = rsqrtf(((a[0] + a[1]) + (a[2] + a[3]) + (bb[0] + bb[1]) + (bb[2] + bb[3])) * (1.f / 1024.f) + RMS_EPS); }
#pragma unroll
        for (int hx = 0; hx < 2; ++hx) { const int h = 2 * w + hx;
#pragma unroll
            for (int pt = 0; pt < 4; ++pt) { const int col = 64 * h + 16 * pt + 4 * fq; const f32x4 gn = gnv[hx][pt];
#pragma unroll
                for (int rt = 0; rt < 4; ++rt) { const u32x2 gv = (hx == 0) ? *(const LAS u32x2*)(GT + (16 * rt + fr) * 68 + 16 * pt + 4 * fq) : gpk[rt][pt]; const float rs = ssr[rt];
                    u32x2 o; o.x = pk2(lo_f(gv.x) * rs * gn[0], hi_f(gv.x) * rs * gn[1]); o.y = pk2(lo_f(gv.y) * rs * gn[2], hi_f(gv.y) * rs * gn[3]);
                    *(u32x2*)(mix + (size_t)(t0 + 16 * rt + fr) * D + col) = o; }
                asm volatile("" ::: "memory"); } }
        __syncthreads();
    }
}

__device__ __forceinline__ void p6_attn_merge(const Args& A) {
    unsigned char* ws = A.ws;
    const bf16_t* AO = (const bf16_t*)(ws + WS_AO); const float* ML = (const float*)(ws + WS_ML); bf16_t* mix = (bf16_t*)(ws + WS_MIX);
    const int gtid = blockIdx.x * 512 + threadIdx.x, NT = gridDim.x * 512;
    for (int i = gtid; i < T * 16 * 8; i += NT) {
        const int e8 = i & 7, h = (i >> 3) & 15, t = i >> 7;
        float m[3], l[3];
#pragma unroll
        for (int r = 0; r < 3; ++r) { const f32x2 v = *(const f32x2*)(ML + (((size_t)r * T + t) * 16 + h) * 2); m[r] = v[0]; l[r] = v[1]; }
        const float M = fmaxf(m[0], fmaxf(m[1], m[2]));
        float wgt[3], W = 0.f;
#pragma unroll
        for (int r = 0; r < 3; ++r) { wgt[r] = l[r] * __builtin_amdgcn_exp2f(m[r] - M); W += wgt[r]; }
        const float iw = 1.f / W; float o[8];
#pragma unroll
        for (int j = 0; j < 8; ++j) o[j] = 0.f;
#pragma unroll
        for (int r = 0; r < 3; ++r) { const u32x4 v = *(const u32x4*)(AO + ((size_t)r * T + t) * 1024 + 64 * h + 8 * e8); const float ww = wgt[r] * iw;
            o[0] += ww * lo_f(v.x); o[1] += ww * hi_f(v.x); o[2] += ww * lo_f(v.y); o[3] += ww * hi_f(v.y); o[4] += ww * lo_f(v.z); o[5] += ww * hi_f(v.z); o[6] += ww * lo_f(v.w); o[7] += ww * hi_f(v.w); }
        u32x4 ow; ow.x = pk2(o[0], o[1]); ow.y = pk2(o[2], o[3]); ow.z = pk2(o[4], o[5]); ow.w = pk2(o[6], o[7]);
        *(u32x4*)(mix + (size_t)t * D + 1024 + 64 * h + 8 * e8) = ow;
    }
}

constexpr int RP = 264;
__device__ __forceinline__ void p8_router(const Args& A, LAS unsigned char* lds, int dry) {
    const int tid = threadIdx.x, lane = tid & 63, w = __builtin_amdgcn_readfirstlane(tid >> 6), fr = lane & 15, fq = lane >> 4;
    unsigned char* ws = A.ws;
    const bf16_t* x1 = (const bf16_t*)(ws + WS_X1); const float* mod = (const float*)(ws + WS_MOD); const float* g2 = (const float*)A.in[I_N2G]; const float* rss = (const float*)(ws + WS_RSS);
    const bf16_t* wrt = (const bf16_t*)(ws + WS_WRT);
    const float* brg = (const float*)A.in[I_BRG]; const float* bre = (const float*)A.in[I_BRE];
    bf16_t* h2 = (bf16_t*)(ws + WS_HB);
    unsigned* cnt = (unsigned*)(ws + WS_CTL) + CW_CNT; int* elist = (int*)(ws + WS_ELIST); float* gates = (float*)(ws + WS_GATES);
    LAS float* A2 = (LAS float*)lds; LAS float* SH2 = A2 + D;
    LAS bf16_t* Bs = (LAS bf16_t*)(lds + 16384);
    LAS float* LG = (LAS float*)(lds + 16384 + 2 * 42240);
    if (blockIdx.x == 0 && tid < 256) ((u32x4*)(ws + WS_MIX))[tid] = (u32x4){0u, 0u, 0u, 0u};
    for (int tt0 = vcu_id(); tt0 < (T / 64) * (1 + dry); tt0 += gridDim.x) { const int tt = tt0 & (T / 64 - 1); const bool isdry = tt0 >= T / 64;
        const int b = (tt * 64) >= SEQ ? 1 : 0; const float* mb = mod + b * 12288;
        for (int i = tid; i < D; i += 512) { A2[i] = g2[i] * (1.f + mb[4 * D + i]); SH2[i] = mb[3 * D + i]; }
        const int tk = tt * 64 + 8 * w + (fr & 7); const bf16_t* xr = x1 + (size_t)tk * D + 8 * fq;
        float rstd; { const f32x4* rp = (const f32x4*)(rss + (size_t)tk * 32); float sacc = 0.f;
#pragma unroll
            for (int i = 0; i < 8; ++i) { const f32x4 v = rp[i]; sacc += (v[0] + v[1]) + (v[2] + v[3]); }
            rstd = rsqrtf(sacc * (1.f / D) + RMS_EPS); }
        u32x4 bst[5];
#define P8_BLOAD(c_) do { _Pragma("unroll") for (int i = 0; i < 5; ++i) { const int p = tid + 512 * i, row = p >> 5, c16 = p & 31; \
            bst[i] = *(const u32x4*)(wrt + (size_t)row * D + 256 * (c_) + 8 * c16); } } while (0)
#define P8_BSTORE(buf_) do { _Pragma("unroll") for (int i = 0; i < 5; ++i) { const int p = tid + 512 * i, row = p >> 5, c16 = p & 31; \
            *(LAS u32x4*)(Bs + (buf_) * 21120 + row * RP + 8 * c16) = bst[i]; } } while (0)
        u32x4 xa[8], xna[8];
#define P8_XLOAD(c_, xa_) do { _Pragma("unroll") for (int ks = 0; ks < 8; ++ks) xa_[ks] = *(const u32x4*)(xr + 256 * (c_) + 32 * ks); } while (0)
        P8_BLOAD(0); P8_XLOAD(0, xa);
        P8_BSTORE(0);
        __syncthreads();
        f32x4 acc[5];
#pragma unroll
        for (int ct = 0; ct < 5; ++ct) acc[ct] = (f32x4){0.f, 0.f, 0.f, 0.f};
#pragma unroll 1
        for (int c = 0; c < 8; ++c) {
            { const int cn = c + 1 < 8 ? c + 1 : 7; P8_BLOAD(cn); P8_XLOAD(cn, xna); }
            const LAS bf16_t* bb = Bs + (c & 1) * 21120 + fr * RP + 8 * fq;
#pragma unroll
            for (int ks = 0; ks < 8; ++ks) { const int col = 256 * c + 32 * ks + 8 * fq;
                const f32x4 m0 = *(const LAS f32x4*)(A2 + col), m1 = *(const LAS f32x4*)(A2 + col + 4), s0 = *(const LAS f32x4*)(SH2 + col), s1 = *(const LAS f32x4*)(SH2 + col + 4);
                const f32x4 xf0 = {lo_f(xa[ks].x), hi_f(xa[ks].x), lo_f(xa[ks].y), hi_f(xa[ks].y)}, xf1 = {lo_f(xa[ks].z), hi_f(xa[ks].z), lo_f(xa[ks].w), hi_f(xa[ks].w)};
                const f32x4 v0 = (xf0 * rstd) * m0 + s0, v1 = (xf1 * rstd) * m1 + s1;
                u32x4 hw; hw.x = pk2(v0[0], v0[1]); hw.y = pk2(v0[2], v0[3]); hw.z = pk2(v1[0], v1[1]); hw.w = pk2(v1[2], v1[3]);
                if (fr < 8) *(u32x4*)(h2 + (size_t)tk * D + col) = hw;
                const bf16x8 ah = mk_frag(hw);
#pragma unroll
                for (int ct = 0; ct < 5; ++ct) acc[ct] = mfma16(ah, *(const LAS bf16x8*)(bb + (16 * ct) * RP + 32 * ks), acc[ct]); }
            P8_BSTORE((c + 1) & 1);
#pragma unroll
            for (int ks = 0; ks < 8; ++ks) xa[ks] = xna[ks];
            __syncthreads();
        }
#undef P8_BLOAD
#undef P8_BSTORE
#undef P8_XLOAD
        if (fq < 2) {
#pragma unroll
            for (int ct = 0; ct < 5; ++ct)
#pragma unroll
                for (int r = 0; r < 4; ++r) LG[(8 * w + 4 * fq + r) * NRT + 16 * ct + fr] = acc[ct][r]; }
        __syncthreads();
        LAS int* lcnt = (LAS int*)(lds + 16384); LAS int* lbase = lcnt + 64;
        if (tid < 64) lcnt[tid] = 0;
        __syncthreads();
        int ea = 0, eb = 0, ra = 0, rb = 0; float g1v = 0.f, g2v = 0.f;
        if (lane < 8) {
            const LAS float* lg = LG + (8 * w + lane) * NRT;
            float gmx = -3.0e38f; int gi = 0;
#pragma unroll
            for (int j = 0; j < 8; ++j) { const float v = lg[j] + brg[j]; if (v > gmx) { gmx = v; gi = j; } }
            float gse = 0.f;
#pragma unroll
            for (int j = 0; j < 8; ++j) gse += __expf(lg[j] + brg[j] - gmx);
            const float pgroup = 1.f / gse;
            const LAS float* el = lg + 16 + 8 * gi; const float* be = bre + 8 * gi;
            float emx = -3.0e38f; int i1 = 0;
#pragma unroll
            for (int j = 0; j < 8; ++j) { const float v = el[j] + be[j]; if (v > emx) { emx = v; i1 = j; } }
            float e2 = -3.0e38f; int i2 = 0; float ese = 0.f;
#pragma unroll
            for (int j = 0; j < 8; ++j) { const float v = el[j] + be[j]; ese += __expf(v - emx); if (j != i1 && v > e2) { e2 = v; i2 = j; } }
            const float p1 = 1.f / ese, p2 = __expf(e2 - emx) / ese; const float ps = p1 + p2;
            g1v = pgroup * p1 / ps; g2v = pgroup * p2 / ps;
            ea = 8 * gi + i1; eb = 8 * gi + i2;
            if (!isdry) { ra = __hip_atomic_fetch_add(lcnt + ea, 1, __ATOMIC_RELAXED, __HIP_MEMORY_SCOPE_WORKGROUP); rb = __hip_atomic_fetch_add(lcnt + eb, 1, __ATOMIC_RELAXED, __HIP_MEMORY_SCOPE_WORKGROUP); }
        }
        __syncthreads();
        if (tid < 64 && !isdry) { const int c = lcnt[tid]; if (c > 0) lbase[tid] = (int)atomicAdd(cnt + 32 * tid, (unsigned)c); }
        __syncthreads();
        if (lane < 8 && !isdry) { const int tok = tt * 64 + 8 * w + lane;
            elist[(size_t)ea * ECAP + lbase[ea] + ra] = 2 * tok; elist[(size_t)eb * ECAP + lbase[eb] + rb] = 2 * tok + 1;
            gates[2 * tok] = g1v; gates[2 * tok + 1] = g2v; }
        __syncthreads();
    }
}

__device__ __forceinline__ int moe_tables(const Args& A, LAS unsigned char* lds, int npn, bool down) {
    const int tid = threadIdx.x;
    unsigned char* ws = A.ws;
    const unsigned* cnt = (const unsigned*)(ws + WS_CTL) + CW_CNT; const int* elist = (const int*)(ws + WS_ELIST); const float* gates = (const float*)(ws + WS_GATES);
    LAS int* tb = (LAS int*)(lds + ETAB_OFF); LAS int* cn = tb + 80;
    if (tid < 64) cn[tid] = (int)__hip_atomic_load(cnt + 32 * tid, __ATOMIC_RELAXED, __HIP_MEMORY_SCOPE_AGENT);
    __syncthreads();
    if (tid <= 64) { int s = 0; for (int j = 0; j < tid; ++j) s += (cn[j] + 255) >> 8; tb[tid] = s; }
    __syncthreads();
    const int ntiles = tb[64];
    LAS int* tab = (LAS int*)(lds + TAB_OFF);
    const int cap = down ? 6 : 12;
    for (int li = 0; li < cap; ++li) {
        const long L = (long)li * gridDim.x + vcu_id(); if (L >= (long)ntiles * npn) break;
        const int tau = (int)(L / npn); int e = 0;
        for (int j = 1; j < NEXP; ++j) e += (tb[j] <= tau) ? 1 : 0;
        const int mt = tau - tb[e], ce = cn[e];
        if (tid < 256) { const int pos = 256 * mt + tid; const bool ok = pos < ce; const int a = ok ? elist[(size_t)e * ECAP + pos] : -1;
            if (down) { tab[li * 512 + 2 * tid] = a; tab[li * 512 + 2 * tid + 1] = ok ? __float_as_int(gates[a]) : 0; }
            else tab[li * 256 + tid] = ok ? (a >> 1) * (D * 2) : (int)(unsigned)(WS_MIX - WS_HB); }
    }
    __syncthreads();
    return ntiles;
}

__device__ __forceinline__ void p11_combine(const Args& A) {
    unsigned char* ws = A.ws;
    const bf16_t* x1 = (const bf16_t*)(ws + WS_X1); const float* mod = (const float*)(ws + WS_MOD); const bf16_t* Y = (const bf16_t*)(ws + WS_YSLOT);
    const int gtid = blockIdx.x * 512 + threadIdx.x, NR = (gridDim.x * 512) >> 8, c8 = (gtid & 255) * 8;
    f32x4 gt[2][2];
#pragma unroll
    for (int bb = 0; bb < 2; ++bb) { gt[bb][0] = *(const f32x4*)(mod + bb * 12288 + 5 * D + c8); gt[bb][1] = *(const f32x4*)(mod + bb * 12288 + 5 * D + c8 + 4); }
    for (int t0 = gtid >> 8; t0 < T; t0 += 4 * NR) {
        u32x4 xw[4], ya[4], yb[4];
#pragma unroll
        for (int u = 0; u < 4; ++u) { int t = t0 + u * NR; t = t < T ? t : T - 1;
            xw[u] = *(const u32x4*)(x1 + (size_t)t * D + c8); ya[u] = *(const u32x4*)(Y + (size_t)(2 * t) * D + c8); yb[u] = *(const u32x4*)(Y + (size_t)(2 * t + 1) * D + c8); }
        __builtin_amdgcn_sched_barrier(0);
#pragma unroll
        for (int u = 0; u < 4; ++u) { const int t = t0 + u * NR; if (t < T) { const int bb = t >= SEQ ? 1 : 0;
            const f32x4 g0 = bb ? gt[1][0] : gt[0][0], g1 = bb ? gt[1][1] : gt[0][1];
            const f32x4 a0 = {lo_f(xw[u].x), hi_f(xw[u].x), lo_f(xw[u].y), hi_f(xw[u].y)}, a1 = {lo_f(xw[u].z), hi_f(xw[u].z), lo_f(xw[u].w), hi_f(xw[u].w)};
            f32x4 s0, s1;
            s0[0] = lo_f(ya[u].x) + lo_f(yb[u].x); s0[1] = hi_f(ya[u].x) + hi_f(yb[u].x); s0[2] = lo_f(ya[u].y) + lo_f(yb[u].y); s0[3] = hi_f(ya[u].y) + hi_f(yb[u].y);
            s1[0] = lo_f(ya[u].z) + lo_f(yb[u].z); s1[1] = hi_f(ya[u].z) + hi_f(yb[u].z); s1[2] = lo_f(ya[u].w) + lo_f(yb[u].w); s1[3] = hi_f(ya[u].w) + hi_f(yb[u].w);
            __builtin_nontemporal_store(a0 + g0 * s0, (f32x4*)(A.out + (size_t)t * D + c8)); __builtin_nontemporal_store(a1 + g1 * s1, (f32x4*)(A.out + (size_t)t * D + c8 + 4)); } }
    }
}

constexpr int NPH = 12;
#ifndef DUP_PH
#define DUP_PH -1
#endif
#define REP(k) for (int _rep = 0; _rep < ((DUP_PH) == (k) ? 2 : 1); ++_rep)
__global__ void __launch_bounds__(512, 2) hyb_fwd(Args args) {
    extern __shared__ __attribute__((aligned(16))) unsigned char lds_raw[];
    LAS unsigned char* lds = (LAS unsigned char*)lds_raw;
    const int tid = threadIdx.x;
    volatile LAS unsigned* MISC = (volatile LAS unsigned*)(lds + MISC_OFF);
    for (int u = tid; u < 128; u += 512) MISC[u] = 0u;
    __syncthreads();
    unsigned char* ws = args.ws;
    unsigned* ctl = (unsigned*)(ws + WS_CTL);
    const int lo = args.ph_lo, hi = args.ph_hi;
    XcdBarrier bar; bar.bar = ctl + CW_BAR; bar.x = 0; bar.st = nullptr;
    if (hi - lo > 1) bar = xcd_barrier_post(ctl + CW_BAR, MISC + 8);
#ifndef PH_MASK
#define PH_MASK 0xFFF
#endif
#define IN(k) ((((PH_MASK) >> (k)) & 1) && lo <= (k) && (k) < hi)
#ifndef TPROBE_A
#define TPROBE_A -1
#define TPROBE_B -1
#endif
#define SEAM(k) do { if (IN(k) && IN((k) + 1)) xcd_barrier(bar); if (TPROBE_A >= 0 && blockIdx.x == 0 && tid == 0) ctl[CW_FLAG + 1 + (k)] = (unsigned)wall_clock64(); } while (0)
    if (TPROBE_A >= 0 && blockIdx.x == 0 && tid == 0) ctl[CW_FLAG] = (unsigned)wall_clock64();

    if (IN(0)) { REP(0) { p0_prologue(args, lds); __syncthreads(); } } SEAM(0);
    if (IN(1)) { REP(1) p1_norm1(args); } SEAM(1);
    if (IN(2)) {
        const int G2 = (gridDim.x == 256) ? 184 : (int)gridDim.x;
        if ((int)blockIdx.x < G2) {
            pg8::Gemm g{(const bf16_t*)(ws + WS_HB), (const bf16_t*)(ws + WS_WINT), D, 0};
            pg8::StaticOrder S; S.init(T, NPROJ_PAD, G2, (int)blockIdx.x, (DUP_PH) == 2 ? 2 : 1);
            EpiProj E{(bf16_t*)(ws + WS_PROJ), (float*)(ws + WS_DTRAW), (const float*)args.in[I_QG], (const float*)args.in[I_KG], (const float*)(ws + WS_ROPE)};
            pg8::gemm_phase<EpiProj, pg8::StaticOrder, true, false>(lds, g, S, E);
            p2_convert_late(args, lds);
        } else p2_convert_late(args, lds);
    } SEAM(2);
    if (IN(3)) { p3_post(args, (DUP_PH) == 13 ? 1 : 0, (DUP_PH) == 3 ? 2 : 1); } SEAM(3);
    if (IN(4)) { p4_ssd_local(args, lds, (DUP_PH) == 4 ? 2 : 1); p4_attn<0, 2, false>(args, lds, (DUP_PH) == 14 ? 2 : 1); } SEAM(4);
    if (IN(5)) { p5_scan(args); } SEAM(5);
    if (IN(6)) { p6_ssd_final(args, lds, (DUP_PH) == 6 ? 2 : 1); p4_attn<2, 4, true>(args, lds, (DUP_PH) == 16 ? 2 : 1); } SEAM(6);
    if (IN(7)) {
        pg8::Gemm g{(const bf16_t*)(ws + WS_MIX), (const bf16_t*)(ws + WS_WOUTT), D, 0};
        pg8::StaticOrder S; S.init(T, D, (int)gridDim.x, (int)blockIdx.x, (DUP_PH) == 7 ? 2 : 1);
        EpiOut E{(const float*)args.in[I_X], (const float*)(ws + WS_MOD), (bf16_t*)(ws + WS_X1), (float*)(ws + WS_RSS)};
        pg8::gemm_phase<EpiOut, pg8::StaticOrder, true, false>(lds, g, S, E);
    } SEAM(7);
    if (IN(8)) { p8_router(args, lds, (DUP_PH) == 8 ? 1 : 0); } SEAM(8);
    if (IN(9)) {
        const int ntiles = moe_tables(args, lds, 4, false);
        pg8::Gemm g{(const bf16_t*)(ws + WS_HB), (const bf16_t*)(ws + WS_WGUT), D, (size_t)1024 * D * 2};
        MoeOrder S{(const LAS int*)(lds + ETAB_OFF), ntiles, 4, (int)gridDim.x, vcu_id(), (const LAS unsigned*)(lds + TAB_OFF)};
        EpiGU E{(bf16_t*)(ws + WS_HMOE)};
        _Pragma("unroll 1") REP(9) pg8::gemm_phase<EpiGU, MoeOrder, true, true>(lds, g, S, E);
    } SEAM(9);
    if (IN(10)) {
        const int ntiles = moe_tables(args, lds, 8, true);
        pg8::Gemm g{(const bf16_t*)(ws + WS_HMOE), (const bf16_t*)(ws + WS_WDT), EH, (size_t)D * EH * 2};
        MoeOrder S{(const LAS int*)(lds + ETAB_OFF), ntiles, 8, (int)gridDim.x, vcu_id(), (const LAS unsigned*)(lds + TAB_OFF)};
        EpiDown E{(bf16_t*)(ws + WS_YSLOT), (const LAS int*)(lds + TAB_OFF)};
        _Pragma("unroll 1") REP(10) pg8::gemm_phase<EpiDown, MoeOrder, true, false>(lds, g, S, E);
    } SEAM(10);
    if (IN(11)) { REP(11) p11_combine(args); }
    if (TPROBE_A >= 0) {
        xcd_barrier(bar);
        if (blockIdx.x == 0 && tid == 0) ctl[CW_FLAG + 1 + 11] = (unsigned)wall_clock64();
        __syncthreads();
        const unsigned ea = __hip_atomic_load(ctl + CW_FLAG + 1 + TPROBE_A, __ATOMIC_RELAXED, __HIP_MEMORY_SCOPE_AGENT), sa = __hip_atomic_load(ctl + CW_FLAG + TPROBE_A, __ATOMIC_RELAXED, __HIP_MEMORY_SCOPE_AGENT);
        const unsigned eb = __hip_atomic_load(ctl + CW_FLAG + 1 + TPROBE_B, __ATOMIC_RELAXED, __HIP_MEMORY_SCOPE_AGENT), sb = __hip_atomic_load(ctl + CW_FLAG + TPROBE_B, __ATOMIC_RELAXED, __HIP_MEMORY_SCOPE_AGENT);
        xcd_barrier(bar);
        const float ta = (float)(ea - sa) * 0.01f, tb = (float)(eb - sb) * 0.01f;
        const float sfac = sqrtf(ta * 0.01f); const float* xin = (const float*)args.in[I_X];
        for (size_t i = (size_t)blockIdx.x * 512 + tid; i < (size_t)T * D; i += (size_t)gridDim.x * 512) args.out[i] += xin[i] * sfac + (i == 0 ? tb : 0.f);
    }
#undef IN
#undef SEAM
}

extern "C" void kernel_launch(void* const* d_in, const int* in_sizes, int n_in, void* d_out, int out_size, void* d_ws, size_t ws_size, hipStream_t stream) {
    static int grid = 0;
    if (grid == 0) {
        if (n_in != 24 || in_sizes[0] != T * D || out_size != T * D || ws_size < WS_END) { fprintf(stderr, "kernel_launch: unexpected shapes (n_in %d, in0 %d, out %d, ws %zu < %zu); nothing launched\n", n_in, n_in > 0 ? in_sizes[0] : -1, out_size, ws_size, (size_t)WS_END); grid = -1; return; }
        int dev = 0, cus = 0, per_cu = 0;
        if (hipGetDevice(&dev) != hipSuccess || hipDeviceGetAttribute(&cus, hipDeviceAttributeMultiprocessorCount, dev) != hipSuccess) { grid = -1; return; }
        if (hipFuncSetAttribute((const void*)hyb_fwd, hipFuncAttributeMaxDynamicSharedMemorySize, LDS_BYTES) != hipSuccess) { fprintf(stderr, "kernel_launch: hipFuncSetAttribute failed\n"); grid = -1; return; }
        if (hipOccupancyMaxActiveBlocksPerMultiprocessor(&per_cu, (const void*)hyb_fwd, 512, LDS_BYTES) != hipSuccess || per_cu < 1) fprintf(stderr, "kernel_launch: occupancy query reports %d\n", per_cu);
        (void)hipGetLastError();
        grid = cus;
    }
    if (grid < 0) return;
    (void)hipMemsetAsync((char*)d_ws + WS_CTL, 0, CTL_BYTES, stream);
    Args a{};
    for (int i = 0; i < 24; ++i) a.in[i] = d_in[i];
    a.out = (float*)d_out; a.ws = (unsigned char*)d_ws;
#if MK_ONE_LAUNCH
    a.ph_lo = 0; a.ph_hi = NPH;
    hipLaunchKernelGGL(hyb_fwd, dim3(grid), dim3(512), LDS_BYTES, stream, a);
#else
    for (int p = 0; p < NPH; ++p) { a.ph_lo = p; a.ph_hi = p + 1; hipLaunchKernelGGL(hyb_fwd, dim3(grid), dim3(512), LDS_BYTES, stream, a); }
#endif
}
```

```cpp
#include <hip/hip_runtime.h>
#include <cstdio>
#include <cstdint>

#ifndef MK_ONE_LAUNCH
#define MK_ONE_LAUNCH 1
#endif

#define LAS __attribute__((address_space(3)))
#define GAS __attribute__((address_space(1)))
typedef unsigned short bf16_t;
typedef short bf16x8 __attribute__((ext_vector_type(8)));
typedef float f32x4 __attribute__((ext_vector_type(4)));
typedef float f32x2 __attribute__((ext_vector_type(2)));
typedef unsigned u32x4 __attribute__((ext_vector_type(4)));
typedef unsigned u32x2 __attribute__((ext_vector_type(2)));

constexpr int BATCH = 2, SEQ = 8192, T = BATCH * SEQ, D = 2048;
constexpr int NPROJ = 5664, NPROJ_PAD = 5888;
constexpr int OFF_Q = 0, OFF_K = 1024, OFF_V = 2048, OFF_Z = 3072, OFF_XBC = 4096, OFF_DT = 5632;
constexpr int XBCW = 1536, NHEAD = 16, CHUNK = 128, NCHUNK = SEQ / CHUNK;
constexpr int NEXP = 64, EH = 512;
constexpr int ECAP = T;
constexpr int NRT = 80;
constexpr float RMS_EPS = 1e-6f;
constexpr float LOG2E = 1.4426950408889634f;

constexpr size_t MiB = 1u << 20;
constexpr size_t WS_CTL = 0, CTL_BYTES = 1 * MiB;
constexpr size_t WS_MOD = 1 * MiB;
constexpr size_t WS_ROPE = 2 * MiB;
constexpr size_t WS_WRT = 6 * MiB;
constexpr size_t WS_SMALL = 7 * MiB;
constexpr size_t WS_DTRAW = WS_SMALL, WS_DTF = WS_SMALL + 2 * MiB, WS_DTB = WS_SMALL + 3 * MiB, WS_ACS = WS_SMALL + 4 * MiB, WS_RCS = WS_SMALL + 5 * MiB, WS_DEC = WS_SMALL + 6 * MiB;
constexpr size_t WS_ML = 14 * MiB;
constexpr size_t WS_ELIST = 20 * MiB;
constexpr size_t WS_GATES = 24 * MiB;
constexpr size_t WS_WINT = 25 * MiB;
constexpr size_t WS_WOUTT = 48 * MiB;
constexpr size_t WS_WGUT = 56 * MiB;
constexpr size_t WS_WDT = 312 * MiB;
constexpr size_t WS_HB = 440 * MiB;
constexpr size_t WS_PROJ = 504 * MiB;
constexpr size_t WS_YSLOT = WS_PROJ, WS_HMOE = WS_PROJ + 128 * MiB;
constexpr size_t WS_ST = 688 * MiB;
constexpr size_t WS_X1 = WS_ST;
constexpr size_t WS_YD = 816 * MiB;
constexpr size_t WS_AO = 880 * MiB;
constexpr size_t WS_RSS = WS_AO;
constexpr size_t WS_MIX = 976 * MiB;
constexpr size_t WS_END = 1040 * MiB;

constexpr int CW_BAR = 4096;
constexpr int CW_CNT = 16384;
constexpr int CW_FLAG = 16384 + 4096;

constexpr int RING_BYTES = 131072;
constexpr int MISC_OFF = 133120;
constexpr int TAB_OFF = MISC_OFF + 512;
constexpr int ETAB_OFF = TAB_OFF + 12288;
constexpr int LDS_BYTES = 147456;
static_assert(ETAB_OFF + 1024 <= LDS_BYTES, "LDS map");

__device__ __forceinline__ float bf2f(unsigned v) { return __uint_as_float(v << 16); }
__device__ __forceinline__ unsigned f2bf(float f) { unsigned u = __float_as_uint(f); return (u + 0x7fffu + ((u >> 16) & 1u)) >> 16; }
typedef __bf16 bf16v2_t __attribute__((ext_vector_type(2)));
__device__ __forceinline__ unsigned pk2(float lo, float hi) { const f32x2 v = {lo, hi}; return __builtin_bit_cast(unsigned, __builtin_convertvector(v, bf16v2_t)); }
__device__ __forceinline__ float lo_f(unsigned w) { return __uint_as_float(w << 16); }
__device__ __forceinline__ float hi_f(unsigned w) { return __uint_as_float(w & 0xffff0000u); }
__device__ __forceinline__ float silu_f(float v) { return v / (1.f + __expf(-v)); }
#define LDS_WAIT() asm volatile("s_waitcnt lgkmcnt(0)" ::: "memory")
#define VM_WAIT() asm volatile("s_waitcnt vmcnt(0)" ::: "memory")

#define XB_TMO      128
#define XB_XCNT(j)  (256  + 64 * (j))
#define XB_XSUB(j)  (1280 + 64 * (j))
#define XB_XGEN(j)  (2304 + 64 * (j))
#define XB_TOP      3328
#define XB_TOPGEN   3392
#define XCD_BAR_WORDS 3456
#define XB_SPIN_CAP (1u << 18)
__device__ __forceinline__ unsigned xb_ld(unsigned* p)              { return __hip_atomic_load(p, __ATOMIC_RELAXED, __HIP_MEMORY_SCOPE_AGENT); }
__device__ __forceinline__ unsigned xb_add(unsigned* p, unsigned v) { return __hip_atomic_fetch_add(p, v, __ATOMIC_RELAXED, __HIP_MEMORY_SCOPE_AGENT); }
__device__ __forceinline__ unsigned xb_xcc_id() { return (unsigned)__builtin_amdgcn_s_getreg((3 << 11) | 20) & 0xFu; }
#define XB_SPIN(cond, bar) do { unsigned _sp = 0; while (cond) { __builtin_amdgcn_s_sleep(1); \
    if ((++_sp & 255u) == 0u) { if (xb_ld(&(bar)[XB_TMO])) break; if (_sp > XB_SPIN_CAP) { atomicAdd(&(bar)[XB_TMO], 1u); break; } } } } while (0)
struct XcdBarrier { unsigned* bar; unsigned x; volatile LAS unsigned* st; };
__device__ __forceinline__ XcdBarrier xcd_barrier_post(unsigned* bar, volatile LAS unsigned* st) {
    XcdBarrier b; b.bar = bar; b.x = xb_xcc_id(); b.st = st;
    if (threadIdx.x == 0) (void)xb_add(&bar[XB_XCNT(b.x)], 1u);
    return b;
}
__device__ __forceinline__ void xcd_barrier_complete(unsigned* bar, unsigned x, unsigned& nloc, unsigned& nx) {
    const unsigned G = gridDim.x * gridDim.y * gridDim.z;
    unsigned sum, cnt, mine, sp = 0u;
    for (;;) {
        sum = 0u; cnt = 0u; mine = 0u;
#pragma unroll
        for (unsigned j = 0; j < 16; ++j) { const unsigned c = xb_ld(&bar[XB_XCNT(j)]); sum += c; cnt += (c > 0u) ? 1u : 0u; mine = (j == x) ? c : mine; }
        if (sum == G) break;
        __builtin_amdgcn_s_sleep(1);
        if ((++sp & 255u) == 0u) { if (xb_ld(&bar[XB_TMO])) break; if (sp > XB_SPIN_CAP) { atomicAdd(&bar[XB_TMO], 1u); break; } }
    }
    nloc = mine > 0u ? mine : 1u; nx = cnt > 0u ? cnt : 1u;
}
__device__ __forceinline__ void xcd_barrier(const XcdBarrier& b) {
    asm volatile("s_waitcnt vmcnt(0)" ::: "memory");
    __syncthreads();
    if (threadIdx.x == 0) {
        unsigned* bar = b.bar;
        __builtin_amdgcn_s_waitcnt(0);
        unsigned nloc = b.st[0], nx = b.st[1];
        if (nloc == 0u) { xcd_barrier_complete(bar, b.x, nloc, nx); b.st[0] = nloc; b.st[1] = nx; }
        const unsigned old = xb_add(&bar[XB_XSUB(b.x)], 1u);
        const unsigned gen = old / nloc;
        if (old + 1u == (gen + 1u) * nloc) {
            __builtin_amdgcn_fence(__ATOMIC_RELEASE, "agent");
            asm volatile("s_waitcnt vmcnt(0)" ::: "memory");
            const unsigned og = xb_add(&bar[XB_TOP], 1u);
            const unsigned tg = og / nx;
            if (og + 1u == (tg + 1u) * nx) xb_add(&bar[XB_TOPGEN], 1u);
            else XB_SPIN(xb_ld(&bar[XB_TOPGEN]) == tg, bar);
            __builtin_amdgcn_fence(__ATOMIC_ACQUIRE, "agent");
            xb_add(&bar[XB_XGEN(b.x)], 1u);
            asm volatile("s_waitcnt vmcnt(0)" ::: "memory");
        } else {
            XB_SPIN(xb_ld(&bar[XB_XGEN(b.x)]) == gen, bar);
            __builtin_amdgcn_fence(__ATOMIC_ACQUIRE, "agent");
            asm volatile("s_waitcnt vmcnt(0)" ::: "memory");
        }
    }
    __syncthreads();
}

namespace pg8 {
constexpr int BM = 256, BK = 64, HALF = 128, HTB = HALF * BK * 2, STAGE_BYTES = 8 * HTB, NXCD = 8, WGM = 8;
__device__ __forceinline__ int lds_byte(int r, int c) { const int st = (r >> 4) * 2 + (c >> 5), rr = r & 15, cc = c & 31, ob = rr * 64 + cc * 2; return st * 1024 + (ob ^ (((ob >> 9) & 1) << 5)); }
__device__ __forceinline__ void stage_rc(int b, int& R, int& C) { const int st = b / 1024, sb = b % 1024, swz = sb ^ (((sb >> 9) & 1) << 5); R = (st >> 1) * 16 + swz / 64; C = (st & 1) * 32 + (swz % 64) / 2; }
__device__ __forceinline__ int perm32(int rho) { const int n = rho >> 4, i = rho & 15; return 8 * (i >> 2) + 4 * n + (i & 3); }

struct Unit { int pm, pn, e, li; };
struct Gemm { const bf16_t* A; const bf16_t* Bt; int K; size_t bstride; };

struct StaticOrder {
    int nM, nN, nwg, G, c, rep;
    __device__ void init(int M, int N, int G_, int c_, int rep_ = 1) { nM = M / BM; nN = N / BM; nwg = nM * nN; G = G_; c = c_; rep = rep_; }
    __device__ bool next(int i, Unit& u) const {
        const long L = (long)i * G + c; if (L >= (long)nwg * rep) return false;
        int wgid = (int)(L % nwg); { const int q = nwg / NXCD, r = nwg % NXCD, xcd = wgid % NXCD, off = wgid / NXCD; wgid = (xcd < r ? xcd * (q + 1) : r * (q + 1) + (xcd - r) * q) + off; }
        const int nig = WGM * nN, gid = wgid / nig, fm = gid * WGM, gsz = (nM - fm) < WGM ? (nM - fm) : WGM;
        u.pm = fm + ((wgid % nig) % gsz); u.pn = (wgid % nig) / gsz; u.e = 0; u.li = i; return true;
    }
    __device__ __forceinline__ void a_ready(const Unit&) const {}
    __device__ __forceinline__ void done(const Unit&) const {}
    __device__ __forceinline__ void load_goff(const Unit&, unsigned (&)[2][2], const int (&)[2], const int (&)[2]) const {}
};

template <class Epi, class Sched, bool ALIGN_EPI, bool GATHER>
__device__ __forceinline__ void gemm_phase(LAS unsigned char* lds, const Gemm g, const Sched& S, const Epi& E) {
    const int tid = threadIdx.x, wid = __builtin_amdgcn_readfirstlane(tid >> 6), lane = tid & 63, wr = wid >> 2, wc = wid & 3, fr = lane & 15, fq = lane >> 4;
    const int K = g.K, nt = K / BK;
    unsigned voffA[2], voffB[2]; int RA[2], CA[2];
#pragma unroll
    for (int i = 0; i < 2; ++i) { int R, C; stage_rc(tid * 16 + i * 8192, R, C); const int Rb = Epi::PERM ? ((R & ~31) + perm32(R & 31)) : R; RA[i] = R; CA[i] = C;
        voffA[i] = (unsigned)(R * K + C) * 2u; voffB[i] = (unsigned)(Rb * K + C) * 2u; }
    unsigned goff[2][2] = {{0u, 0u}, {0u, 0u}};
    const size_t kstep = (size_t)(BK * 2);
    const size_t hstep = (size_t)HALF * K * 2;
    const size_t tstep = 2 * hstep;
    const unsigned ldsw = (unsigned)wid * 1024u;
    const int aoff = lds_byte(wr * 64 + fr, fq * 8), boff = lds_byte(wc * 32 + fr, fq * 8);
#define PG8_SA(b, h) (((b) * 2 + (h)) * HTB)
#define PG8_SB(b, h) ((4 + (b) * 2 + (h)) * HTB)
#define PG8_STAGE(bufoff, gbase, voff) do { _Pragma("unroll") for (int _i = 0; _i < 2; ++_i) \
        __builtin_amdgcn_global_load_lds((const unsigned*)((const char*)(gbase) + (voff)[_i]), (LAS unsigned*)(lds + (bufoff) + ldsw + _i * 8192), 16, 0, 0); } while (0)
#define PG8_STAGE_A(bufoff, cptr, kb, h) do { if constexpr (GATHER) { PG8_STAGE(bufoff, (const char*)g.A + (kb), goff[h]); } else { PG8_STAGE(bufoff, (cptr) + (kb) + ((h) ? hstep : 0), voffA); } } while (0)
#define PG8_LDA(dst, b, h) do { _Pragma("unroll") for (int m = 0; m < 4; ++m) _Pragma("unroll") for (int k = 0; k < 2; ++k) dst[m][k] = *(const LAS bf16x8*)(lds + PG8_SA(b, h) + aoff + m * 2048 + k * 1024); } while (0)
#define PG8_LDB(dst, b, h) do { _Pragma("unroll") for (int n = 0; n < 2; ++n) _Pragma("unroll") for (int k = 0; k < 2; ++k) dst[n][k] = *(const LAS bf16x8*)(lds + PG8_SB(b, h) + boff + n * 2048 + k * 1024); } while (0)
#define PG8_MMA(ai, bj, At, Bt) do { __builtin_amdgcn_s_setprio(1); _Pragma("unroll") for (int m = 0; m < 4; ++m) _Pragma("unroll") for (int n = 0; n < 2; ++n) _Pragma("unroll") for (int k = 0; k < 2; ++k) \
        acc[ai][bj][m][n] = __builtin_amdgcn_mfma_f32_16x16x32_bf16(Bt[n][k], At[m][k], acc[ai][bj][m][n], 0, 0, 0); __builtin_amdgcn_s_setprio(0); } while (0)
#define PG8_WAIT_V(n) asm volatile("s_waitcnt vmcnt(" #n ")" ::: "memory")
#define PG8_WAIT_L(n) asm volatile("s_waitcnt lgkmcnt(" #n ")" ::: "memory")
#define PG8_BAR __builtin_amdgcn_s_barrier()
#define PG8_SCHED __builtin_amdgcn_sched_barrier(0)
    Unit cur, nxt; int ui = 0;
    if (!S.next(0, cur)) return;
    f32x4 acc[2][2][4][2];
#pragma unroll
    for (int a = 0; a < 2; ++a)
#pragma unroll
        for (int b = 0; b < 2; ++b)
#pragma unroll
            for (int m = 0; m < 4; ++m)
#pragma unroll
                for (int n = 0; n < 2; ++n) acc[a][b][m][n] = (f32x4){0.f, 0.f, 0.f, 0.f};
    bf16x8 At[4][2], B0[2][2], B1[2][2];
    const char* cA = GATHER ? (const char*)g.A : (const char*)g.A + (size_t)cur.pm * tstep;
    const char* cB = (const char*)g.Bt + (size_t)cur.e * g.bstride + (size_t)cur.pn * tstep;
    S.a_ready(cur);
    if constexpr (GATHER) { S.load_goff(cur, goff, RA, CA); }
    PG8_STAGE(PG8_SB(0, 0), cB, voffB); PG8_STAGE(PG8_SB(0, 1), cB + hstep, voffB); PG8_STAGE_A(PG8_SA(0, 0), cA, 0, 0); PG8_STAGE_A(PG8_SA(0, 1), cA, 0, 1);
    if (wr == 1) PG8_BAR;
    PG8_WAIT_V(2); PG8_BAR;
    PG8_STAGE(PG8_SB(1, 0), cB + kstep, voffB); PG8_STAGE_A(PG8_SA(1, 0), cA, kstep, 0); PG8_STAGE(PG8_SB(1, 1), cB + hstep + kstep, voffB);
    PG8_WAIT_V(6); PG8_BAR;
    for (;;) {
        const bool has_next = S.next(ui + 1, nxt);
        const char* nA = GATHER ? cA : (has_next ? (const char*)g.A + (size_t)nxt.pm * tstep : cA);
        const char* nB = has_next ? (const char*)g.Bt + (size_t)nxt.e * g.bstride + (size_t)nxt.pn * tstep : cB;
        for (int t = 0; t < nt; t += 2) {
            const bool last = (t == nt - 2);
            const size_t kb1 = (size_t)(t + 1) * kstep;
            const char* a2 = last ? nA : cA; const size_t kb2 = last ? 0 : (size_t)(t + 2) * kstep; const char* b2 = last ? nB : cB + (size_t)(t + 2) * kstep;
            const size_t kb3 = kb2 + kstep; const char* b3 = b2 + kstep;
            if (last && has_next) S.a_ready(nxt);
            PG8_LDB(B0, 0, 0); PG8_LDB(B1, 0, 1); PG8_SCHED; PG8_LDA(At, 0, 0); PG8_STAGE_A(PG8_SA(1, 1), cA, kb1, 1);
            PG8_WAIT_V(8); PG8_WAIT_L(0); PG8_BAR; PG8_MMA(0, 0, At, B0); PG8_MMA(0, 1, At, B1); PG8_BAR; PG8_SCHED;
            if constexpr (GATHER) { if (last && has_next) S.load_goff(nxt, goff, RA, CA); }
            PG8_LDA(At, 0, 1); PG8_STAGE(PG8_SB(0, 0), b2, voffB); PG8_STAGE(PG8_SB(0, 1), b2 + hstep, voffB); PG8_STAGE_A(PG8_SA(0, 0), a2, kb2, 0);
            PG8_WAIT_V(8); PG8_WAIT_L(0); PG8_BAR; PG8_MMA(1, 0, At, B0); PG8_MMA(1, 1, At, B1); PG8_BAR; PG8_SCHED;
            PG8_LDB(B0, 1, 0); PG8_LDB(B1, 1, 1); PG8_SCHED; PG8_LDA(At, 1, 0); PG8_STAGE_A(PG8_SA(0, 1), a2, kb2, 1);
            PG8_WAIT_V(8); PG8_WAIT_L(0); PG8_BAR; PG8_MMA(0, 0, At, B0); PG8_MMA(0, 1, At, B1); PG8_BAR; PG8_SCHED;
            PG8_LDA(At, 1, 1); PG8_STAGE(PG8_SB(1, 0), b3, voffB); PG8_STAGE(PG8_SB(1, 1), b3 + hstep, voffB); PG8_STAGE_A(PG8_SA(1, 0), a2, kb3, 0);
            PG8_WAIT_V(8); PG8_WAIT_L(0); PG8_BAR; PG8_MMA(1, 0, At, B0); PG8_MMA(1, 1, At, B1); PG8_BAR; PG8_SCHED;
        }
        if constexpr (ALIGN_EPI) { if (wr == 0) PG8_BAR; }
        E(acc, cur, wr, wc, fr, fq); S.done(cur);
        if (!has_next) break;
#pragma unroll
        for (int a = 0; a < 2; ++a)
#pragma unroll
            for (int b = 0; b < 2; ++b)
#pragma unroll
                for (int m = 0; m < 4; ++m)
#pragma unroll
                    for (int n = 0; n < 2; ++n) acc[a][b][m][n] = (f32x4){0.f, 0.f, 0.f, 0.f};
        cur = nxt; cA = nA; cB = nB; ++ui;
        if constexpr (ALIGN_EPI) { if (wr == 1) PG8_BAR; }
    }
    PG8_WAIT_V(0);
    if constexpr (!ALIGN_EPI) { if (wr == 0) PG8_BAR; }
    PG8_BAR;
#undef PG8_SA
#undef PG8_SB
#undef PG8_STAGE
#undef PG8_STAGE_A
#undef PG8_LDA
#undef PG8_LDB
#undef PG8_MMA
#undef PG8_WAIT_V
#undef PG8_WAIT_L
#undef PG8_BAR
#undef PG8_SCHED
}
}

struct EpiProj {
    static constexpr bool PERM = true;
    bf16_t* O; float* dtraw; const float* qg; const float* kg; const float* rope;
    __device__ __forceinline__ void operator()(const f32x4 (&acc)[2][2][4][2], const pg8::Unit& u, int wr, int wc, int fr, int fq) const {
        const int row0 = u.pm * 256 + wr * 64 + fr, col0 = u.pn * 256 + wc * 32 + 8 * fq;
        if (u.pn < 8) {
            const float* gp = (u.pn < 4 ? qg : kg) + 4 * fq; const float sc = u.pn < 4 ? 0.125f * LOG2E : 1.f;
            f32x4 gn[2][2];
#pragma unroll
            for (int bj = 0; bj < 2; ++bj)
#pragma unroll
                for (int n = 0; n < 2; ++n) gn[bj][n] = *(const f32x4*)(gp + 32 * n + 16 * bj);
#pragma unroll
            for (int ai = 0; ai < 2; ++ai)
#pragma unroll
                for (int m = 0; m < 4; ++m) { const int row = row0 + ai * 128 + m * 16;
                    float ss = 0.f;
#pragma unroll
                    for (int bj = 0; bj < 2; ++bj)
#pragma unroll
                        for (int n = 0; n < 2; ++n) { const f32x4 v = acc[ai][bj][m][n]; ss += (v[0] * v[0] + v[1] * v[1]) + (v[2] * v[2] + v[3] * v[3]); }
                    ss += __shfl_xor(ss, 16); ss += __shfl_xor(ss, 32);
                    const float rstd = rsqrtf(ss * (1.f / 64.f) + RMS_EPS);
                    bf16_t* rowp = O + (size_t)row * NPROJ_PAD + col0; const float* rp = rope + (size_t)row * 64 + 8 * fq;
#pragma unroll
                    for (int bj = 0; bj < 2; ++bj) { const f32x4 c0 = *(const f32x4*)(rp + 32 * bj), c1 = *(const f32x4*)(rp + 32 * bj + 4);
                        const f32x4 t1 = acc[ai][bj][m][0] * rstd * gn[bj][0], t2 = acc[ai][bj][m][1] * rstd * gn[bj][1];
                        f32x4 o1, o2;
                        o1[0] = (t1[0] * c0[0] - t2[0] * c0[1]) * sc; o2[0] = (t1[0] * c0[1] + t2[0] * c0[0]) * sc;
                        o1[1] = (t1[1] * c0[2] - t2[1] * c0[3]) * sc; o2[1] = (t1[1] * c0[3] + t2[1] * c0[2]) * sc;
                        o1[2] = (t1[2] * c1[0] - t2[2] * c1[1]) * sc; o2[2] = (t1[2] * c1[1] + t2[2] * c1[0]) * sc;
                        o1[3] = (t1[3] * c1[2] - t2[3] * c1[3]) * sc; o2[3] = (t1[3] * c1[3] + t2[3] * c1[2]) * sc;
                        u32x4 w; w.x = pk2(o1[0], o1[1]); w.y = pk2(o1[2], o1[3]); w.z = pk2(o2[0], o2[1]); w.w = pk2(o2[2], o2[3]);
                        *(u32x4*)(rowp + bj * 128) = w; } }
            return;
        }
#pragma unroll
        for (int ai = 0; ai < 2; ++ai)
#pragma unroll
            for (int m = 0; m < 4; ++m) { bf16_t* rowp = O + (size_t)(row0 + ai * 128 + m * 16) * NPROJ_PAD + col0;
#pragma unroll
                for (int bj = 0; bj < 2; ++bj) { const f32x4 v0 = acc[ai][bj][m][0], v1 = acc[ai][bj][m][1];
                    u32x4 w; w.x = pk2(v0[0], v0[1]); w.y = pk2(v0[2], v0[3]); w.z = pk2(v1[0], v1[1]); w.w = pk2(v1[2], v1[3]);
                    *(u32x4*)(rowp + bj * 128) = w; } }
        if (u.pn == 22 && wc == 0) {
#pragma unroll
            for (int ai = 0; ai < 2; ++ai)
#pragma unroll
                for (int m = 0; m < 4; ++m) { float* p = dtraw + (size_t)(row0 + ai * 128 + m * 16) * 32 + 8 * fq;
                    *(f32x4*)p = acc[ai][0][m][0]; *(f32x4*)(p + 4) = acc[ai][0][m][1]; }
        }
    }
};
struct EpiOut {
    static constexpr bool PERM = true;
    const float* x; const float* mod; bf16_t* x1; float* rss;
    __device__ __forceinline__ void operator()(const f32x4 (&acc)[2][2][4][2], const pg8::Unit& u, int wr, int wc, int fr, int fq) const {
        const int row0 = u.pm * 256 + wr * 64 + fr, col0 = u.pn * 256 + wc * 32 + 8 * fq;
        const float* gp = mod + (size_t)(u.pm >= 32 ? 1 : 0) * 12288 + 2 * D + col0;
        f32x4 gv[2][2];
#pragma unroll
        for (int bj = 0; bj < 2; ++bj)
#pragma unroll
            for (int n = 0; n < 2; ++n) gv[bj][n] = *(const f32x4*)(gp + bj * 128 + n * 4);
        f32x4 xa[2][2][2], xb[2][2][2];
#define EO_LOAD(ch_, buf_) do { _Pragma("unroll") for (int mm = 0; mm < 2; ++mm) { const float* p_ = x + (size_t)(row0 + ((ch_) >> 1) * 128 + (2 * ((ch_) & 1) + mm) * 16) * D + col0; \
            _Pragma("unroll") for (int bj = 0; bj < 2; ++bj) { buf_[mm][bj][0] = __builtin_nontemporal_load((const f32x4*)(p_ + bj * 128)); buf_[mm][bj][1] = __builtin_nontemporal_load((const f32x4*)(p_ + bj * 128 + 4)); } } } while (0)
#define EO_PROC(ch_, buf_) do { _Pragma("unroll") for (int mm = 0; mm < 2; ++mm) { const int ai_ = (ch_) >> 1, m_ = 2 * ((ch_) & 1) + mm; const size_t off = (size_t)(row0 + ai_ * 128 + m_ * 16) * D + col0; float ss = 0.f; \
            _Pragma("unroll") for (int bj = 0; bj < 2; ++bj) { const f32x4 o0 = buf_[mm][bj][0] + gv[bj][0] * acc[ai_][bj][m_][0], o1 = buf_[mm][bj][1] + gv[bj][1] * acc[ai_][bj][m_][1]; \
                ss += (o0[0] * o0[0] + o0[1] * o0[1]) + (o0[2] * o0[2] + o0[3] * o0[3]) + (o1[0] * o1[0] + o1[1] * o1[1]) + (o1[2] * o1[2] + o1[3] * o1[3]); \
                u32x4 w; w.x = pk2(o0[0], o0[1]); w.y = pk2(o0[2], o0[3]); w.z = pk2(o1[0], o1[1]); w.w = pk2(o1[2], o1[3]); \
                *(u32x4*)(x1 + off + bj * 128) = w; } \
            ss += __shfl_xor(ss, 16); ss += __shfl_xor(ss, 32); \
            if (fq == 0) rss[(size_t)(row0 + ai_ * 128 + m_ * 16) * 32 + 4 * u.pn + wc] = ss; } } while (0)
        EO_LOAD(0, xa); EO_LOAD(1, xb); asm volatile("" ::: "memory");
        EO_PROC(0, xa); asm volatile("" ::: "memory"); EO_LOAD(2, xa); asm volatile("" ::: "memory");
        EO_PROC(1, xb); asm volatile("" ::: "memory"); EO_LOAD(3, xb); asm volatile("" ::: "memory");
        EO_PROC(2, xa); EO_PROC(3, xb);
#undef EO_LOAD
#undef EO_PROC
    }
};
struct EpiGU {
    static constexpr bool PERM = true;
    bf16_t* H;
    __device__ __forceinline__ void operator()(const f32x4 (&acc)[2][2][4][2], const pg8::Unit& u, int wr, int wc, int fr, int fq) const {
        const int row0 = u.pm * 256 + wr * 64 + fr, col0 = u.pn * 128 + wc * 16 + 4 * fq;
#pragma unroll
        for (int ai = 0; ai < 2; ++ai)
#pragma unroll
            for (int m = 0; m < 4; ++m) { bf16_t* rowp = H + (size_t)(row0 + ai * 128 + m * 16) * EH + col0;
#pragma unroll
                for (int bj = 0; bj < 2; ++bj) { const f32x4 gt = acc[ai][bj][m][0], up = acc[ai][bj][m][1];
                    u32x2 w; w.x = pk2(silu_f(gt[0]) * up[0], silu_f(gt[1]) * up[1]); w.y = pk2(silu_f(gt[2]) * up[2], silu_f(gt[3]) * up[3]);
                    *(u32x2*)(rowp + bj * 64) = w; } }
    }
};
struct EpiDown {
    static constexpr bool PERM = true;
    bf16_t* Y; const LAS int* tab;
    __device__ __forceinline__ void operator()(const f32x4 (&acc)[2][2][4][2], const pg8::Unit& u, int wr, int wc, int fr, int fq) const {
        const int col0 = u.pn * 256 + wc * 32 + 8 * fq;
        const LAS int* tb = tab + u.li * 512;
#pragma unroll
        for (int ai = 0; ai < 2; ++ai)
#pragma unroll
            for (int m = 0; m < 4; ++m) { const int r = ai * 128 + wr * 64 + m * 16 + fr; const int a = tb[2 * r]; const float gt = __int_as_float(tb[2 * r + 1]);
                if (a >= 0) { bf16_t* rowp = Y + (size_t)a * D + col0;
#pragma unroll
                    for (int bj = 0; bj < 2; ++bj) { const f32x4 v0 = acc[ai][bj][m][0] * gt, v1 = acc[ai][bj][m][1] * gt;
                        u32x4 w; w.x = pk2(v0[0], v0[1]); w.y = pk2(v0[2], v0[3]); w.z = pk2(v1[0], v1[1]); w.w = pk2(v1[2], v1[3]);
                        *(u32x4*)(rowp + bj * 128) = w; } } }
    }
};
struct MoeOrder {
    const LAS int* tilebase; int ntiles, npn, G, c; const LAS unsigned* goff_tab;
    __device__ __forceinline__ bool next(int i, pg8::Unit& u) const {
        const long L = (long)i * G + c; if (L >= (long)ntiles * npn) return false;
        const int tau = (int)(L / npn); u.pn = (int)(L % npn); u.pm = tau; u.li = i;
        int e = 0;
        for (int j = 1; j < NEXP; ++j) e += (tilebase[j] <= tau) ? 1 : 0;
        u.e = e; return true;
    }
    __device__ __forceinline__ void a_ready(const pg8::Unit&) const {}
    __device__ __forceinline__ void done(const pg8::Unit&) const {}
    __device__ __forceinline__ void load_goff(const pg8::Unit& u, unsigned (&goff)[2][2], const int (&RA)[2], const int (&CA)[2]) const {
        const LAS unsigned* tb = goff_tab + u.li * 256;
#pragma unroll
        for (int h = 0; h < 2; ++h)
#pragma unroll
            for (int i = 0; i < 2; ++i) goff[h][i] = tb[h * 128 + RA[i]] + (unsigned)CA[i] * 2u;
    }
};

struct Args { const void* in[24]; float* out; unsigned char* ws; int ph_lo, ph_hi; };
enum InIdx { I_X = 0, I_C, I_POS, I_WADA, I_BADA, I_N1G, I_WIN, I_CONVW, I_CONVB, I_DTBIAS, I_ALOG, I_DSKIP, I_SSDG, I_QG, I_KG, I_WOUT, I_N2G, I_WRG, I_BRG, I_WRE, I_BRE, I_WG, I_WU, I_WD };

__device__ __forceinline__ int vcu_id() { const int G = gridDim.x, bx = blockIdx.x; return (G % 8 == 0) ? (bx % 8) * (G / 8) + bx / 8 : bx; }
__device__ __forceinline__ float wave_sum(float v) {
#pragma unroll
    for (int o = 1; o < 64; o <<= 1) v += __shfl_xor(v, o);
    return v;
}

__device__ __forceinline__ void p0_adaln(const float* c, const float* w_ada, const float* b_ada, float* mod, LAS float* lds) {
    const int tid = threadIdx.x;
    LAS float* sc = lds; LAS float* red = lds + 4096;
    { const f32x4 c0 = *(const f32x4*)(c + 8 * tid), c1 = *(const f32x4*)(c + 8 * tid + 4);
#pragma unroll
      for (int j = 0; j < 4; ++j) { sc[8 * tid + j] = silu_f(c0[j]); sc[8 * tid + 4 + j] = silu_f(c1[j]); } }
    __syncthreads();
    for (int cg = blockIdx.x; cg < 256; cg += gridDim.x) {
        if (tid < 504) {
            const int c4 = tid % 12, r0 = tid / 12;
            f32x4 a0 = {0.f, 0.f, 0.f, 0.f}, a1 = {0.f, 0.f, 0.f, 0.f};
            const float* wp = w_ada + 48 * cg + 4 * c4;
#pragma unroll 7
            for (int k = r0; k < D; k += 42) { const f32x4 w = __builtin_nontemporal_load((const f32x4*)(wp + (size_t)k * 12288)); a0 += w * sc[k]; a1 += w * sc[D + k]; }
            LAS float* rp = red + (r0 * 12 + c4) * 8;
            rp[0] = a0[0]; rp[1] = a0[1]; rp[2] = a0[2]; rp[3] = a0[3]; rp[4] = a1[0]; rp[5] = a1[1]; rp[6] = a1[2]; rp[7] = a1[3];
        }
        __syncthreads();
        if (tid < 96) {
            const int c4 = tid >> 3, j = tid & 7; float s = 0.f;
            for (int r = 0; r < 42; ++r) s += red[(r * 12 + c4) * 8 + j];
            const int col = 48 * cg + 4 * c4 + (j & 3);
            mod[(j >> 2) * 12288 + col] = s + b_ada[col];
        }
        __syncthreads();
    }
}
template <class RowMap>
__device__ __forceinline__ void transpose_item(const float* W, int ldw, int nvalid, bf16_t* WT, int ldt, int k0, int n0, LAS float* scr, int lane, RowMap rm) {
#pragma unroll 4
    for (int it = 0; it < 16; ++it) {
        const int kk = 4 * it + (lane >> 4), n = n0 + 4 * (lane & 15);
        f32x4 v = {0.f, 0.f, 0.f, 0.f};
        if (n < nvalid) v = __builtin_nontemporal_load((const f32x4*)(W + (size_t)(k0 + kk) * ldw + n));
        LAS float* s = scr + kk * 65 + 4 * (lane & 15);
        s[0] = v[0]; s[1] = v[1]; s[2] = v[2]; s[3] = v[3];
    }
    LDS_WAIT(); asm volatile("" ::: "memory");
    const int c = lane & 7;
#pragma unroll
    for (int j = 0; j < 8; ++j) {
        const int nn = (lane >> 3) + 8 * j, n = n0 + nn;
        const LAS float* s = scr + (8 * c) * 65 + nn;
        u32x4 o; o.x = pk2(s[0], s[65]); o.y = pk2(s[2 * 65], s[3 * 65]); o.z = pk2(s[4 * 65], s[5 * 65]); o.w = pk2(s[6 * 65], s[7 * 65]);
        if (n < nvalid) *(u32x4*)(WT + (size_t)rm(n) * ldt + k0 + 8 * c) = o;
    }
    LDS_WAIT(); asm volatile("" ::: "memory");
}
struct RmId { __device__ __forceinline__ int operator()(int n) const { return n; } };
struct RmIn { __device__ __forceinline__ int operator()(int c) const { if (c >= 2048) return c; const int blk = c & ~1023, hd = (c >> 6) & 15, i = c & 63;
    return blk + 256 * (hd >> 2) + 128 * ((i >> 4) & 1) + 32 * (hd & 3) + 8 * ((i >> 2) & 3) + 4 * (i >> 5) + (i & 3); } };
struct RmGU { int add; __device__ __forceinline__ int operator()(int n) const { return 8 * (n >> 2) + add + (n & 3); } };

__device__ __forceinline__ void p0_prologue(const Args& A, LAS unsigned char* lds) {
    const int tid = threadIdx.x, lane = tid & 63, wave = tid >> 6;
    unsigned char* ws = A.ws;
    p0_adaln((const float*)A.in[I_C], (const float*)A.in[I_WADA], (const float*)A.in[I_BADA], (float*)(ws + WS_MOD), (LAS float*)lds);
    const int gtid = blockIdx.x * 512 + tid, NT = gridDim.x * 512;
    { const int* pos = (const int*)A.in[I_POS]; float* rope = (float*)(ws + WS_ROPE);
      const int f = gtid & 31; const float invf = powf(10000.0f, -(float)f / 32.0f);
      for (int t0 = gtid >> 5; t0 < T; t0 += 4 * (NT >> 5)) { int pv[4];
#pragma unroll
          for (int u = 0; u < 4; ++u) { const int t = t0 + u * (NT >> 5); pv[u] = pos[t < T ? t : T - 1]; }
#pragma unroll
          for (int u = 0; u < 4; ++u) { const int t = t0 + u * (NT >> 5); if (t < T) { const float ang = (float)pv[u] * invf;
              const double rev = (double)ang * 0.15915494309189533577; const float fr = (float)(rev - rint(rev));
              f32x2 cs = {__builtin_amdgcn_cosf(fr), __builtin_amdgcn_sinf(fr)}; *(f32x2*)(rope + 2 * (t * 32 + f)) = cs; } } } }
    { const float* wrg = (const float*)A.in[I_WRG]; const float* wre = (const float*)A.in[I_WRE]; bf16_t* hi = (bf16_t*)(ws + WS_WRT);
      for (int i = gtid; i < NRT * D; i += NT) { const int n = i / D, k = i % D; float w = 0.f;
          if (n < 8) w = wrg[k * 8 + n]; else if (n >= 16) w = wre[k * 64 + (n - 16)];
          hi[i] = (bf16_t)f2bf(w); } }
    { u32x4* z = (u32x4*)(ws + WS_WINT + (size_t)NPROJ * D * 2); const int n16 = (NPROJ_PAD - NPROJ) * D * 2 / 16;
      for (int i = gtid; i < n16; i += NT) z[i] = (u32x4){0u, 0u, 0u, 0u}; }
    __syncthreads();
    LAS float* scr = (LAS float*)(lds) + wave * (64 * 65);
    const int gw = blockIdx.x * 8 + wave, NGW = gridDim.x * 8;
    constexpr int I_IN = 32 * 89;
    const float* W = (const float*)A.in[I_WIN]; bf16_t* WT = (bf16_t*)(ws + WS_WINT);
    f32x4 va[16], vb[16];
#define WIN_LOAD(it_, v_) do { const int k0_ = 64 * ((it_) / 89), n_ = 64 * ((it_) % 89) + 4 * (lane & 15); const float* p_ = W + (size_t)(k0_ + (lane >> 4)) * NPROJ + (n_ < NPROJ ? n_ : NPROJ - 4); \
        _Pragma("unroll") for (int i_ = 0; i_ < 16; ++i_) v_[i_] = __builtin_nontemporal_load((const f32x4*)(p_ + (size_t)(4 * i_) * NPROJ)); } while (0)
#define WIN_STORE(it_, v_) do { const int k0_ = 64 * ((it_) / 89), n0_ = 64 * ((it_) % 89); \
        _Pragma("unroll") for (int i_ = 0; i_ < 16; ++i_) { LAS float* sp_ = scr + (4 * i_ + (lane >> 4)) * 65 + 4 * (lane & 15); sp_[0] = v_[i_][0]; sp_[1] = v_[i_][1]; sp_[2] = v_[i_][2]; sp_[3] = v_[i_][3]; } \
        LDS_WAIT(); asm volatile("" ::: "memory"); const int c_ = lane & 7; \
        _Pragma("unroll") for (int j_ = 0; j_ < 8; ++j_) { const int nn_ = (lane >> 3) + 8 * j_, n_ = n0_ + nn_; const LAS float* sp_ = scr + (8 * c_) * 65 + nn_; \
            u32x4 o_; o_.x = pk2(sp_[0], sp_[65]); o_.y = pk2(sp_[2 * 65], sp_[3 * 65]); o_.z = pk2(sp_[4 * 65], sp_[5 * 65]); o_.w = pk2(sp_[6 * 65], sp_[7 * 65]); \
            if (n_ < NPROJ) *(u32x4*)(WT + (size_t)RmIn{}(n_) * D + k0_ + 8 * c_) = o_; } \
        LDS_WAIT(); asm volatile("" ::: "memory"); } while (0)
    int it = gw;
    if (it < I_IN) WIN_LOAD(it, va);
    while (it < I_IN) {
        const bool hb = it + NGW < I_IN;
        if (hb) WIN_LOAD(it + NGW, vb);
        WIN_STORE(it, va);
        if (!hb) break;
        const bool ha = it + 2 * NGW < I_IN;
        if (ha) WIN_LOAD(it + 2 * NGW, va);
        WIN_STORE(it + NGW, vb);
        if (!ha) break;
        it += 2 * NGW;
    }
#undef WIN_LOAD
#undef WIN_STORE
}
struct TItem { const float* src; bf16_t* dst; int ldw, ldt, gu, n0; };
__device__ __forceinline__ void late_item(const Args& A, int it, TItem& d) {
    unsigned char* ws = A.ws;
    constexpr int I_OUT = 32 * 32, I_E = 32 * 8, I_DN = 8 * 32;
    int r = it;
    if (r < I_OUT) { const int k0 = 64 * (r / 32), n0 = 64 * (r % 32); d.src = (const float*)A.in[I_WOUT] + (size_t)k0 * D + n0; d.dst = (bf16_t*)(ws + WS_WOUTT) + k0; d.ldw = D; d.ldt = D; d.gu = -1; d.n0 = n0; return; }
    r -= I_OUT;
    const int e = r / (2 * I_E + I_DN); r -= e * (2 * I_E + I_DN);
    if (r < 2 * I_E) { const int up = r >= I_E ? 1 : 0; r -= up * I_E; const int k0 = 64 * (r / 8), n0 = 64 * (r % 8);
        d.src = (const float*)A.in[up ? I_WU : I_WG] + (size_t)e * D * EH + (size_t)k0 * EH + n0; d.dst = (bf16_t*)(ws + WS_WGUT) + (size_t)e * 1024 * D + k0; d.ldw = EH; d.ldt = D; d.gu = 4 * up; d.n0 = n0; return; }
    r -= 2 * I_E;
    { const int k0 = 64 * (r / 32), n0 = 64 * (r % 32); d.src = (const float*)A.in[I_WD] + (size_t)e * EH * D + (size_t)k0 * D + n0; d.dst = (bf16_t*)(ws + WS_WDT) + (size_t)e * D * EH + k0; d.ldw = D; d.ldt = EH; d.gu = -1; d.n0 = n0; }
}
__device__ __forceinline__ void titem_load(const TItem& d, f32x4 (&v)[16], int lane) {
    const float* p = d.src + (size_t)(lane >> 4) * d.ldw + 4 * (lane & 15);
#pragma unroll
    for (int i = 0; i < 16; ++i) v[i] = __builtin_nontemporal_load((const f32x4*)(p + (size_t)(4 * i) * d.ldw));
}
__device__ __forceinline__ void titem_store(const TItem& d, const f32x4 (&v)[16], LAS float* scr, int lane) {
#pragma unroll
    for (int i = 0; i < 16; ++i) { LAS float* sp = scr + (4 * i + (lane >> 4)) * 65 + 4 * (lane & 15); sp[0] = v[i][0]; sp[1] = v[i][1]; sp[2] = v[i][2]; sp[3] = v[i][3]; }
    LDS_WAIT(); asm volatile("" ::: "memory");
    const int c = lane & 7;
#pragma unroll
    for (int j = 0; j < 8; ++j) { const int nn = (lane >> 3) + 8 * j, n = d.n0 + nn; const LAS float* sp = scr + (8 * c) * 65 + nn;
        u32x4 o; o.x = pk2(sp[0], sp[65]); o.y = pk2(sp[2 * 65], sp[3 * 65]); o.z = pk2(sp[4 * 65], sp[5 * 65]); o.w = pk2(sp[6 * 65], sp[7 * 65]);
        const int row = d.gu < 0 ? n : (8 * (n >> 2) + d.gu + (n & 3));
        __builtin_nontemporal_store(o, (u32x4*)(d.dst + (size_t)row * d.ldt + 8 * c)); }
    LDS_WAIT(); asm volatile("" ::: "memory");
}
__device__ __forceinline__ int claim_items(unsigned* ctr, unsigned n) { unsigned v = 0; if ((threadIdx.x & 63) == 0) v = __hip_atomic_fetch_add(ctr, n, __ATOMIC_RELAXED, __HIP_MEMORY_SCOPE_AGENT); return (int)__builtin_amdgcn_readfirstlane(v); }
__device__ __forceinline__ void p2_convert_late(const Args& A, LAS unsigned char* lds) {
    const int lane = threadIdx.x & 63, wave = threadIdx.x >> 6;
    LAS float* scr = (LAS float*)(lds) + wave * (64 * 65);
    unsigned* ctr = (unsigned*)(A.ws + WS_CTL) + CW_FLAG + 64;
    constexpr int NITEMS = 32 * 32 + NEXP * (2 * 32 * 8 + 8 * 32), CB = 16;
    int base = claim_items(ctr, CB), pos = 0;
#define CONV_NEXT() ({ if (pos == CB) { base = claim_items(ctr, CB); pos = 0; } const int r_ = base + pos; ++pos; r_; })
#define CONV_PROC(d_, v_, itn_) do { \
        _Pragma("unroll") for (int i = 0; i < 16; ++i) { LAS float* sp = scr + (4 * i + (lane >> 4)) * 65 + 4 * (lane & 15); sp[0] = v_[i][0]; sp[1] = v_[i][1]; sp[2] = v_[i][2]; sp[3] = v_[i][3]; } \
        const TItem dc_ = d_; late_item(A, (itn_) < NITEMS ? (itn_) : NITEMS - 1, d_); titem_load(d_, v_, lane); \
        LDS_WAIT(); asm volatile("" ::: "memory"); \
        const int c = lane & 7; \
        _Pragma("unroll") for (int j = 0; j < 8; ++j) { const int nn = (lane >> 3) + 8 * j, n = dc_.n0 + nn; const LAS float* sp = scr + (8 * c) * 65 + nn; \
            u32x4 o; o.x = pk2(sp[0], sp[65]); o.y = pk2(sp[2 * 65], sp[3 * 65]); o.z = pk2(sp[4 * 65], sp[5 * 65]); o.w = pk2(sp[6 * 65], sp[7 * 65]); \
            const int row = dc_.gu < 0 ? n : (8 * (n >> 2) + dc_.gu + (n & 3)); \
            __builtin_nontemporal_store(o, (u32x4*)(dc_.dst + (size_t)row * dc_.ldt + 8 * c)); } \
        LDS_WAIT(); asm volatile("" ::: "memory"); } while (0)
    TItem da, db; f32x4 va[16], vb[16];
    int ia = CONV_NEXT(), ib = CONV_NEXT();
    late_item(A, ia < NITEMS ? ia : NITEMS - 1, da); titem_load(da, va, lane);
    late_item(A, ib < NITEMS ? ib : NITEMS - 1, db); titem_load(db, vb, lane);
#pragma unroll 1
    for (;;) {
        if (ia >= NITEMS) break;
        { const int in = CONV_NEXT(); CONV_PROC(da, va, in); ia = in; }
        if (ib >= NITEMS) break;
        { const int in = CONV_NEXT(); CONV_PROC(db, vb, in); ib = in; }
    }
#undef CONV_NEXT
#undef CONV_PROC
}

__device__ __forceinline__ void p1_norm1(const Args& A) {
    const int tid = threadIdx.x, lane = tid & 63, wave = tid >> 6;
    const float* x = (const float*)A.in[I_X]; const float* g1 = (const float*)A.in[I_N1G]; const float* mod = (const float*)(A.ws + WS_MOD);
    bf16_t* hb = (bf16_t*)(A.ws + WS_HB);
    const int gw = blockIdx.x * 8 + wave, NGW = gridDim.x * 8, NB = NGW / BATCH, bsel = gw / NB, r0 = gw - bsel * NB;
    if (bsel >= BATCH) return;
    const float* mb = mod + bsel * 12288;
    f32x4 ca[8], cs[8];
#pragma unroll
    for (int j = 0; j < 8; ++j) { const int col = 4 * lane + 256 * j; const f32x4 g = *(const f32x4*)(g1 + col), sc = *(const f32x4*)(mb + D + col); ca[j] = g * (sc + 1.f); cs[j] = *(const f32x4*)(mb + col); }
    f32x4 v[8], vn[8];
    if (r0 < SEQ) { const f32x4* xr = (const f32x4*)(x + (size_t)(bsel * SEQ + r0) * D) + lane;
#pragma unroll
        for (int j = 0; j < 8; ++j) vn[j] = __builtin_nontemporal_load(xr + 64 * j); }
    for (int r = r0; r < SEQ; r += NB) { const int m = bsel * SEQ + r;
#pragma unroll
        for (int j = 0; j < 8; ++j) v[j] = vn[j];
        if (r + NB < SEQ) { const f32x4* xr = (const f32x4*)(x + (size_t)(m + NB) * D) + lane;
#pragma unroll
            for (int j = 0; j < 8; ++j) vn[j] = __builtin_nontemporal_load(xr + 64 * j); }
        float s = 0.f;
#pragma unroll
        for (int j = 0; j < 8; ++j) s += (v[j][0] * v[j][0] + v[j][1] * v[j][1]) + (v[j][2] * v[j][2] + v[j][3] * v[j][3]);
        const float rstd = rsqrtf(wave_sum(s) * (1.f / D) + RMS_EPS);
        u32x2* o = (u32x2*)(hb + (size_t)m * D) + lane;
#pragma unroll
        for (int j = 0; j < 8; ++j) { const f32x4 h = (v[j] * rstd) * ca[j] + cs[j];
            u32x2 w; w.x = pk2(h[0], h[1]); w.y = pk2(h[2], h[3]); o[64 * j] = w; }
    }
}

__device__ __forceinline__ void p3_post(const Args& A, int dryA, int repB) {
    const int tid = threadIdx.x, lane = tid & 63, wave = tid >> 6;
    unsigned char* ws = A.ws;
    bf16_t* proj = (bf16_t*)(ws + WS_PROJ);
    const int gw = blockIdx.x * 8 + wave, NGW = gridDim.x * 8;
    for (int rb = 0; rb < repB; ++rb) { const float* cw = (const float*)A.in[I_CONVW]; const float* cb = (const float*)A.in[I_CONVB]; bf16_t* xc = (bf16_t*)(ws + WS_HB);
      for (int tb = gw; tb < T / 8; tb += NGW) {
          const int t0 = tb * 8, s0 = t0 & (SEQ - 1), sb = t0 - s0;
          u32x4 ra[12]; f32x4 wa[5], wb[5], ba, bb;
#define P3_LOAD(c8_, r_, wa_, wb_, ba_, bb_) do { const bf16_t* pc_ = proj + OFF_XBC + (c8_); \
              _Pragma("unroll") for (int k = 0; k < 12; ++k) { int t_ = t0 + k - 2; t_ = t_ < sb ? sb : t_; t_ = t_ > sb + SEQ - 1 ? sb + SEQ - 1 : t_; r_[k] = *(const u32x4*)(pc_ + (size_t)t_ * NPROJ_PAD); } \
              _Pragma("unroll") for (int k = 0; k < 5; ++k) { wa_[k] = *(const f32x4*)(cw + k * XBCW + (c8_)); wb_[k] = *(const f32x4*)(cw + k * XBCW + (c8_) + 4); } \
              ba_ = *(const f32x4*)(cb + (c8_)); bb_ = *(const f32x4*)(cb + (c8_) + 4); } while (0)
#pragma unroll 1
          for (int st = 0; st < 3; ++st) { const int c8 = 8 * (lane + 64 * st);
              P3_LOAD(c8, ra, wa, wb, ba, bb);
              if (s0 == 0) { ra[0] = (u32x4){0u, 0u, 0u, 0u}; ra[1] = (u32x4){0u, 0u, 0u, 0u}; }
              if (s0 == SEQ - 8) { ra[10] = (u32x4){0u, 0u, 0u, 0u}; ra[11] = (u32x4){0u, 0u, 0u, 0u}; }
#pragma unroll
              for (int j = 0; j < 8; ++j) {
                  f32x4 a0 = ba, a1 = bb;
#pragma unroll
                  for (int k = 0; k < 5; ++k) { const u32x4 w = ra[j + k];
                      a0[0] += lo_f(w.x) * wa[k][0]; a0[1] += hi_f(w.x) * wa[k][1]; a0[2] += lo_f(w.y) * wa[k][2]; a0[3] += hi_f(w.y) * wa[k][3];
                      a1[0] += lo_f(w.z) * wb[k][0]; a1[1] += hi_f(w.z) * wb[k][1]; a1[2] += lo_f(w.w) * wb[k][2]; a1[3] += hi_f(w.w) * wb[k][3]; }
                  u32x4 o; o.x = pk2(silu_f(a0[0]), silu_f(a0[1])); o.y = pk2(silu_f(a0[2]), silu_f(a0[3])); o.z = pk2(silu_f(a1[0]), silu_f(a1[1])); o.w = pk2(silu_f(a1[2]), silu_f(a1[3]));
                  *(u32x4*)(xc + (size_t)(t0 + j) * XBCW + c8) = o; }
          }
#undef P3_LOAD
      } }
    { const float* dtraw = (const float*)(ws + WS_DTRAW); const float* dtbias = (const float*)A.in[I_DTBIAS]; const float* alog = (const float*)A.in[I_ALOG];
      float* dtf = (float*)(ws + WS_DTF); float* dtb = (float*)(ws + WS_DTB); float* acs = (float*)(ws + WS_ACS); float* rcs = (float*)(ws + WS_RCS); float* dec = (float*)(ws + WS_DEC);
      const int h = lane & 15, q = lane >> 4;
      for (int it = gw; it < BATCH * NCHUNK * 2; it += NGW) {
          const int dir = it & 1, bc = it >> 1; const int t0 = bc * CHUNK + 32 * q;
          const float aneg = -__expf(alog[dir * 16 + h]), bias = dtbias[dir * 16 + h];
          float d[32];
#pragma unroll
          for (int i = 0; i < 32; ++i) d[i] = dtraw[(size_t)(t0 + i) * 32 + dir * 16 + h];
          float tot = 0.f;
#pragma unroll
          for (int i = 0; i < 32; ++i) { const float r = d[i] + bias; d[i] = r > 20.f ? r : log1pf(__expf(r)); tot += d[i] * aneg; }
          const float t1 = __shfl_xor(tot, 16), t2 = __shfl_xor(tot, 32), t3 = __shfl_xor(tot, 48);
          float tq[4]; tq[q] = tot; tq[q ^ 1] = t1; tq[q ^ 2] = t2; tq[q ^ 3] = t3;
          float base = 0.f;
          if (dir == 0) { for (int j = 0; j < 4; ++j) if (j < q) base += tq[j]; } else { for (int j = 0; j < 4; ++j) if (j > q) base += tq[j]; }
          float* dd = dir ? dtb : dtf; float* cc = dir ? rcs : acs;
          if (dir == 0) { float run = base;
#pragma unroll
              for (int i = 0; i < 32; ++i) { run += d[i] * aneg; dd[(size_t)(t0 + i) * 16 + h] = d[i]; cc[(size_t)(t0 + i) * 16 + h] = run; } }
          else { float run = base;
#pragma unroll
              for (int i = 31; i >= 0; --i) { run += d[i] * aneg; dd[(size_t)(t0 + i) * 16 + h] = d[i]; cc[(size_t)(t0 + i) * 16 + h] = run; } }
          if (q == 0) dec[bc * 32 + dir * 16 + h] = __expf(tq[0] + tq[1] + tq[2] + tq[3]);
      } }
}

__device__ __forceinline__ bf16x8 mk_frag(u32x4 w) { return __builtin_bit_cast(bf16x8, w); }
__device__ __forceinline__ f32x4 mfma16(bf16x8 a, bf16x8 b, f32x4 c) { return __builtin_amdgcn_mfma_f32_16x16x32_bf16(a, b, c, 0, 0, 0); }

typedef short v4i16_t __attribute__((ext_vector_type(4)));
__device__ __forceinline__ u32x2 lds_tr16(const LAS bf16_t* p) { return __builtin_bit_cast(u32x2, __builtin_amdgcn_ds_read_tr16_b64_v4i16((LAS v4i16_t*)p)); }
__device__ __forceinline__ bf16x8 lds_tr16x2(const LAS bf16_t* p, int rowstep4) { const u32x2 a = lds_tr16(p), b = lds_tr16(p + rowstep4); u32x4 w; w.x = a.x; w.y = a.y; w.z = b.x; w.w = b.y; return mk_frag(w); }

constexpr int SP = 136;
constexpr int XP = 72;
__device__ __forceinline__ void p4_ssd_local(const Args& A, LAS unsigned char* lds, int rep) {
    const int tid = threadIdx.x, lane = tid & 63, w = __builtin_amdgcn_readfirstlane(tid >> 6), fr = lane & 15, fq = lane >> 4;
    unsigned char* ws = A.ws;
    const bf16_t* xc = (const bf16_t*)(ws + WS_HB);
    const float* DTF = (const float*)(ws + WS_DTF); const float* DTB = (const float*)(ws + WS_DTB); const float* ACS = (const float*)(ws + WS_ACS); const float* RCS = (const float*)(ws + WS_RCS);
    bf16_t* YD = (bf16_t*)(ws + WS_YD); bf16_t* ST = (bf16_t*)(ws + WS_ST);
    LAS bf16_t* Cs = (LAS bf16_t*)lds; LAS bf16_t* Bs = (LAS bf16_t*)(lds + 34816);
    LAS bf16_t* Xs = (LAS bf16_t*)(lds + 69632);
    LAS float* VEC = (LAS float*)(lds + 69632 + 36864);
    const int sl = tid >> 2, sq = tid & 3;
    for (int uu = vcu_id(); uu < BATCH * NCHUNK * 2 * rep; uu += gridDim.x) { const int u = uu & 255;
        const int b = u >> 7, c = (u >> 1) & 63, g = u & 1; const int t0 = b * SEQ + c * CHUNK;
        u32x4 xv[2]; float vv[6];
#define P4_XLOAD(h_) do { const bf16_t* src_ = xc + (size_t)(t0 + sl) * XBCW + 64 * (h_) + 16 * sq; xv[0] = *(const u32x4*)src_; xv[1] = *(const u32x4*)(src_ + 8); \
            if (tid < 128) { const size_t o_ = (size_t)(t0 + tid) * 16 + (h_); vv[0] = DTF[o_]; vv[1] = DTB[o_]; vv[2] = ACS[o_]; vv[3] = RCS[o_]; vv[4] = ACS[(size_t)(t0 + 127) * 16 + (h_)]; vv[5] = RCS[(size_t)t0 * 16 + (h_)]; } } while (0)
#define P4_XSTORE(buf_) do { *(LAS u32x4*)(Xs + (buf_) * (128 * XP) + sl * XP + 16 * sq) = xv[0]; *(LAS u32x4*)(Xs + (buf_) * (128 * XP) + sl * XP + 16 * sq + 8) = xv[1]; \
            if (tid < 128) { LAS float* v_ = VEC + (buf_) * 768; v_[tid] = vv[0]; v_[128 + tid] = vv[1]; v_[256 + tid] = vv[2]; v_[384 + tid] = vv[3]; v_[512 + tid] = __expf(vv[4] - vv[2]) * vv[0]; v_[640 + tid] = __expf(vv[5] - vv[3]) * vv[1]; } } while (0)
        { const bf16_t* src = xc + (size_t)(t0 + sl) * XBCW + 1024 + 128 * g + 32 * sq;
#pragma unroll
          for (int i = 0; i < 4; ++i) { *(LAS u32x4*)(Bs + sl * SP + 32 * sq + 8 * i) = *(const u32x4*)(src + 8 * i); *(LAS u32x4*)(Cs + sl * SP + 32 * sq + 8 * i) = *(const u32x4*)(src + 256 + 8 * i); } }
        P4_XLOAD(8 * g);
        __syncthreads();
        { bf16x8 cf[4];
#pragma unroll
          for (int ks = 0; ks < 4; ++ks) cf[ks] = *(const LAS bf16x8*)(Cs + (16 * w + fr) * SP + 32 * ks + 8 * fq);
          u32x2 cbw[8];
#pragma unroll
          for (int st = 0; st < 8; ++st) { f32x4 acc = {0.f, 0.f, 0.f, 0.f};
#pragma unroll
              for (int ks = 0; ks < 4; ++ks) acc = mfma16(*(const LAS bf16x8*)(Bs + (16 * st + fr) * SP + 32 * ks + 8 * fq), cf[ks], acc);
              cbw[st].x = pk2(acc[0], acc[1]); cbw[st].y = pk2(acc[2], acc[3]); }
#pragma unroll
          for (int st = 0; st < 8; ++st) *(LAS u32x2*)(Cs + (16 * w + fr) * SP + 16 * st + 4 * fq) = cbw[st]; }
        bf16x8 btf[4];
#pragma unroll
        for (int ks = 0; ks < 4; ++ks) btf[ks] = lds_tr16x2(Bs + (32 * ks + 8 * fq + (fr >> 2)) * SP + 16 * w + 4 * (fr & 3), 4 * SP);
        P4_XSTORE(0);
        __syncthreads();
        for (int hh = 0; hh < 8; ++hh) {
            const int h = 8 * g + hh, buf = hh & 1;
            P4_XLOAD(hh < 7 ? h + 1 : h);
            const LAS bf16_t* Xb = Xs + buf * (128 * XP); const LAS float* V = VEC + buf * 768;
            { const int l = 16 * w + fr; const float ac_l = V[256 + l], rc_l = V[384 + l];
              f32x4 acc[4], sf[4], sb[4];
#pragma unroll
              for (int pt = 0; pt < 4; ++pt) { acc[pt] = (f32x4){0.f, 0.f, 0.f, 0.f}; sf[pt] = (f32x4){0.f, 0.f, 0.f, 0.f}; sb[pt] = (f32x4){0.f, 0.f, 0.f, 0.f}; }
#pragma unroll
              for (int ks = 0; ks < 4; ++ks) { const int s0 = 32 * ks + 8 * fq;
                  bf16x8 xf[4];
#pragma unroll
                  for (int pt = 0; pt < 4; ++pt) xf[pt] = lds_tr16x2(Xb + (s0 + (fr >> 2)) * XP + 16 * pt + 4 * (fr & 3), 4 * XP);
                  const u32x4 cb = *(const LAS u32x4*)(Cs + l * SP + s0); const unsigned cw[4] = {cb.x, cb.y, cb.z, cb.w};
                  f32x4 vd[6][2];
#pragma unroll
                  for (int a = 0; a < 6; ++a) { vd[a][0] = *(const LAS f32x4*)(V + 128 * a + s0); vd[a][1] = *(const LAS f32x4*)(V + 128 * a + s0 + 4); }
                  float mv[8];
#pragma unroll
                  for (int j = 0; j < 8; ++j) { const int s = s0 + j; const float cbj = (j & 1) ? hi_f(cw[j >> 1]) : lo_f(cw[j >> 1]);
                      const float df = vd[0][j >> 2][j & 3], db = vd[1][j >> 2][j & 3], ac = vd[2][j >> 2][j & 3], rc = vd[3][j >> 2][j & 3];
                      const float arg = (s < l) ? (ac_l - ac) : (rc_l - rc);
                      const float wg = (s < l) ? df : ((s > l) ? db : df + db);
                      mv[j] = cbj * __expf(arg) * wg; }
                  u32x4 mw; mw.x = pk2(mv[0], mv[1]); mw.y = pk2(mv[2], mv[3]); mw.z = pk2(mv[4], mv[5]); mw.w = pk2(mv[6], mv[7]);
                  const bf16x8 mfr = mk_frag(mw);
#pragma unroll
                  for (int pt = 0; pt < 4; ++pt) acc[pt] = mfma16(xf[pt], mfr, acc[pt]);
                  bf16x8 bff, bfb;
                  { const u32x4 bw = __builtin_bit_cast(u32x4, btf[ks]);
                    const float b0 = lo_f(bw.x), b1 = hi_f(bw.x), b2 = lo_f(bw.y), b3 = hi_f(bw.y), b4 = lo_f(bw.z), b5 = hi_f(bw.z), b6 = lo_f(bw.w), b7 = hi_f(bw.w);
                    const f32x4 f0 = vd[4][0], f1 = vd[4][1], g0 = vd[5][0], g1 = vd[5][1];
                    u32x4 aw; aw.x = pk2(b0 * f0[0], b1 * f0[1]); aw.y = pk2(b2 * f0[2], b3 * f0[3]); aw.z = pk2(b4 * f1[0], b5 * f1[1]); aw.w = pk2(b6 * f1[2], b7 * f1[3]); bff = mk_frag(aw);
                    aw.x = pk2(b0 * g0[0], b1 * g0[1]); aw.y = pk2(b2 * g0[2], b3 * g0[3]); aw.z = pk2(b4 * g1[0], b5 * g1[1]); aw.w = pk2(b6 * g1[2], b7 * g1[3]); bfb = mk_frag(aw); }
#pragma unroll
                  for (int pt = 0; pt < 4; ++pt) { sf[pt] = mfma16(bff, xf[pt], sf[pt]); sb[pt] = mfma16(bfb, xf[pt], sb[pt]); } }
              bf16_t* stf = ST + ((size_t)(((b * NCHUNK + c) * 2) * 16 + h)) * 8192; bf16_t* stb = stf + (size_t)16 * 8192;
#pragma unroll
              for (int pt = 0; pt < 4; ++pt) { u32x2 o; o.x = pk2(acc[pt][0], acc[pt][1]); o.y = pk2(acc[pt][2], acc[pt][3]);
                  *(u32x2*)(YD + (size_t)(t0 + l) * 1024 + 64 * h + 16 * pt + 4 * fq) = o;
                  o.x = pk2(sf[pt][0], sf[pt][1]); o.y = pk2(sf[pt][2], sf[pt][3]); *(u32x2*)(stf + (16 * pt + fr) * 128 + 16 * w + 4 * fq) = o;
                  o.x = pk2(sb[pt][0], sb[pt][1]); o.y = pk2(sb[pt][2], sb[pt][3]); *(u32x2*)(stb + (16 * pt + fr) * 128 + 16 * w + 4 * fq) = o; } }
            if (hh < 7) P4_XSTORE(buf ^ 1);
            __syncthreads();
        }
#undef P4_XLOAD
#undef P4_XSTORE
    }
}

__device__ __forceinline__ void p5_scan(const Args& A) {
    bf16_t* ST = (bf16_t*)(A.ws + WS_ST); const float* DEC = (const float*)(A.ws + WS_DEC);
    const int gtid = blockIdx.x * 512 + threadIdx.x, NT = gridDim.x * 512;
    for (int i = gtid; i < BATCH * 2 * 16 * 2048; i += NT) {
        const int e4 = i & 2047, h = (i >> 11) & 15, dir = (i >> 15) & 1, b = i >> 16;
        f32x4 st = {0.f, 0.f, 0.f, 0.f};
        for (int cc = 0; cc < NCHUNK; cc += 16) {
            u32x2 v[16]; float dc[16];
#pragma unroll
            for (int j = 0; j < 16; ++j) { const int c = dir ? (NCHUNK - 1 - (cc + j)) : (cc + j);
                v[j] = *(const u32x2*)(ST + ((size_t)(((b * NCHUNK + c) * 2 + dir) * 16 + h)) * 8192 + 4 * e4); dc[j] = DEC[(b * NCHUNK + c) * 32 + dir * 16 + h]; }
#pragma unroll
            for (int j = 0; j < 16; ++j) { const int c = dir ? (NCHUNK - 1 - (cc + j)) : (cc + j);
                u32x2 o; o.x = pk2(st[0], st[1]); o.y = pk2(st[2], st[3]);
                *(u32x2*)(ST + ((size_t)(((b * NCHUNK + c) * 2 + dir) * 16 + h)) * 8192 + 4 * e4) = o;
                const f32x4 sv = {lo_f(v[j].x), hi_f(v[j].x), lo_f(v[j].y), hi_f(v[j].y)}; st = st * dc[j] + sv; }
        }
    }
}

constexpr int KP = 72;
struct AttnRun { int br, b, h, d, cls, blk0, nblk, n; };
__device__ __forceinline__ void attn_run(int su, int q, AttnRun& a) { const int bh = su >> 3, r8 = su & 7; a.b = bh >> 4; a.h = bh & 15;
    if (q == 0) { a.br = 0; a.cls = 0; a.blk0 = 8 * r8; a.nblk = 8; } else if (q == 1) { a.br = 1; a.cls = r8 >> 1; a.blk0 = 8 * (r8 & 1); a.nblk = 8; } else { a.br = 2; a.cls = 2 * r8 + (q - 2); a.blk0 = 0; a.nblk = 4; }
    a.d = 1 << (2 * a.br); a.n = SEQ >> (2 * a.br); }
template <bool MERGE>
__device__ __forceinline__ void attn_compute(const AttnRun& cur, int blk, int par, bf16x8 (&qf)[2], unsigned qoff, const unsigned char* projb, const LAS bf16_t* Ks, const LAS bf16_t* Vs, bf16_t* AO, float* ML, bf16_t* mix, int w, int fr, int fq) {
    const int qi = 128 * blk + 16 * w + fr; const unsigned tq = (unsigned)(cur.b * SEQ + cur.cls + cur.d * qi); const int n = cur.n;
    const unsigned char* AOb = (const unsigned char*)AO; const unsigned char* MLb = (const unsigned char*)ML; unsigned char* mixb = (unsigned char*)mix; unsigned char* AOw = (unsigned char*)AO; unsigned char* MLw = (unsigned char*)ML;
    f32x4 st[9];
    {
        bf16x8 kf[9][2];
        const LAS bf16_t* kb = Ks + fr * KP + 8 * fq;
#pragma unroll
        for (int kt = 0; kt < 9; ++kt) { const int Tt = w + kt; const int srow = (((par + (Tt >> 3)) & 1) << 7) + ((Tt & 7) << 4);
#pragma unroll
            for (int ks = 0; ks < 2; ++ks) kf[kt][ks] = *(const LAS bf16x8*)(kb + srow * KP + 32 * ks); }
        __builtin_amdgcn_sched_barrier(0);
#pragma unroll
        for (int kt = 0; kt < 9; ++kt) { const f32x4 z = {0.f, 0.f, 0.f, 0.f}; st[kt] = mfma16(kf[kt][0], qf[0], z); }
#pragma unroll
        for (int kt = 0; kt < 9; ++kt) st[kt] = mfma16(kf[kt][1], qf[1], st[kt]);
        __builtin_amdgcn_sched_barrier(0);
    }
#pragma unroll
    for (int ks = 0; ks < 2; ++ks) qf[ks] = *(const bf16x8*)(projb + qoff + 256 * ks);
    f32x2 pm0 = {0.f, 0.f}, pm1 = {0.f, 0.f}; u32x2 po0[4], po1[4];
    if (MERGE) { pm0 = *(const f32x2*)(MLb + (unsigned)((tq * 16 + cur.h) * 8)); pm1 = *(const f32x2*)(MLb + (unsigned)(((T + tq) * 16 + cur.h) * 8));
#pragma unroll
        for (int et = 0; et < 4; ++et) { po0[et] = *(const u32x2*)(AOb + (unsigned)((tq * 1024 + 64 * cur.h + 4 * fq) * 2) + 32 * et); po1[et] = *(const u32x2*)(AOb + (unsigned)(((T + tq) * 1024 + 64 * cur.h + 4 * fq) * 2) + 32 * et); } }
#pragma unroll
    for (int r = 0; r < 4; ++r) { if (4 * fq + r < fr) st[0][r] = -1.0e30f; if (4 * fq + r > fr) st[8][r] = -1.0e30f; }
    if (blk == 0 || 128 * (blk + 1) >= n) {
#pragma unroll
        for (int kt = 0; kt < 9; ++kt)
#pragma unroll
            for (int r = 0; r < 4; ++r) { const int kj = qi + 16 * kt + 4 * fq + r - 64 - fr; if (kj < 0 || kj >= n) st[kt][r] = -1.0e30f; } }
    float mx = fmaxf(fmaxf(st[0][0], st[0][1]), fmaxf(st[0][2], st[0][3]));
#pragma unroll
    for (int kt = 1; kt < 9; ++kt) { mx = __builtin_fmaxf(__builtin_fmaxf(mx, st[kt][0]), st[kt][1]); mx = __builtin_fmaxf(__builtin_fmaxf(mx, st[kt][2]), st[kt][3]); }
    mx = fmaxf(mx, __shfl_xor(mx, 16)); mx = fmaxf(mx, __shfl_xor(mx, 32));
    f32x2 s2 = {0.f, 0.f}; const f32x2 m2 = {mx, mx};
#pragma unroll
    for (int kt = 0; kt < 9; ++kt) { f32x2 a = {st[kt][0], st[kt][1]}, c = {st[kt][2], st[kt][3]}; a -= m2; c -= m2;
        a[0] = __builtin_amdgcn_exp2f(a[0]); a[1] = __builtin_amdgcn_exp2f(a[1]); c[0] = __builtin_amdgcn_exp2f(c[0]); c[1] = __builtin_amdgcn_exp2f(c[1]);
        s2 += a; s2 += c; st[kt][0] = a[0]; st[kt][1] = a[1]; st[kt][2] = c[0]; st[kt][3] = c[1]; }
    float sum = s2[0] + s2[1];
    sum += __shfl_xor(sum, 16); sum += __shfl_xor(sum, 32);
    bf16x8 pf[5];
#pragma unroll
    for (int k2 = 0; k2 < 5; ++k2) { u32x4 pw; pw.x = pk2(st[2 * k2][0], st[2 * k2][1]); pw.y = pk2(st[2 * k2][2], st[2 * k2][3]);
        if (k2 < 4) { pw.z = pk2(st[2 * k2 + 1][0], st[2 * k2 + 1][1]); pw.w = pk2(st[2 * k2 + 1][2], st[2 * k2 + 1][3]); } else { pw.z = 0u; pw.w = 0u; }
        pf[k2] = mk_frag(pw); }
    float inv = 1.f / sum, w0 = 0.f, w1 = 0.f;
    if (MERGE) { const float M = fmaxf(mx, fmaxf(pm0[0], pm1[0])); w0 = pm0[1] * __builtin_amdgcn_exp2f(pm0[0] - M); w1 = pm1[1] * __builtin_amdgcn_exp2f(pm1[0] - M);
        const float e2 = __builtin_amdgcn_exp2f(mx - M); const float iw = 1.f / (w0 + w1 + e2 * sum); inv = e2 * iw; w0 *= iw; w1 *= iw; }
    const LAS bf16_t* vb = Vs + (4 * fq + (fr >> 2)) * KP + 4 * (fr & 3);
    const LAS bf16_t* vp[9];
#pragma unroll
    for (int kt = 0; kt < 9; ++kt) { const int Tt = w + kt; vp[kt] = vb + ((((par + (Tt >> 3)) & 1) << 7) + ((Tt & 7) << 4)) * KP; }
    u32x2 vf[2][9];
#pragma unroll
    for (int kt = 0; kt < 9; ++kt) vf[0][kt] = lds_tr16(vp[kt]);
#pragma unroll
    for (int et = 0; et < 4; ++et) {
        if (et < 3) {
#pragma unroll
            for (int kt = 0; kt < 9; ++kt) vf[(et + 1) & 1][kt] = lds_tr16(vp[kt] + 16 * (et + 1)); }
        __builtin_amdgcn_sched_barrier(0);
        f32x4 acc = {0.f, 0.f, 0.f, 0.f};
#pragma unroll
        for (int k2 = 0; k2 < 5; ++k2) { const u32x2 lo = vf[et & 1][2 * k2]; u32x2 hi = {0u, 0u}; if (k2 < 4) hi = vf[et & 1][2 * k2 + 1];
            u32x4 vw; vw.x = lo.x; vw.y = lo.y; vw.z = hi.x; vw.w = hi.y;
            acc = mfma16(mk_frag(vw), pf[k2], acc); }
        if (MERGE) { u32x2 o; o.x = pk2(acc[0] * inv + w0 * lo_f(po0[et].x) + w1 * lo_f(po1[et].x), acc[1] * inv + w0 * hi_f(po0[et].x) + w1 * hi_f(po1[et].x));
            o.y = pk2(acc[2] * inv + w0 * lo_f(po0[et].y) + w1 * lo_f(po1[et].y), acc[3] * inv + w0 * hi_f(po0[et].y) + w1 * hi_f(po1[et].y));
            *(u32x2*)(mixb + (unsigned)((tq * D + 1024 + 64 * cur.h + 4 * fq) * 2) + 32 * et) = o; }
        else { u32x2 o; o.x = pk2(acc[0] * inv, acc[1] * inv); o.y = pk2(acc[2] * inv, acc[3] * inv);
            *(u32x2*)(AOw + (unsigned)(((cur.br * T + tq) * 1024 + 64 * cur.h + 4 * fq) * 2) + 32 * et) = o; }
        __builtin_amdgcn_sched_barrier(0);
    }
    if (!MERGE && fq == 0) { f32x2 ml = {mx, sum}; *(f32x2*)(MLw + (unsigned)(((cur.br * T + tq) * 16 + cur.h) * 8)) = ml; }
}
template <int Q0, int Q1, bool MERGE>
__device__ __forceinline__ void p4_attn(const Args& A, LAS unsigned char* lds, int rep) {
    const int tid = threadIdx.x, lane = tid & 63, w = __builtin_amdgcn_readfirstlane(tid >> 6), fr = lane & 15, fq = lane >> 4;
    unsigned char* ws = A.ws;
    const unsigned char* projb = (const unsigned char*)(ws + WS_PROJ);
    bf16_t* AO = (bf16_t*)(ws + WS_AO); float* ML = (float*)(ws + WS_ML); bf16_t* mix = (bf16_t*)(ws + WS_MIX);
    LAS bf16_t* Ks = (LAS bf16_t*)lds; LAS bf16_t* Vs = (LAS bf16_t*)(lds + 36864);
    const int sr = tid >> 2, sq4 = tid & 3;
#define ATT_SEG_LOAD(d_, cls_, n_, s_, vk_, vv_) do { int kj_ = 128 * (s_) - 64 + sr; kj_ = kj_ < 0 ? 0 : kj_; kj_ = kj_ >= (n_) ? (n_) - 1 : kj_; \
        const unsigned ro_ = (unsigned)(rowb + (cls_) + (d_) * kj_) * (unsigned)(NPROJ_PAD * 2); \
        _Pragma("unroll") for (int i_ = 0; i_ < 2; ++i_) { vk_[i_] = *(const u32x4*)(projb + ro_ + kcol + 16 * i_); vv_[i_] = *(const u32x4*)(projb + ro_ + vcol + 16 * i_); } } while (0)
#define ATT_SEG_STORE(half_, vk_, vv_) do { _Pragma("unroll") for (int i_ = 0; i_ < 2; ++i_) { *(LAS u32x4*)(Ks + (128 * (half_) + sr) * KP + 16 * sq4 + 8 * i_) = vk_[i_]; *(LAS u32x4*)(Vs + (128 * (half_) + sr) * KP + 16 * sq4 + 8 * i_) = vv_[i_]; } } while (0)
#define ATT_Q_OFF(d_, cls_, n_, blk_) ({ int qi_ = 128 * (blk_) + 16 * w + fr; qi_ = qi_ >= (n_) ? (n_) - 1 : qi_; (unsigned)(rowb + (cls_) + (d_) * qi_) * (unsigned)(NPROJ_PAD * 2) + qcol; })
    u32x4 vk0[2], vv0[2], vk1[2], vv1[2]; bf16x8 qf[2];
#define ATT_STEP(P_, VKL_, VVL_, VKS_, VVS_) do { const int i_s = i + (P_); \
        { const bool in_ = (i_s + 3 <= cur.nblk); const int d_ = in_ ? cur.d : nxt.d, c_ = in_ ? cur.cls : nxt.cls, n_ = in_ ? cur.n : nxt.n, s_ = in_ ? cur.blk0 + i_s + 3 : nxt.blk0 + (P_); ATT_SEG_LOAD(d_, c_, n_, s_, VKL_, VVL_); } \
        const bool qmore_ = (i_s + 1 < cur.nblk); \
        const unsigned qoff_ = ATT_Q_OFF(qmore_ ? cur.d : nxt.d, qmore_ ? cur.cls : nxt.cls, qmore_ ? cur.n : nxt.n, qmore_ ? cur.blk0 + i_s + 1 : nxt.blk0); \
        attn_compute<MERGE>(cur, cur.blk0 + i_s, (P_), qf, qoff_, projb, Ks, Vs, AO, ML, mix, w, fr, fq); \
        __syncthreads(); \
        if (i_s + 2 <= cur.nblk) ATT_SEG_STORE((P_), VKS_, VVS_); \
        else if (hasn) { ATT_SEG_STORE(0, vk1, vv1); ATT_SEG_STORE(1, vk0, vv0); ATT_SEG_LOAD(nxt.d, nxt.cls, nxt.n, nxt.blk0 + 2, vk0, vv0); ATT_SEG_LOAD(nxt.d, nxt.cls, nxt.n, nxt.blk0 + 3, vk1, vv1); } \
        __syncthreads(); } while (0)
    for (int su0 = vcu_id(); su0 < 256 * rep; su0 += gridDim.x) { const int su = su0 & 255;
        AttnRun cur, nxt;
        attn_run(su, Q0, cur); nxt = cur;
        const int rowb = cur.b * SEQ, hq = 256 * (cur.h >> 2) + 32 * (cur.h & 3);
        const unsigned kcol = (unsigned)((OFF_K + hq + 128 * (sq4 >> 1) + 16 * (sq4 & 1)) * 2), vcol = (unsigned)((OFF_V + 64 * cur.h + 16 * sq4) * 2), qcol = (unsigned)((OFF_Q + hq + 8 * fq) * 2);
        ATT_SEG_LOAD(cur.d, cur.cls, cur.n, cur.blk0, vk0, vv0); ATT_SEG_LOAD(cur.d, cur.cls, cur.n, cur.blk0 + 1, vk1, vv1);
        { const unsigned qo = ATT_Q_OFF(cur.d, cur.cls, cur.n, cur.blk0); qf[0] = *(const bf16x8*)(projb + qo); qf[1] = *(const bf16x8*)(projb + qo + 256); }
        ATT_SEG_STORE(0, vk0, vv0); ATT_SEG_STORE(1, vk1, vv1);
        ATT_SEG_LOAD(cur.d, cur.cls, cur.n, cur.blk0 + 2, vk0, vv0); ATT_SEG_LOAD(cur.d, cur.cls, cur.n, cur.blk0 + 3, vk1, vv1);
        __syncthreads();
#pragma unroll 1
        for (int q = Q0; q < Q1; ++q) {
            const bool hasn = q < Q1 - 1;
            if (hasn) attn_run(su, q + 1, nxt);
#pragma unroll 1
            for (int i = 0; i < cur.nblk; i += 2) {
                ATT_STEP(0, vk1, vv1, vk0, vv0);
                ATT_STEP(1, vk0, vv0, vk1, vv1);
            }
            cur = nxt;
        }
    }
#undef ATT_STEP
#undef ATT_SEG_LOAD
#undef ATT_SEG_STORE
#undef ATT_Q_OFF
}

__device__ __forceinline__ void p6_ssd_final(const Args& A, LAS unsigned char* lds, int rep) {
    const int tid = threadIdx.x, lane = tid & 63, w = __builtin_amdgcn_readfirstlane(tid >> 6), fr = lane & 15, fq = lane >> 4;
    unsigned char* ws = A.ws;
    const bf16_t* xc = (const bf16_t*)(ws + WS_HB); const bf16_t* proj = (const bf16_t*)(ws + WS_PROJ);
    const float* ACS = (const float*)(ws + WS_ACS); const float* RCS = (const float*)(ws + WS_RCS);
    const bf16_t* YD = (const bf16_t*)(ws + WS_YD); const bf16_t* ST = (const bf16_t*)(ws + WS_ST);
    const float* dskip = (const float*)A.in[I_DSKIP]; const float* sg = (const float*)A.in[I_SSDG];
    bf16_t* mix = (bf16_t*)(ws + WS_MIX);
    LAS bf16_t* Cs = (LAS bf16_t*)lds;
    LAS float* EF = (LAS float*)(lds + 34816);
    LAS float* RED = (LAS float*)(lds + 34816 + 8192);
    for (int uu = vcu_id(); uu < BATCH * NCHUNK * 2 * rep; uu += gridDim.x) { const int u = uu & 255;
        const int b = u >> 7, c = (u >> 1) & 63, hf = u & 1; const int t0 = b * SEQ + c * CHUNK + 64 * hf;
        { const int row = tid >> 3, part = tid & 7, grp = part >> 2, q = part & 3; const bf16_t* src = xc + (size_t)(t0 + row) * XBCW + 1280 + 128 * grp + 32 * q;
#pragma unroll
          for (int i = 0; i < 4; ++i) *(LAS u32x4*)(Cs + grp * 64 * SP + row * SP + 32 * q + 8 * i) = *(const u32x4*)(src + 8 * i);
#pragma unroll
          for (int k = 0; k < 4; ++k) { const int idx = tid + 512 * k, dir = idx >> 10, hh = (idx >> 6) & 15, row2 = idx & 63;
              EF[idx] = __expf((dir ? RCS : ACS)[(size_t)(t0 + row2) * 16 + hh]); } }
        __syncthreads();
        const int grp = w >> 2;
        float ssr[4] = {0.f, 0.f, 0.f, 0.f};
        u32x2 gpk[4][4];
        LAS bf16_t* GT = (LAS bf16_t*)(lds + 45056) + w * (64 * 68);
#pragma unroll 1
        for (int hx = 0; hx < 2; ++hx) {
            const int h = 2 * w + hx;
            f32x4 y[4][4];
#pragma unroll
            for (int rt = 0; rt < 4; ++rt)
#pragma unroll
                for (int pt = 0; pt < 4; ++pt) y[rt][pt] = (f32x4){0.f, 0.f, 0.f, 0.f};
            const bf16_t* stb = ST + ((size_t)((b * NCHUNK + c) * 2) * 16 + h) * 8192 + (size_t)fr * 128 + 8 * fq;
#define P6_LOAD(dk_, hf_) do { const bf16_t* p_ = stb + (size_t)((dk_) >> 2) * (16 * 8192) + 32 * ((dk_) & 3); \
                _Pragma("unroll") for (int pt = 0; pt < 4; ++pt) hf_[pt] = *(const bf16x8*)(p_ + pt * (16 * 128)); } while (0)
#define P6_COMP(dk_, hf_) do { const int dir_ = (dk_) >> 2, ks_ = (dk_) & 3; \
                _Pragma("unroll") for (int rt = 0; rt < 4; ++rt) { \
                    const u32x4 cw = *(const LAS u32x4*)(Cs + grp * 64 * SP + (16 * rt + fr) * SP + 32 * ks_ + 8 * fq); \
                    const float ev = EF[dir_ * 1024 + h * 64 + 16 * rt + fr]; \
                    u32x4 aw; aw.x = pk2(lo_f(cw.x) * ev, hi_f(cw.x) * ev); aw.y = pk2(lo_f(cw.y) * ev, hi_f(cw.y) * ev); aw.z = pk2(lo_f(cw.z) * ev, hi_f(cw.z) * ev); aw.w = pk2(lo_f(cw.w) * ev, hi_f(cw.w) * ev); \
                    const bf16x8 af = mk_frag(aw); \
                    _Pragma("unroll") for (int pt = 0; pt < 4; ++pt) y[rt][pt] = mfma16(hf_[pt], af, y[rt][pt]); } } while (0)
            { bf16x8 hfa[4], hfb[4];
              P6_LOAD(0, hfa);
#pragma unroll 1
              for (int dk = 0; dk < 8; dk += 2) { P6_LOAD(dk + 1, hfb); P6_COMP(dk, hfa); P6_LOAD(dk + 2 < 8 ? dk + 2 : 7, hfa); P6_COMP(dk + 1, hfb); } }
#undef P6_LOAD
#undef P6_COMP
            asm volatile("" ::: "memory");
            const float dsk = dskip[h];
            u32x2 ea[12], eb[12];
#define P6_ELOAD(rt_, e_) do { const size_t tok_ = (size_t)(t0 + 16 * (rt_) + fr); const int col_ = 64 * h + 4 * fq; \
                _Pragma("unroll") for (int pt = 0; pt < 4; ++pt) { e_[3 * pt] = *(const u32x2*)(YD + tok_ * 1024 + col_ + 16 * pt); e_[3 * pt + 1] = *(const u32x2*)(xc + tok_ * XBCW + col_ + 16 * pt); e_[3 * pt + 2] = *(const u32x2*)(proj + tok_ * NPROJ_PAD + OFF_Z + col_ + 16 * pt); } } while (0)
#define P6_ECOMP(rt_, e_) do { \
                _Pragma("unroll") for (int pt = 0; pt < 4; ++pt) { const f32x4 yy = y[rt_][pt]; const u32x2 yd_ = e_[3 * pt], xv_ = e_[3 * pt + 1], zv_ = e_[3 * pt + 2]; \
                    const float g0 = (yy[0] + lo_f(yd_.x) + dsk * lo_f(xv_.x)) * silu_f(lo_f(zv_.x)), g1 = (yy[1] + hi_f(yd_.x) + dsk * hi_f(xv_.x)) * silu_f(hi_f(zv_.x)); \
                    const float g2 = (yy[2] + lo_f(yd_.y) + dsk * lo_f(xv_.y)) * silu_f(lo_f(zv_.y)), g3 = (yy[3] + hi_f(yd_.y) + dsk * hi_f(xv_.y)) * silu_f(hi_f(zv_.y)); \
                    ssr[rt_] += (g0 * g0 + g1 * g1) + (g2 * g2 + g3 * g3); \
                    u32x2 gp; gp.x = pk2(g0, g1); gp.y = pk2(g2, g3); \
                    if (hx == 0) *(LAS u32x2*)(GT + (16 * (rt_) + fr) * 68 + 16 * pt + 4 * fq) = gp; else gpk[rt_][pt] = gp; } \
                asm volatile("" ::: "memory"); } while (0)
            P6_ELOAD(0, ea);
            P6_ELOAD(1, eb); P6_ECOMP(0, ea);
            P6_ELOAD(2, ea); P6_ECOMP(1, eb);
            P6_ELOAD(3, eb); P6_ECOMP(2, ea);
            P6_ECOMP(3, eb);
#undef P6_ELOAD
#undef P6_ECOMP
        }
#pragma unroll
        for (int rt = 0; rt < 4; ++rt) { float v = ssr[rt]; v += __shfl_xor(v, 16); v += __shfl_xor(v, 32); if (fq == 0) RED[(16 * rt + fr) * 8 + w] = v; }
        f32x4 gnv[2][4];
#pragma unroll
        for (int hx = 0; hx < 2; ++hx)
#pragma unroll
            for (int pt = 0; pt < 4; ++pt) gnv[hx][pt] = *(const f32x4*)(sg + 64 * (2 * w + hx) + 16 * pt + 4 * fq);
        __syncthreads();
#pragma unroll
        for (int rt = 0; rt < 4; ++rt) { const LAS float* rp = RED + (16 * rt + fr) * 8; const f32x4 a = *(const LAS f32x4*)rp, bb = *(const LAS f32x4*)(rp + 4);
            ssr[rt] = rsqrtf(((a[0] + a[1]) + (a[2] + a[3]) + (bb[0] + bb[1]) + (bb[2] + bb[3])) * (1.f / 1024.f) + RMS_EPS); }
#pragma unroll
        for (int hx = 0; hx < 2; ++hx) { const int h = 2 * w + hx;
#pragma unroll
            for (int pt = 0; pt < 4; ++pt) { const int col = 64 * h + 16 * pt + 4 * fq; const f32x4 gn = gnv[hx][pt];
#pragma unroll
                for (int rt = 0; rt < 4; ++rt) { const u32x2 gv = (hx == 0) ? *(const LAS u32x2*)(GT + (16 * rt + fr) * 68 + 16 * pt + 4 * fq) : gpk[rt][pt]; const float rs = ssr[rt];
                    u32x2 o; o.x = pk2(lo_f(gv.x) * rs * gn[0], hi_f(gv.x) * rs * gn[1]); o.y = pk2(lo_f(gv.y) * rs * gn[2], hi_f(gv.y) * rs * gn[3]);
                    *(u32x2*)(mix + (size_t)(t0 + 16 * rt + fr) * D + col) = o; }
                asm volatile("" ::: "memory"); } }
        __syncthreads();
    }
}

__device__ __forceinline__ void p6_attn_merge(const Args& A) {
    unsigned char* ws = A.ws;
    const bf16_t* AO = (const bf16_t*)(ws + WS_AO); const float* ML = (const float*)(ws + WS_ML); bf16_t* mix = (bf16_t*)(ws + WS_MIX);
    const int gtid = blockIdx.x * 512 + threadIdx.x, NT = gridDim.x * 512;
    for (int i = gtid; i < T * 16 * 8; i += NT) {
        const int e8 = i & 7, h = (i >> 3) & 15, t = i >> 7;
        float m[3], l[3];
#pragma unroll
        for (int r = 0; r < 3; ++r) { const f32x2 v = *(const f32x2*)(ML + (((size_t)r * T + t) * 16 + h) * 2); m[r] = v[0]; l[r] = v[1]; }
        const float M = fmaxf(m[0], fmaxf(m[1], m[2]));
        float wgt[3], W = 0.f;
#pragma unroll
        for (int r = 0; r < 3; ++r) { wgt[r] = l[r] * __builtin_amdgcn_exp2f(m[r] - M); W += wgt[r]; }
        const float iw = 1.f / W; float o[8];
#pragma unroll
        for (int j = 0; j < 8; ++j) o[j] = 0.f;
#pragma unroll
        for (int r = 0; r < 3; ++r) { const u32x4 v = *(const u32x4*)(AO + ((size_t)r * T + t) * 1024 + 64 * h + 8 * e8); const float ww = wgt[r] * iw;
            o[0] += ww * lo_f(v.x); o[1] += ww * hi_f(v.x); o[2] += ww * lo_f(v.y); o[3] += ww * hi_f(v.y); o[4] += ww * lo_f(v.z); o[5] += ww * hi_f(v.z); o[6] += ww * lo_f(v.w); o[7] += ww * hi_f(v.w); }
        u32x4 ow; ow.x = pk2(o[0], o[1]); ow.y = pk2(o[2], o[3]); ow.z = pk2(o[4], o[5]); ow.w = pk2(o[6], o[7]);
        *(u32x4*)(mix + (size_t)t * D + 1024 + 64 * h + 8 * e8) = ow;
    }
}

constexpr int RP = 264;
__device__ __forceinline__ void p8_router(const Args& A, LAS unsigned char* lds, int dry) {
    const int tid = threadIdx.x, lane = tid & 63, w = __builtin_amdgcn_readfirstlane(tid >> 6), fr = lane & 15, fq = lane >> 4;
    unsigned char* ws = A.ws;
    const bf16_t* x1 = (const bf16_t*)(ws + WS_X1); const float* mod = (const float*)(ws + WS_MOD); const float* g2 = (const float*)A.in[I_N2G]; const float* rss = (const float*)(ws + WS_RSS);
    const bf16_t* wrt = (const bf16_t*)(ws + WS_WRT);
    const float* brg = (const float*)A.in[I_BRG]; const float* bre = (const float*)A.in[I_BRE];
    bf16_t* h2 = (bf16_t*)(ws + WS_HB);
    unsigned* cnt = (unsigned*)(ws + WS_CTL) + CW_CNT; int* elist = (int*)(ws + WS_ELIST); float* gates = (float*)(ws + WS_GATES);
    LAS float* A2 = (LAS float*)lds; LAS float* SH2 = A2 + D;
    LAS bf16_t* Bs = (LAS bf16_t*)(lds + 16384);
    LAS float* LG = (LAS float*)(lds + 16384 + 2 * 42240);
    if (blockIdx.x == 0 && tid < 256) ((u32x4*)(ws + WS_MIX))[tid] = (u32x4){0u, 0u, 0u, 0u};
    for (int tt0 = vcu_id(); tt0 < (T / 64) * (1 + dry); tt0 += gridDim.x) { const int tt = tt0 & (T / 64 - 1); const bool isdry = tt0 >= T / 64;
        const int b = (tt * 64) >= SEQ ? 1 : 0; const float* mb = mod + b * 12288;
        for (int i = tid; i < D; i += 512) { A2[i] = g2[i] * (1.f + mb[4 * D + i]); SH2[i] = mb[3 * D + i]; }
        const int tk = tt * 64 + 8 * w + (fr & 7); const bf16_t* xr = x1 + (size_t)tk * D + 8 * fq;
        float rstd; { const f32x4* rp = (const f32x4*)(rss + (size_t)tk * 32); float sacc = 0.f;
#pragma unroll
            for (int i = 0; i < 8; ++i) { const f32x4 v = rp[i]; sacc += (v[0] + v[1]) + (v[2] + v[3]); }
            rstd = rsqrtf(sacc * (1.f / D) + RMS_EPS); }
        u32x4 bst[5];
#define P8_BLOAD(c_) do { _Pragma("unroll") for (int i = 0; i < 5; ++i) { const int p = tid + 512 * i, row = p >> 5, c16 = p & 31; \
            bst[i] = *(const u32x4*)(wrt + (size_t)row * D + 256 * (c_) + 8 * c16); } } while (0)
#define P8_BSTORE(buf_) do { _Pragma("unroll") for (int i = 0; i < 5; ++i) { const int p = tid + 512 * i, row = p >> 5, c16 = p & 31; \
            *(LAS u32x4*)(Bs + (buf_) * 21120 + row * RP + 8 * c16) = bst[i]; } } while (0)
        u32x4 xa[8], xna[8];
#define P8_XLOAD(c_, xa_) do { _Pragma("unroll") for (int ks = 0; ks < 8; ++ks) xa_[ks] = *(const u32x4*)(xr + 256 * (c_) + 32 * ks); } while (0)
        P8_BLOAD(0); P8_XLOAD(0, xa);
        P8_BSTORE(0);
        __syncthreads();
        f32x4 acc[5];
#pragma unroll
        for (int ct = 0; ct < 5; ++ct) acc[ct] = (f32x4){0.f, 0.f, 0.f, 0.f};
#pragma unroll 1
        for (int c = 0; c < 8; ++c) {
            { const int cn = c + 1 < 8 ? c + 1 : 7; P8_BLOAD(cn); P8_XLOAD(cn, xna); }
            const LAS bf16_t* bb = Bs + (c & 1) * 21120 + fr * RP + 8 * fq;
#pragma unroll
            for (int ks = 0; ks < 8; ++ks) { const int col = 256 * c + 32 * ks + 8 * fq;
                const f32x4 m0 = *(const LAS f32x4*)(A2 + col), m1 = *(const LAS f32x4*)(A2 + col + 4), s0 = *(const LAS f32x4*)(SH2 + col), s1 = *(const LAS f32x4*)(SH2 + col + 4);
                const f32x4 xf0 = {lo_f(xa[ks].x), hi_f(xa[ks].x), lo_f(xa[ks].y), hi_f(xa[ks].y)}, xf1 = {lo_f(xa[ks].z), hi_f(xa[ks].z), lo_f(xa[ks].w), hi_f(xa[ks].w)};
                const f32x4 v0 = (xf0 * rstd) * m0 + s0, v1 = (xf1 * rstd) * m1 + s1;
                u32x4 hw; hw.x = pk2(v0[0], v0[1]); hw.y = pk2(v0[2], v0[3]); hw.z = pk2(v1[0], v1[1]); hw.w = pk2(v1[2], v1[3]);
                if (fr < 8) *(u32x4*)(h2 + (size_t)tk * D + col) = hw;
                const bf16x8 ah = mk_frag(hw);
#pragma unroll
                for (int ct = 0; ct < 5; ++ct) acc[ct] = mfma16(ah, *(const LAS bf16x8*)(bb + (16 * ct) * RP + 32 * ks), acc[ct]); }
            P8_BSTORE((c + 1) & 1);
#pragma unroll
            for (int ks = 0; ks < 8; ++ks) xa[ks] = xna[ks];
            __syncthreads();
        }
#undef P8_BLOAD
#undef P8_BSTORE
#undef P8_XLOAD
        if (fq < 2) {
#pragma unroll
            for (int ct = 0; ct < 5; ++ct)
#pragma unroll
                for (int r = 0; r < 4; ++r) LG[(8 * w + 4 * fq + r) * NRT + 16 * ct + fr] = acc[ct][r]; }
        __syncthreads();
        LAS int* lcnt = (LAS int*)(lds + 16384); LAS int* lbase = lcnt + 64;
        if (tid < 64) lcnt[tid] = 0;
        __syncthreads();
        int ea = 0, eb = 0, ra = 0, rb = 0; float g1v = 0.f, g2v = 0.f;
        if (lane < 8) {
            const LAS float* lg = LG + (8 * w + lane) * NRT;
            float gmx = -3.0e38f; int gi = 0;
#pragma unroll
            for (int j = 0; j < 8; ++j) { const float v = lg[j] + brg[j]; if (v > gmx) { gmx = v; gi = j; } }
            float gse = 0.f;
#pragma unroll
            for (int j = 0; j < 8; ++j) gse += __expf(lg[j] + brg[j] - gmx);
            const float pgroup = 1.f / gse;
            const LAS float* el = lg + 16 + 8 * gi; const float* be = bre + 8 * gi;
            float emx = -3.0e38f; int i1 = 0;
#pragma unroll
            for (int j = 0; j < 8; ++j) { const float v = el[j] + be[j]; if (v > emx) { emx = v; i1 = j; } }
            float e2 = -3.0e38f; int i2 = 0; float ese = 0.f;
#pragma unroll
            for (int j = 0; j < 8; ++j) { const float v = el[j] + be[j]; ese += __expf(v - emx); if (j != i1 && v > e2) { e2 = v; i2 = j; } }
            const float p1 = 1.f / ese, p2 = __expf(e2 - emx) / ese; const float ps = p1 + p2;
            g1v = pgroup * p1 / ps; g2v = pgroup * p2 / ps;
            ea = 8 * gi + i1; eb = 8 * gi + i2;
            if (!isdry) { ra = __hip_atomic_fetch_add(lcnt + ea, 1, __ATOMIC_RELAXED, __HIP_MEMORY_SCOPE_WORKGROUP); rb = __hip_atomic_fetch_add(lcnt + eb, 1, __ATOMIC_RELAXED, __HIP_MEMORY_SCOPE_WORKGROUP); }
        }
        __syncthreads();
        if (tid < 64 && !isdry) { const int c = lcnt[tid]; if (c > 0) lbase[tid] = (int)atomicAdd(cnt + 32 * tid, (unsigned)c); }
        __syncthreads();
        if (lane < 8 && !isdry) { const int tok = tt * 64 + 8 * w + lane;
            elist[(size_t)ea * ECAP + lbase[ea] + ra] = 2 * tok; elist[(size_t)eb * ECAP + lbase[eb] + rb] = 2 * tok + 1;
            gates[2 * tok] = g1v; gates[2 * tok + 1] = g2v; }
        __syncthreads();
    }
}

__device__ __forceinline__ int moe_tables(const Args& A, LAS unsigned char* lds, int npn, bool down) {
    const int tid = threadIdx.x;
    unsigned char* ws = A.ws;
    const unsigned* cnt = (const unsigned*)(ws + WS_CTL) + CW_CNT; const int* elist = (const int*)(ws + WS_ELIST); const float* gates = (const float*)(ws + WS_GATES);
    LAS int* tb = (LAS int*)(lds + ETAB_OFF); LAS int* cn = tb + 80;
    if (tid < 64) cn[tid] = (int)__hip_atomic_load(cnt + 32 * tid, __ATOMIC_RELAXED, __HIP_MEMORY_SCOPE_AGENT);
    __syncthreads();
    if (tid <= 64) { int s = 0; for (int j = 0; j < tid; ++j) s += (cn[j] + 255) >> 8; tb[tid] = s; }
    __syncthreads();
    const int ntiles = tb[64];
    LAS int* tab = (LAS int*)(lds + TAB_OFF);
    const int cap = down ? 6 : 12;
    for (int li = 0; li < cap; ++li) {
        const long L = (long)li * gridDim.x + vcu_id(); if (L >= (long)ntiles * npn) break;
        const int tau = (int)(L / npn); int e = 0;
        for (int j = 1; j < NEXP; ++j) e += (tb[j] <= tau) ? 1 : 0;
        const int mt = tau - tb[e], ce = cn[e];
        if (tid < 256) { const int pos = 256 * mt + tid; const bool ok = pos < ce; const int a = ok ? elist[(size_t)e * ECAP + pos] : -1;
            if (down) { tab[li * 512 + 2 * tid] = a; tab[li * 512 + 2 * tid + 1] = ok ? __float_as_int(gates[a]) : 0; }
            else tab[li * 256 + tid] = ok ? (a >> 1) * (D * 2) : (int)(unsigned)(WS_MIX - WS_HB); }
    }
    __syncthreads();
    return ntiles;
}

__device__ __forceinline__ void p11_combine(const Args& A) {
    unsigned char* ws = A.ws;
    const bf16_t* x1 = (const bf16_t*)(ws + WS_X1); const float* mod = (const float*)(ws + WS_MOD); const bf16_t* Y = (const bf16_t*)(ws + WS_YSLOT);
    const int gtid = blockIdx.x * 512 + threadIdx.x, NR = (gridDim.x * 512) >> 8, c8 = (gtid & 255) * 8;
    f32x4 gt[2][2];
#pragma unroll
    for (int bb = 0; bb < 2; ++bb) { gt[bb][0] = *(const f32x4*)(mod + bb * 12288 + 5 * D + c8); gt[bb][1] = *(const f32x4*)(mod + bb * 12288 + 5 * D + c8 + 4); }
    for (int t0 = gtid >> 8; t0 < T; t0 += 4 * NR) {
        u32x4 xw[4], ya[4], yb[4];
#pragma unroll
        for (int u = 0; u < 4; ++u) { int t = t0 + u * NR; t = t < T ? t : T - 1;
            xw[u] = *(const u32x4*)(x1 + (size_t)t * D + c8); ya[u] = *(const u32x4*)(Y + (size_t)(2 * t) * D + c8); yb[u] = *(const u32x4*)(Y + (size_t)(2 * t + 1) * D + c8); }
        __builtin_amdgcn_sched_barrier(0);
#pragma unroll
        for (int u = 0; u < 4; ++u) { const int t = t0 + u * NR; if (t < T) { const int bb = t >= SEQ ? 1 : 0;
            const f32x4 g0 = bb ? gt[1][0] : gt[0][0], g1 = bb ? gt[1][1] : gt[0][1];
            const f32x4 a0 = {lo_f(xw[u].x), hi_f(xw[u].x), lo_f(xw[u].y), hi_f(xw[u].y)}, a1 = {lo_f(xw[u].z), hi_f(xw[u].z), lo_f(xw[u].w), hi_f(xw[u].w)};
            f32x4 s0, s1;
            s0[0] = lo_f(ya[u].x) + lo_f(yb[u].x); s0[1] = hi_f(ya[u].x) + hi_f(yb[u].x); s0[2] = lo_f(ya[u].y) + lo_f(yb[u].y); s0[3] = hi_f(ya[u].y) + hi_f(yb[u].y);
            s1[0] = lo_f(ya[u].z) + lo_f(yb[u].z); s1[1] = hi_f(ya[u].z) + hi_f(yb[u].z); s1[2] = lo_f(ya[u].w) + lo_f(yb[u].w); s1[3] = hi_f(ya[u].w) + hi_f(yb[u].w);
            __builtin_nontemporal_store(a0 + g0 * s0, (f32x4*)(A.out + (size_t)t * D + c8)); __builtin_nontemporal_store(a1 + g1 * s1, (f32x4*)(A.out + (size_t)t * D + c8 + 4)); } }
    }
}

constexpr int NPH = 12;
#ifndef DUP_PH
#define DUP_PH -1
#endif
#define REP(k) for (int _rep = 0; _rep < ((DUP_PH) == (k) ? 2 : 1); ++_rep)
__global__ void __launch_bounds__(512, 2) hyb_fwd(Args args) {
    extern __shared__ __attribute__((aligned(16))) unsigned char lds_raw[];
    LAS unsigned char* lds = (LAS unsigned char*)lds_raw;
    const int tid = threadIdx.x;
    volatile LAS unsigned* MISC = (volatile LAS unsigned*)(lds + MISC_OFF);
    for (int u = tid; u < 128; u += 512) MISC[u] = 0u;
    __syncthreads();
    unsigned char* ws = args.ws;
    unsigned* ctl = (unsigned*)(ws + WS_CTL);
    const int lo = args.ph_lo, hi = args.ph_hi;
    XcdBarrier bar; bar.bar = ctl + CW_BAR; bar.x = 0; bar.st = nullptr;
    if (hi - lo > 1) bar = xcd_barrier_post(ctl + CW_BAR, MISC + 8);
#ifndef PH_MASK
#define PH_MASK 0xFFF
#endif
#define IN(k) ((((PH_MASK) >> (k)) & 1) && lo <= (k) && (k) < hi)
#ifndef TPROBE_A
#define TPROBE_A -1
#define TPROBE_B -1
#endif
#define SEAM(k) do { if (IN(k) && IN((k) + 1)) xcd_barrier(bar); if (TPROBE_A >= 0 && blockIdx.x == 0 && tid == 0) ctl[CW_FLAG + 1 + (k)] = (unsigned)wall_clock64(); } while (0)
    if (TPROBE_A >= 0 && blockIdx.x == 0 && tid == 0) ctl[CW_FLAG] = (unsigned)wall_clock64();

    if (IN(0)) { REP(0) { p0_prologue(args, lds); __syncthreads(); } } SEAM(0);
    if (IN(1)) { REP(1) p1_norm1(args); } SEAM(1);
    if (IN(2)) {
        const int G2 = (gridDim.x == 256) ? 164 : (int)gridDim.x;
        if ((int)blockIdx.x < G2) {
            pg8::Gemm g{(const bf16_t*)(ws + WS_HB), (const bf16_t*)(ws + WS_WINT), D, 0};
            pg8::StaticOrder S; S.init(T, NPROJ_PAD, G2, (int)blockIdx.x, (DUP_PH) == 2 ? 2 : 1);
            EpiProj E{(bf16_t*)(ws + WS_PROJ), (float*)(ws + WS_DTRAW), (const float*)args.in[I_QG], (const float*)args.in[I_KG], (const float*)(ws + WS_ROPE)};
            pg8::gemm_phase<EpiProj, pg8::StaticOrder, true, false>(lds, g, S, E);
            p2_convert_late(args, lds);
        } else p2_convert_late(args, lds);
    } SEAM(2);
    if (IN(3)) { p3_post(args, (DUP_PH) == 13 ? 1 : 0, (DUP_PH) == 3 ? 2 : 1); } SEAM(3);
    if (IN(4)) { p4_ssd_local(args, lds, (DUP_PH) == 4 ? 2 : 1); p4_attn<0, 2, false>(args, lds, (DUP_PH) == 14 ? 2 : 1); } SEAM(4);
    if (IN(5)) { p5_scan(args); } SEAM(5);
    if (IN(6)) { p6_ssd_final(args, lds, (DUP_PH) == 6 ? 2 : 1); p4_attn<2, 4, true>(args, lds, (DUP_PH) == 16 ? 2 : 1); } SEAM(6);
    if (IN(7)) {
        pg8::Gemm g{(const bf16_t*)(ws + WS_MIX), (const bf16_t*)(ws + WS_WOUTT), D, 0};
        pg8::StaticOrder S; S.init(T, D, (int)gridDim.x, (int)blockIdx.x, (DUP_PH) == 7 ? 2 : 1);
        EpiOut E{(const float*)args.in[I_X], (const float*)(ws + WS_MOD), (bf16_t*)(ws + WS_X1), (float*)(ws + WS_RSS)};
        pg8::gemm_phase<EpiOut, pg8::StaticOrder, true, false>(lds, g, S, E);
    } SEAM(7);
    if (IN(8)) { p8_router(args, lds, (DUP_PH) == 8 ? 1 : 0); } SEAM(8);
    if (IN(9)) {
        const int ntiles = moe_tables(args, lds, 4, false);
        pg8::Gemm g{(const bf16_t*)(ws + WS_HB), (const bf16_t*)(ws + WS_WGUT), D, (size_t)1024 * D * 2};
        MoeOrder S{(const LAS int*)(lds + ETAB_OFF), ntiles, 4, (int)gridDim.x, vcu_id(), (const LAS unsigned*)(lds + TAB_OFF)};
        EpiGU E{(bf16_t*)(ws + WS_HMOE)};
        _Pragma("unroll 1") REP(9) pg8::gemm_phase<EpiGU, MoeOrder, true, true>(lds, g, S, E);
    } SEAM(9);
    if (IN(10)) {
        const int ntiles = moe_tables(args, lds, 8, true);
        pg8::Gemm g{(const bf16_t*)(ws + WS_HMOE), (const bf16_t*)(ws + WS_WDT), EH, (size_t)D * EH * 2};
        MoeOrder S{(const LAS int*)(lds + ETAB_OFF), ntiles, 8, (int)gridDim.x, vcu_id(), (const LAS unsigned*)(lds + TAB_OFF)};
        EpiDown E{(bf16_t*)(ws + WS_YSLOT), (const LAS int*)(lds + TAB_OFF)};
        _Pragma("unroll 1") REP(10) pg8::gemm_phase<EpiDown, MoeOrder, true, false>(lds, g, S, E);
    } SEAM(10);
    if (IN(11)) { REP(11) p11_combine(args); }
    if (TPROBE_A >= 0) {
        xcd_barrier(bar);
        if (blockIdx.x == 0 && tid == 0) ctl[CW_FLAG + 1 + 11] = (unsigned)wall_clock64();
        __syncthreads();
        const unsigned ea = __hip_atomic_load(ctl + CW_FLAG + 1 + TPROBE_A, __ATOMIC_RELAXED, __HIP_MEMORY_SCOPE_AGENT), sa = __hip_atomic_load(ctl + CW_FLAG + TPROBE_A, __ATOMIC_RELAXED, __HIP_MEMORY_SCOPE_AGENT);
        const unsigned eb = __hip_atomic_load(ctl + CW_FLAG + 1 + TPROBE_B, __ATOMIC_RELAXED, __HIP_MEMORY_SCOPE_AGENT), sb = __hip_atomic_load(ctl + CW_FLAG + TPROBE_B, __ATOMIC_RELAXED, __HIP_MEMORY_SCOPE_AGENT);
        xcd_barrier(bar);
        const float ta = (float)(ea - sa) * 0.01f, tb = (float)(eb - sb) * 0.01f;
        const float sfac = sqrtf(ta * 0.01f); const float* xin = (const float*)args.in[I_X];
        for (size_t i = (size_t)blockIdx.x * 512 + tid; i < (size_t)T * D; i += (size_t)gridDim.x * 512) args.out[i] += xin[i] * sfac + (i == 0 ? tb : 0.f);
    }
#undef IN
#undef SEAM
}

extern "C" void kernel_launch(void* const* d_in, const int* in_sizes, int n_in, void* d_out, int out_size, void* d_ws, size_t ws_size, hipStream_t stream) {
    static int grid = 0;
    if (grid == 0) {
        if (n_in != 24 || in_sizes[0] != T * D || out_size != T * D || ws_size < WS_END) { fprintf(stderr, "kernel_launch: unexpected shapes (n_in %d, in0 %d, out %d, ws %zu < %zu); nothing launched\n", n_in, n_in > 0 ? in_sizes[0] : -1, out_size, ws_size, (size_t)WS_END); grid = -1; return; }
        int dev = 0, cus = 0, per_cu = 0;
        if (hipGetDevice(&dev) != hipSuccess || hipDeviceGetAttribute(&cus, hipDeviceAttributeMultiprocessorCount, dev) != hipSuccess) { grid = -1; return; }
        if (hipFuncSetAttribute((const void*)hyb_fwd, hipFuncAttributeMaxDynamicSharedMemorySize, LDS_BYTES) != hipSuccess) { fprintf(stderr, "kernel_launch: hipFuncSetAttribute failed\n"); grid = -1; return; }
        if (hipOccupancyMaxActiveBlocksPerMultiprocessor(&per_cu, (const void*)hyb_fwd, 512, LDS_BYTES) != hipSuccess || per_cu < 1) fprintf(stderr, "kernel_launch: occupancy query reports %d\n", per_cu);
        (void)hipGetLastError();
        grid = cus;
    }
    if (grid < 0) return;
    (void)hipMemsetAsync((char*)d_ws + WS_CTL, 0, CTL_BYTES, stream);
    Args a{};
    for (int i = 0; i < 24; ++i) a.in[i] = d_in[i];
    a.out = (float*)d_out; a.ws = (unsigned char*)d_ws;
#if MK_ONE_LAUNCH
    a.ph_lo = 0; a.ph_hi = NPH;
    hipLaunchKernelGGL(hyb_fwd, dim3(grid), dim3(512), LDS_BYTES, stream, a);
#else
    for (int p = 0; p < NPH; ++p) { a.ph_lo = p; a.ph_hi = p + 1; hipLaunchKernelGGL(hyb_fwd, dim3(grid), dim3(512), LDS_BYTES, stream, a); }
#endif
}
```

```cpp
#include <hip/hip_runtime.h>
#include <cstdio>
#include <cstdint>

#ifndef MK_ONE_LAUNCH
#define MK_ONE_LAUNCH 1
#endif

#define LAS __attribute__((address_space(3)))
#define GAS __attribute__((address_space(1)))
typedef unsigned short bf16_t;
typedef short bf16x8 __attribute__((ext_vector_type(8)));
typedef float f32x4 __attribute__((ext_vector_type(4)));
typedef float f32x2 __attribute__((ext_vector_type(2)));
typedef unsigned u32x4 __attribute__((ext_vector_type(4)));
typedef unsigned u32x2 __attribute__((ext_vector_type(2)));

constexpr int BATCH = 2, SEQ = 8192, T = BATCH * SEQ, D = 2048;
constexpr int NPROJ = 5664, NPROJ_PAD = 5888;
constexpr int OFF_Q = 0, OFF_K = 1024, OFF_V = 2048, OFF_Z = 3072, OFF_XBC = 4096, OFF_DT = 5632;
constexpr int XBCW = 1536, NHEAD = 16, CHUNK = 128, NCHUNK = SEQ / CHUNK;
constexpr int NEXP = 64, EH = 512;
constexpr int ECAP = T;
constexpr int NRT = 80;
constexpr float RMS_EPS = 1e-6f;
constexpr float LOG2E = 1.4426950408889634f;

constexpr size_t MiB = 1u << 20;
constexpr size_t WS_CTL = 0, CTL_BYTES = 1 * MiB;
constexpr size_t WS_MOD = 1 * MiB;
constexpr size_t WS_ROPE = 2 * MiB;
constexpr size_t WS_WRT = 6 * MiB;
constexpr size_t WS_SMALL = 7 * MiB;
constexpr size_t WS_DTRAW = WS_SMALL, WS_DTF = WS_SMALL + 2 * MiB, WS_DTB = WS_SMALL + 3 * MiB, WS_ACS = WS_SMALL + 4 * MiB, WS_RCS = WS_SMALL + 5 * MiB, WS_DEC = WS_SMALL + 6 * MiB;
constexpr size_t WS_ML = 14 * MiB;
constexpr size_t WS_ELIST = 20 * MiB;
constexpr size_t WS_GATES = 24 * MiB;
constexpr size_t WS_WINT = 25 * MiB;
constexpr size_t WS_WOUTT = 48 * MiB;
constexpr size_t WS_WGUT = 56 * MiB;
constexpr size_t WS_WDT = 312 * MiB;
constexpr size_t WS_HB = 440 * MiB;
constexpr size_t WS_PROJ = 504 * MiB;
constexpr size_t WS_YSLOT = WS_PROJ, WS_HMOE = WS_PROJ + 128 * MiB;
constexpr size_t WS_ST = 688 * MiB;
constexpr size_t WS_X1 = WS_ST;
constexpr size_t WS_YD = 816 * MiB;
constexpr size_t WS_AO = 880 * MiB;
constexpr size_t WS_RSS = WS_AO;
constexpr size_t WS_MIX = 976 * MiB;
constexpr size_t WS_END = 1040 * MiB;

constexpr int CW_BAR = 4096;
constexpr int CW_CNT = 16384;
constexpr int CW_FLAG = 16384 + 4096;

constexpr int RING_BYTES = 131072;
constexpr int MISC_OFF = 133120;
constexpr int TAB_OFF = MISC_OFF + 512;
constexpr int ETAB_OFF = TAB_OFF + 12288;
constexpr int LDS_BYTES = 147456;
static_assert(ETAB_OFF + 1024 <= LDS_BYTES, "LDS map");

__device__ __forceinline__ float bf2f(unsigned v) { return __uint_as_float(v << 16); }
__device__ __forceinline__ unsigned f2bf(float f) { unsigned u = __float_as_uint(f); return (u + 0x7fffu + ((u >> 16) & 1u)) >> 16; }
typedef __bf16 bf16v2_t __attribute__((ext_vector_type(2)));
__device__ __forceinline__ unsigned pk2(float lo, float hi) { const f32x2 v = {lo, hi}; return __builtin_bit_cast(unsigned, __builtin_convertvector(v, bf16v2_t)); }
__device__ __forceinline__ float lo_f(unsigned w) { return __uint_as_float(w << 16); }
__device__ __forceinline__ float hi_f(unsigned w) { return __uint_as_float(w & 0xffff0000u); }
__device__ __forceinline__ float silu_f(float v) { return v / (1.f + __expf(-v)); }
#define LDS_WAIT() asm volatile("s_waitcnt lgkmcnt(0)" ::: "memory")
#define VM_WAIT() asm volatile("s_waitcnt vmcnt(0)" ::: "memory")

#define XB_TMO      128
#define XB_XCNT(j)  (256  + 64 * (j))
#define XB_XSUB(j)  (1280 + 64 * (j))
#define XB_XGEN(j)  (2304 + 64 * (j))
#define XB_TOP      3328
#define XB_TOPGEN   3392
#define XCD_BAR_WORDS 3456
#define XB_SPIN_CAP (1u << 18)
__device__ __forceinline__ unsigned xb_ld(unsigned* p)              { return __hip_atomic_load(p, __ATOMIC_RELAXED, __HIP_MEMORY_SCOPE_AGENT); }
__device__ __forceinline__ unsigned xb_add(unsigned* p, unsigned v) { return __hip_atomic_fetch_add(p, v, __ATOMIC_RELAXED, __HIP_MEMORY_SCOPE_AGENT); }
__device__ __forceinline__ unsigned xb_xcc_id() { return (unsigned)__builtin_amdgcn_s_getreg((3 << 11) | 20) & 0xFu; }
#define XB_SPIN(cond, bar) do { unsigned _sp = 0; while (cond) { __builtin_amdgcn_s_sleep(1); \
    if ((++_sp & 255u) == 0u) { if (xb_ld(&(bar)[XB_TMO])) break; if (_sp > XB_SPIN_CAP) { atomicAdd(&(bar)[XB_TMO], 1u); break; } } } } while (0)
struct XcdBarrier { unsigned* bar; unsigned x; volatile LAS unsigned* st; };
__device__ __forceinline__ XcdBarrier xcd_barrier_post(unsigned* bar, volatile LAS unsigned* st) {
    XcdBarrier b; b.bar = bar; b.x = xb_xcc_id(); b.st = st;
    if (threadIdx.x == 0) (void)xb_add(&bar[XB_XCNT(b.x)], 1u);
    return b;
}
__device__ __forceinline__ void xcd_barrier_complete(unsigned* bar, unsigned x, unsigned& nloc, unsigned& nx) {
    const unsigned G = gridDim.x * gridDim.y * gridDim.z;
    unsigned sum, cnt, mine, sp = 0u;
    for (;;) {
        sum = 0u; cnt = 0u; mine = 0u;
#pragma unroll
        for (unsigned j = 0; j < 16; ++j) { const unsigned c = xb_ld(&bar[XB_XCNT(j)]); sum += c; cnt += (c > 0u) ? 1u : 0u; mine = (j == x) ? c : mine; }
        if (sum == G) break;
        __builtin_amdgcn_s_sleep(1);
        if ((++sp & 255u) == 0u) { if (xb_ld(&bar[XB_TMO])) break; if (sp > XB_SPIN_CAP) { atomicAdd(&bar[XB_TMO], 1u); break; } }
    }
    nloc = mine > 0u ? mine : 1u; nx = cnt > 0u ? cnt : 1u;
}
__device__ __forceinline__ void xcd_barrier(const XcdBarrier& b) {
    asm volatile("s_waitcnt vmcnt(0)" ::: "memory");
    __syncthreads();
    if (threadIdx.x == 0) {
        unsigned* bar = b.bar;
        __builtin_amdgcn_s_waitcnt(0);
        unsigned nloc = b.st[0], nx = b.st[1];
        if (nloc == 0u) { xcd_barrier_complete(bar, b.x, nloc, nx); b.st[0] = nloc; b.st[1] = nx; }
        const unsigned old = xb_add(&bar[XB_XSUB(b.x)], 1u);
        const unsigned gen = old / nloc;
        if (old + 1u == (gen + 1u) * nloc) {
            __builtin_amdgcn_fence(__ATOMIC_RELEASE, "agent");
            asm volatile("s_waitcnt vmcnt(0)" ::: "memory");
            const unsigned og = xb_add(&bar[XB_TOP], 1u);
            const unsigned tg = og / nx;
            if (og + 1u == (tg + 1u) * nx) xb_add(&bar[XB_TOPGEN], 1u);
            else XB_SPIN(xb_ld(&bar[XB_TOPGEN]) == tg, bar);
            __builtin_amdgcn_fence(__ATOMIC_ACQUIRE, "agent");
            xb_add(&bar[XB_XGEN(b.x)], 1u);
            asm volatile("s_waitcnt vmcnt(0)" ::: "memory");
        } else {
            XB_SPIN(xb_ld(&bar[XB_XGEN(b.x)]) == gen, bar);
            __builtin_amdgcn_fence(__ATOMIC_ACQUIRE, "agent");
            asm volatile("s_waitcnt vmcnt(0)" ::: "memory");
        }
    }
    __syncthreads();
}

namespace pg8 {
constexpr int BM = 256, BK = 64, HALF = 128, HTB = HALF * BK * 2, STAGE_BYTES = 8 * HTB, NXCD = 8, WGM = 4;
__device__ __forceinline__ int lds_byte(int r, int c) { const int st = (r >> 4) * 2 + (c >> 5), rr = r & 15, cc = c & 31, ob = rr * 64 + cc * 2; return st * 1024 + (ob ^ (((ob >> 9) & 1) << 5)); }
__device__ __forceinline__ void stage_rc(int b, int& R, int& C) { const int st = b / 1024, sb = b % 1024, swz = sb ^ (((sb >> 9) & 1) << 5); R = (st >> 1) * 16 + swz / 64; C = (st & 1) * 32 + (swz % 64) / 2; }
__device__ __forceinline__ int perm32(int rho) { const int n = rho >> 4, i = rho & 15; return 8 * (i >> 2) + 4 * n + (i & 3); }

struct Unit { int pm, pn, e, li; };
struct Gemm { const bf16_t* A; const bf16_t* Bt; int K; size_t bstride; };

struct StaticOrder {
    int nM, nN, nwg, G, c, rep;
    __device__ void init(int M, int N, int G_, int c_, int rep_ = 1) { nM = M / BM; nN = N / BM; nwg = nM * nN; G = G_; c = c_; rep = rep_; }
    __device__ bool next(int i, Unit& u) const {
        const long L = (long)i * G + c; if (L >= (long)nwg * rep) return false;
        int wgid = (int)(L % nwg); { const int q = nwg / NXCD, r = nwg % NXCD, xcd = wgid % NXCD, off = wgid / NXCD; wgid = (xcd < r ? xcd * (q + 1) : r * (q + 1) + (xcd - r) * q) + off; }
        const int nig = WGM * nN, gid = wgid / nig, fm = gid * WGM, gsz = (nM - fm) < WGM ? (nM - fm) : WGM;
        u.pm = fm + ((wgid % nig) % gsz); u.pn = (wgid % nig) / gsz; u.e = 0; u.li = i; return true;
    }
    __device__ __forceinline__ void a_ready(const Unit&) const {}
    __device__ __forceinline__ void done(const Unit&) const {}
    __device__ __forceinline__ void load_goff(const Unit&, unsigned (&)[2][2], const int (&)[2], const int (&)[2]) const {}
};

template <class Epi, class Sched, bool ALIGN_EPI, bool GATHER>
__device__ __forceinline__ void gemm_phase(LAS unsigned char* lds, const Gemm g, const Sched& S, const Epi& E) {
    const int tid = threadIdx.x, wid = __builtin_amdgcn_readfirstlane(tid >> 6), lane = tid & 63, wr = wid >> 2, wc = wid & 3, fr = lane & 15, fq = lane >> 4;
    const int K = g.K, nt = K / BK;
    unsigned voffA[2], voffB[2]; int RA[2], CA[2];
#pragma unroll
    for (int i = 0; i < 2; ++i) { int R, C; stage_rc(tid * 16 + i * 8192, R, C); const int Rb = Epi::PERM ? ((R & ~31) + perm32(R & 31)) : R; RA[i] = R; CA[i] = C;
        voffA[i] = (unsigned)(R * K + C) * 2u; voffB[i] = (unsigned)(Rb * K + C) * 2u; }
    unsigned goff[2][2] = {{0u, 0u}, {0u, 0u}};
    const size_t kstep = (size_t)(BK * 2);
    const size_t hstep = (size_t)HALF * K * 2;
    const size_t tstep = 2 * hstep;
    const unsigned ldsw = (unsigned)wid * 1024u;
    const int aoff = lds_byte(wr * 64 + fr, fq * 8), boff = lds_byte(wc * 32 + fr, fq * 8);
#define PG8_SA(b, h) (((b) * 2 + (h)) * HTB)
#define PG8_SB(b, h) ((4 + (b) * 2 + (h)) * HTB)
#define PG8_STAGE(bufoff, gbase, voff) do { _Pragma("unroll") for (int _i = 0; _i < 2; ++_i) \
        __builtin_amdgcn_global_load_lds((const unsigned*)((const char*)(gbase) + (voff)[_i]), (LAS unsigned*)(lds + (bufoff) + ldsw + _i * 8192), 16, 0, 0); } while (0)
#define PG8_STAGE_A(bufoff, cptr, kb, h) do { if constexpr (GATHER) { PG8_STAGE(bufoff, (const char*)g.A + (kb), goff[h]); } else { PG8_STAGE(bufoff, (cptr) + (kb) + ((h) ? hstep : 0), voffA); } } while (0)
#define PG8_LDA(dst, b, h) do { _Pragma("unroll") for (int m = 0; m < 4; ++m) _Pragma("unroll") for (int k = 0; k < 2; ++k) dst[m][k] = *(const LAS bf16x8*)(lds + PG8_SA(b, h) + aoff + m * 2048 + k * 1024); } while (0)
#define PG8_LDB(dst, b, h) do { _Pragma("unroll") for (int n = 0; n < 2; ++n) _Pragma("unroll") for (int k = 0; k < 2; ++k) dst[n][k] = *(const LAS bf16x8*)(lds + PG8_SB(b, h) + boff + n * 2048 + k * 1024); } while (0)
#define PG8_MMA(ai, bj, At, Bt) do { __builtin_amdgcn_s_setprio(1); _Pragma("unroll") for (int m = 0; m < 4; ++m) _Pragma("unroll") for (int n = 0; n < 2; ++n) _Pragma("unroll") for (int k = 0; k < 2; ++k) \
        acc[ai][bj][m][n] = __builtin_amdgcn_mfma_f32_16x16x32_bf16(Bt[n][k], At[m][k], acc[ai][bj][m][n], 0, 0, 0); __builtin_amdgcn_s_setprio(0); } while (0)
#define PG8_WAIT_V(n) asm volatile("s_waitcnt vmcnt(" #n ")" ::: "memory")
#define PG8_WAIT_L(n) asm volatile("s_waitcnt lgkmcnt(" #n ")" ::: "memory")
#define PG8_BAR __builtin_amdgcn_s_barrier()
#define PG8_SCHED __builtin_amdgcn_sched_barrier(0)
    Unit cur, nxt; int ui = 0;
    if (!S.next(0, cur)) return;
    f32x4 acc[2][2][4][2];
#pragma unroll
    for (int a = 0; a < 2; ++a)
#pragma unroll
        for (int b = 0; b < 2; ++b)
#pragma unroll
            for (int m = 0; m < 4; ++m)
#pragma unroll
                for (int n = 0; n < 2; ++n) acc[a][b][m][n] = (f32x4){0.f, 0.f, 0.f, 0.f};
    bf16x8 At[4][2], B0[2][2], B1[2][2];
    const char* cA = GATHER ? (const char*)g.A : (const char*)g.A + (size_t)cur.pm * tstep;
    const char* cB = (const char*)g.Bt + (size_t)cur.e * g.bstride + (size_t)cur.pn * tstep;
    S.a_ready(cur);
    if constexpr (GATHER) { S.load_goff(cur, goff, RA, CA); }
    PG8_STAGE(PG8_SB(0, 0), cB, voffB); PG8_STAGE(PG8_SB(0, 1), cB + hstep, voffB); PG8_STAGE_A(PG8_SA(0, 0), cA, 0, 0); PG8_STAGE_A(PG8_SA(0, 1), cA, 0, 1);
    if (wr == 1) PG8_BAR;
    PG8_WAIT_V(2); PG8_BAR;
    PG8_STAGE(PG8_SB(1, 0), cB + kstep, voffB); PG8_STAGE_A(PG8_SA(1, 0), cA, kstep, 0); PG8_STAGE(PG8_SB(1, 1), cB + hstep + kstep, voffB);
    PG8_WAIT_V(6); PG8_BAR;
    for (;;) {
        const bool has_next = S.next(ui + 1, nxt);
        const char* nA = GATHER ? cA : (has_next ? (const char*)g.A + (size_t)nxt.pm * tstep : cA);
        const char* nB = has_next ? (const char*)g.Bt + (size_t)nxt.e * g.bstride + (size_t)nxt.pn * tstep : cB;
        for (int t = 0; t < nt; t += 2) {
            const bool last = (t == nt - 2);
            const size_t kb1 = (size_t)(t + 1) * kstep;
            const char* a2 = last ? nA : cA; const size_t kb2 = last ? 0 : (size_t)(t + 2) * kstep; const char* b2 = last ? nB : cB + (size_t)(t + 2) * kstep;
            const size_t kb3 = kb2 + kstep; const char* b3 = b2 + kstep;
            if (last && has_next) S.a_ready(nxt);
            PG8_LDB(B0, 0, 0); PG8_LDB(B1, 0, 1); PG8_SCHED; PG8_LDA(At, 0, 0); PG8_STAGE_A(PG8_SA(1, 1), cA, kb1, 1);
            PG8_WAIT_V(8); PG8_WAIT_L(0); PG8_BAR; PG8_MMA(0, 0, At, B0); PG8_MMA(0, 1, At, B1); PG8_BAR; PG8_SCHED;
            if constexpr (GATHER) { if (last && has_next) S.load_goff(nxt, goff, RA, CA); }
            PG8_LDA(At, 0, 1); PG8_STAGE(PG8_SB(0, 0), b2, voffB); PG8_STAGE(PG8_SB(0, 1), b2 + hstep, voffB); PG8_STAGE_A(PG8_SA(0, 0), a2, kb2, 0);
            PG8_WAIT_V(8); PG8_WAIT_L(0); PG8_BAR; PG8_MMA(1, 0, At, B0); PG8_MMA(1, 1, At, B1); PG8_BAR; PG8_SCHED;
            PG8_LDB(B0, 1, 0); PG8_LDB(B1, 1, 1); PG8_SCHED; PG8_LDA(At, 1, 0); PG8_STAGE_A(PG8_SA(0, 1), a2, kb2, 1);
            PG8_WAIT_V(8); PG8_WAIT_L(0); PG8_BAR; PG8_MMA(0, 0, At, B0); PG8_MMA(0, 1, At, B1); PG8_BAR; PG8_SCHED;
            PG8_LDA(At, 1, 1); PG8_STAGE(PG8_SB(1, 0), b3, voffB); PG8_STAGE(PG8_SB(1, 1), b3 + hstep, voffB); PG8_STAGE_A(PG8_SA(1, 0), a2, kb3, 0);
            PG8_WAIT_V(8); PG8_WAIT_L(0); PG8_BAR; PG8_MMA(1, 0, At, B0); PG8_MMA(1, 1, At, B1); PG8_BAR; PG8_SCHED;
        }
        if constexpr (ALIGN_EPI) { if (wr == 0) PG8_BAR; }
        E(acc, cur, wr, wc, fr, fq); S.done(cur);
        if (!has_next) break;
#pragma unroll
        for (int a = 0; a < 2; ++a)
#pragma unroll
            for (int b = 0; b < 2; ++b)
#pragma unroll
                for (int m = 0; m < 4; ++m)
#pragma unroll
                    for (int n = 0; n < 2; ++n) acc[a][b][m][n] = (f32x4){0.f, 0.f, 0.f, 0.f};
        cur = nxt; cA = nA; cB = nB; ++ui;
        if constexpr (ALIGN_EPI) { if (wr == 1) PG8_BAR; }
    }
    PG8_WAIT_V(0);
    if constexpr (!ALIGN_EPI) { if (wr == 0) PG8_BAR; }
    PG8_BAR;
#undef PG8_SA
#undef PG8_SB
#undef PG8_STAGE
#undef PG8_STAGE_A
#undef PG8_LDA
#undef PG8_LDB
#undef PG8_MMA
#undef PG8_WAIT_V
#undef PG8_WAIT_L
#undef PG8_BAR
#undef PG8_SCHED
}
}

struct EpiProj {
    static constexpr bool PERM = true;
    bf16_t* O; float* dtraw; const float* qg; const float* kg; const float* rope;
    __device__ __forceinline__ void operator()(const f32x4 (&acc)[2][2][4][2], const pg8::Unit& u, int wr, int wc, int fr, int fq) const {
        const int row0 = u.pm * 256 + wr * 64 + fr, col0 = u.pn * 256 + wc * 32 + 8 * fq;
        if (u.pn < 8) {
            const float* gp = (u.pn < 4 ? qg : kg) + 4 * fq; const float sc = u.pn < 4 ? 0.125f * LOG2E : 1.f;
            f32x4 gn[2][2];
#pragma unroll
            for (int bj = 0; bj < 2; ++bj)
#pragma unroll
                for (int n = 0; n < 2; ++n) gn[bj][n] = *(const f32x4*)(gp + 32 * n + 16 * bj);
#pragma unroll
            for (int ai = 0; ai < 2; ++ai)
#pragma unroll
                for (int m = 0; m < 4; ++m) { const int row = row0 + ai * 128 + m * 16;
                    float ss = 0.f;
#pragma unroll
                    for (int bj = 0; bj < 2; ++bj)
#pragma unroll
                        for (int n = 0; n < 2; ++n) { const f32x4 v = acc[ai][bj][m][n]; ss += (v[0] * v[0] + v[1] * v[1]) + (v[2] * v[2] + v[3] * v[3]); }
                    ss += __shfl_xor(ss, 16); ss += __shfl_xor(ss, 32);
                    const float rstd = rsqrtf(ss * (1.f / 64.f) + RMS_EPS);
                    bf16_t* rowp = O + (size_t)row * NPROJ_PAD + col0; const float* rp = rope + (size_t)row * 64 + 8 * fq;
#pragma unroll
                    for (int bj = 0; bj < 2; ++bj) { const f32x4 c0 = *(const f32x4*)(rp + 32 * bj), c1 = *(const f32x4*)(rp + 32 * bj + 4);
                        const f32x4 t1 = acc[ai][bj][m][0] * rstd * gn[bj][0], t2 = acc[ai][bj][m][1] * rstd * gn[bj][1];
                        f32x4 o1, o2;
                        o1[0] = (t1[0] * c0[0] - t2[0] * c0[1]) * sc; o2[0] = (t1[0] * c0[1] + t2[0] * c0[0]) * sc;
                        o1[1] = (t1[1] * c0[2] - t2[1] * c0[3]) * sc; o2[1] = (t1[1] * c0[3] + t2[1] * c0[2]) * sc;
                        o1[2] = (t1[2] * c1[0] - t2[2] * c1[1]) * sc; o2[2] = (t1[2] * c1[1] + t2[2] * c1[0]) * sc;
                        o1[3] = (t1[3] * c1[2] - t2[3] * c1[3]) * sc; o2[3] = (t1[3] * c1[3] + t2[3] * c1[2]) * sc;
                        u32x4 w; w.x = pk2(o1[0], o1[1]); w.y = pk2(o1[2], o1[3]); w.z = pk2(o2[0], o2[1]); w.w = pk2(o2[2], o2[3]);
                        *(u32x4*)(rowp + bj * 128) = w; } }
            return;
        }
#pragma unroll
        for (int ai = 0; ai < 2; ++ai)
#pragma unroll
            for (int m = 0; m < 4; ++m) { bf16_t* rowp = O + (size_t)(row0 + ai * 128 + m * 16) * NPROJ_PAD + col0;
#pragma unroll
                for (int bj = 0; bj < 2; ++bj) { const f32x4 v0 = acc[ai][bj][m][0], v1 = acc[ai][bj][m][1];
                    u32x4 w; w.x = pk2(v0[0], v0[1]); w.y = pk2(v0[2], v0[3]); w.z = pk2(v1[0], v1[1]); w.w = pk2(v1[2], v1[3]);
                    *(u32x4*)(rowp + bj * 128) = w; } }
        if (u.pn == 22 && wc == 0) {
#pragma unroll
            for (int ai = 0; ai < 2; ++ai)
#pragma unroll
                for (int m = 0; m < 4; ++m) { float* p = dtraw + (size_t)(row0 + ai * 128 + m * 16) * 32 + 8 * fq;
                    *(f32x4*)p = acc[ai][0][m][0]; *(f32x4*)(p + 4) = acc[ai][0][m][1]; }
        }
    }
};
struct EpiOut {
    static constexpr bool PERM = true;
    const float* x; const float* mod; bf16_t* x1; float* rss;
    __device__ __forceinline__ void operator()(const f32x4 (&acc)[2][2][4][2], const pg8::Unit& u, int wr, int wc, int fr, int fq) const {
        const int row0 = u.pm * 256 + wr * 64 + fr, col0 = u.pn * 256 + wc * 32 + 8 * fq;
        const float* gp = mod + (size_t)(u.pm >= 32 ? 1 : 0) * 12288 + 2 * D + col0;
        f32x4 gv[2][2];
#pragma unroll
        for (int bj = 0; bj < 2; ++bj)
#pragma unroll
            for (int n = 0; n < 2; ++n) gv[bj][n] = *(const f32x4*)(gp + bj * 128 + n * 4);
        f32x4 xa[2][2][2], xb[2][2][2];
#define EO_LOAD(ch_, buf_) do { _Pragma("unroll") for (int mm = 0; mm < 2; ++mm) { const float* p_ = x + (size_t)(row0 + ((ch_) >> 1) * 128 + (2 * ((ch_) & 1) + mm) * 16) * D + col0; \
            _Pragma("unroll") for (int bj = 0; bj < 2; ++bj) { buf_[mm][bj][0] = __builtin_nontemporal_load((const f32x4*)(p_ + bj * 128)); buf_[mm][bj][1] = __builtin_nontemporal_load((const f32x4*)(p_ + bj * 128 + 4)); } } } while (0)
#define EO_PROC(ch_, buf_) do { _Pragma("unroll") for (int mm = 0; mm < 2; ++mm) { const int ai_ = (ch_) >> 1, m_ = 2 * ((ch_) & 1) + mm; const size_t off = (size_t)(row0 + ai_ * 128 + m_ * 16) * D + col0; float ss = 0.f; \
            _Pragma("unroll") for (int bj = 0; bj < 2; ++bj) { const f32x4 o0 = buf_[mm][bj][0] + gv[bj][0] * acc[ai_][bj][m_][0], o1 = buf_[mm][bj][1] + gv[bj][1] * acc[ai_][bj][m_][1]; \
                ss += (o0[0] * o0[0] + o0[1] * o0[1]) + (o0[2] * o0[2] + o0[3] * o0[3]) + (o1[0] * o1[0] + o1[1] * o1[1]) + (o1[2] * o1[2] + o1[3] * o1[3]); \
                u32x4 w; w.x = pk2(o0[0], o0[1]); w.y = pk2(o0[2], o0[3]); w.z = pk2(o1[0], o1[1]); w.w = pk2(o1[2], o1[3]); \
                *(u32x4*)(x1 + off + bj * 128) = w; } \
            ss += __shfl_xor(ss, 16); ss += __shfl_xor(ss, 32); \
            if (fq == 0) rss[(size_t)(row0 + ai_ * 128 + m_ * 16) * 32 + 4 * u.pn + wc] = ss; } } while (0)
        EO_LOAD(0, xa); EO_LOAD(1, xb); asm volatile("" ::: "memory");
        EO_PROC(0, xa); asm volatile("" ::: "memory"); EO_LOAD(2, xa); asm volatile("" ::: "memory");
        EO_PROC(1, xb); asm volatile("" ::: "memory"); EO_LOAD(3, xb); asm volatile("" ::: "memory");
        EO_PROC(2, xa); EO_PROC(3, xb);
#undef EO_LOAD
#undef EO_PROC
    }
};
struct EpiGU {
    static constexpr bool PERM = true;
    bf16_t* H;
    __device__ __forceinline__ void operator()(const f32x4 (&acc)[2][2][4][2], const pg8::Unit& u, int wr, int wc, int fr, int fq) const {
        const int row0 = u.pm * 256 + wr * 64 + fr, col0 = u.pn * 128 + wc * 16 + 4 * fq;
#pragma unroll
        for (int ai = 0; ai < 2; ++ai)
#pragma unroll
            for (int m = 0; m < 4; ++m) { bf16_t* rowp = H + (size_t)(row0 + ai * 128 + m * 16) * EH + col0;
#pragma unroll
                for (int bj = 0; bj < 2; ++bj) { const f32x4 gt = acc[ai][bj][m][0], up = acc[ai][bj][m][1];
                    u32x2 w; w.x = pk2(silu_f(gt[0]) * up[0], silu_f(gt[1]) * up[1]); w.y = pk2(silu_f(gt[2]) * up[2], silu_f(gt[3]) * up[3]);
                    *(u32x2*)(rowp + bj * 64) = w; } }
    }
};
struct EpiDown {
    static constexpr bool PERM = true;
    bf16_t* Y; const LAS int* tab;
    __device__ __forceinline__ void operator()(const f32x4 (&acc)[2][2][4][2], const pg8::Unit& u, int wr, int wc, int fr, int fq) const {
        const int col0 = u.pn * 256 + wc * 32 + 8 * fq;
        const LAS int* tb = tab + u.li * 512;
#pragma unroll
        for (int ai = 0; ai < 2; ++ai)
#pragma unroll
            for (int m = 0; m < 4; ++m) { const int r = ai * 128 + wr * 64 + m * 16 + fr; const int a = tb[2 * r]; const float gt = __int_as_float(tb[2 * r + 1]);
                if (a >= 0) { bf16_t* rowp = Y + (size_t)a * D + col0;
#pragma unroll
                    for (int bj = 0; bj < 2; ++bj) { const f32x4 v0 = acc[ai][bj][m][0] * gt, v1 = acc[ai][bj][m][1] * gt;
                        u32x4 w; w.x = pk2(v0[0], v0[1]); w.y = pk2(v0[2], v0[3]); w.z = pk2(v1[0], v1[1]); w.w = pk2(v1[2], v1[3]);
                        *(u32x4*)(rowp + bj * 128) = w; } } }
    }
};
struct MoeOrder {
    const LAS int* tilebase; int ntiles, npn, G, c; const LAS unsigned* goff_tab;
    __device__ __forceinline__ bool next(int i, pg8::Unit& u) const {
        const long L = (long)i * G + c; if (L >= (long)ntiles * npn) return false;
        const int tau = (int)(L / npn); u.pn = (int)(L % npn); u.pm = tau; u.li = i;
        int e = 0;
        for (int j = 1; j < NEXP; ++j) e += (tilebase[j] <= tau) ? 1 : 0;
        u.e = e; return true;
    }
    __device__ __forceinline__ void a_ready(const pg8::Unit&) const {}
    __device__ __forceinline__ void done(const pg8::Unit&) const {}
    __device__ __forceinline__ void load_goff(const pg8::Unit& u, unsigned (&goff)[2][2], const int (&RA)[2], const int (&CA)[2]) const {
        const LAS unsigned* tb = goff_tab + u.li * 256;
#pragma unroll
        for (int h = 0; h < 2; ++h)
#pragma unroll
            for (int i = 0; i < 2; ++i) goff[h][i] = tb[h * 128 + RA[i]] + (unsigned)CA[i] * 2u;
    }
};

struct Args { const void* in[24]; float* out; unsigned char* ws; int ph_lo, ph_hi; };
enum InIdx { I_X = 0, I_C, I_POS, I_WADA, I_BADA, I_N1G, I_WIN, I_CONVW, I_CONVB, I_DTBIAS, I_ALOG, I_DSKIP, I_SSDG, I_QG, I_KG, I_WOUT, I_N2G, I_WRG, I_BRG, I_WRE, I_BRE, I_WG, I_WU, I_WD };

__device__ __forceinline__ int vcu_id() { const int G = gridDim.x, bx = blockIdx.x; return (G % 8 == 0) ? (bx % 8) * (G / 8) + bx / 8 : bx; }
__device__ __forceinline__ float wave_sum(float v) {
#pragma unroll
    for (int o = 1; o < 64; o <<= 1) v += __shfl_xor(v, o);
    return v;
}

__device__ __forceinline__ void p0_adaln(const float* c, const float* w_ada, const float* b_ada, float* mod, LAS float* lds) {
    const int tid = threadIdx.x;
    LAS float* sc = lds; LAS float* red = lds + 4096;
    { const f32x4 c0 = *(const f32x4*)(c + 8 * tid), c1 = *(const f32x4*)(c + 8 * tid + 4);
#pragma unroll
      for (int j = 0; j < 4; ++j) { sc[8 * tid + j] = silu_f(c0[j]); sc[8 * tid + 4 + j] = silu_f(c1[j]); } }
    __syncthreads();
    for (int cg = blockIdx.x; cg < 256; cg += gridDim.x) {
        if (tid < 504) {
            const int c4 = tid % 12, r0 = tid / 12;
            f32x4 a0 = {0.f, 0.f, 0.f, 0.f}, a1 = {0.f, 0.f, 0.f, 0.f};
            const float* wp = w_ada + 48 * cg + 4 * c4;
#pragma unroll 7
            for (int k = r0; k < D; k += 42) { const f32x4 w = __builtin_nontemporal_load((const f32x4*)(wp + (size_t)k * 12288)); a0 += w * sc[k]; a1 += w * sc[D + k]; }
            LAS float* rp = red + (r0 * 12 + c4) * 8;
            rp[0] = a0[0]; rp[1] = a0[1]; rp[2] = a0[2]; rp[3] = a0[3]; rp[4] = a1[0]; rp[5] = a1[1]; rp[6] = a1[2]; rp[7] = a1[3];
        }
        __syncthreads();
        if (tid < 96) {
            const int c4 = tid >> 3, j = tid & 7; float s = 0.f;
            for (int r = 0; r < 42; ++r) s += red[(r * 12 + c4) * 8 + j];
            const int col = 48 * cg + 4 * c4 + (j & 3);
            mod[(j >> 2) * 12288 + col] = s + b_ada[col];
        }
        __syncthreads();
    }
}
template <class RowMap>
__device__ __forceinline__ void transpose_item(const float* W, int ldw, int nvalid, bf16_t* WT, int ldt, int k0, int n0, LAS float* scr, int lane, RowMap rm) {
#pragma unroll 4
    for (int it = 0; it < 16; ++it) {
        const int kk = 4 * it + (lane >> 4), n = n0 + 4 * (lane & 15);
        f32x4 v = {0.f, 0.f, 0.f, 0.f};
        if (n < nvalid) v = __builtin_nontemporal_load((const f32x4*)(W + (size_t)(k0 + kk) * ldw + n));
        LAS float* s = scr + kk * 65 + 4 * (lane & 15);
        s[0] = v[0]; s[1] = v[1]; s[2] = v[2]; s[3] = v[3];
    }
    LDS_WAIT(); asm volatile("" ::: "memory");
    const int c = lane & 7;
#pragma unroll
    for (int j = 0; j < 8; ++j) {
        const int nn = (lane >> 3) + 8 * j, n = n0 + nn;
        const LAS float* s = scr + (8 * c) * 65 + nn;
        u32x4 o; o.x = pk2(s[0], s[65]); o.y = pk2(s[2 * 65], s[3 * 65]); o.z = pk2(s[4 * 65], s[5 * 65]); o.w = pk2(s[6 * 65], s[7 * 65]);
        if (n < nvalid) *(u32x4*)(WT + (size_t)rm(n) * ldt + k0 + 8 * c) = o;
    }
    LDS_WAIT(); asm volatile("" ::: "memory");
}
struct RmId { __device__ __forceinline__ int operator()(int n) const { return n; } };
struct RmIn { __device__ __forceinline__ int operator()(int c) const { if (c >= 2048) return c; const int blk = c & ~1023, hd = (c >> 6) & 15, i = c & 63;
    return blk + 256 * (hd >> 2) + 128 * ((i >> 4) & 1) + 32 * (hd & 3) + 8 * ((i >> 2) & 3) + 4 * (i >> 5) + (i & 3); } };
struct RmGU { int add; __device__ __forceinline__ int operator()(int n) const { return 8 * (n >> 2) + add + (n & 3); } };

__device__ __forceinline__ void p0_prologue(const Args& A, LAS unsigned char* lds) {
    const int tid = threadIdx.x, lane = tid & 63, wave = tid >> 6;
    unsigned char* ws = A.ws;
    p0_adaln((const float*)A.in[I_C], (const float*)A.in[I_WADA], (const float*)A.in[I_BADA], (float*)(ws + WS_MOD), (LAS float*)lds);
    const int gtid = blockIdx.x * 512 + tid, NT = gridDim.x * 512;
    { const int* pos = (const int*)A.in[I_POS]; float* rope = (float*)(ws + WS_ROPE);
      const int f = gtid & 31; const float invf = powf(10000.0f, -(float)f / 32.0f);
      for (int t0 = gtid >> 5; t0 < T; t0 += 4 * (NT >> 5)) { int pv[4];
#pragma unroll
          for (int u = 0; u < 4; ++u) { const int t = t0 + u * (NT >> 5); pv[u] = pos[t < T ? t : T - 1]; }
#pragma unroll
          for (int u = 0; u < 4; ++u) { const int t = t0 + u * (NT >> 5); if (t < T) { const float ang = (float)pv[u] * invf;
              const double rev = (double)ang * 0.15915494309189533577; const float fr = (float)(rev - rint(rev));
              f32x2 cs = {__builtin_amdgcn_cosf(fr), __builtin_amdgcn_sinf(fr)}; *(f32x2*)(rope + 2 * (t * 32 + f)) = cs; } } } }
    { const float* wrg = (const float*)A.in[I_WRG]; const float* wre = (const float*)A.in[I_WRE]; bf16_t* hi = (bf16_t*)(ws + WS_WRT);
      for (int i = gtid; i < NRT * D; i += NT) { const int n = i / D, k = i % D; float w = 0.f;
          if (n < 8) w = wrg[k * 8 + n]; else if (n >= 16) w = wre[k * 64 + (n - 16)];
          hi[i] = (bf16_t)f2bf(w); } }
    { u32x4* z = (u32x4*)(ws + WS_WINT + (size_t)NPROJ * D * 2); const int n16 = (NPROJ_PAD - NPROJ) * D * 2 / 16;
      for (int i = gtid; i < n16; i += NT) z[i] = (u32x4){0u, 0u, 0u, 0u}; }
    __syncthreads();
    LAS float* scr = (LAS float*)(lds) + wave * (64 * 65);
    const int gw = blockIdx.x * 8 + wave, NGW = gridDim.x * 8;
    constexpr int I_IN = 32 * 89;
    const float* W = (const float*)A.in[I_WIN]; bf16_t* WT = (bf16_t*)(ws + WS_WINT);
    f32x4 va[16], vb[16];
#define WIN_LOAD(it_, v_) do { const int k0_ = 64 * ((it_) / 89), n_ = 64 * ((it_) % 89) + 4 * (lane & 15); const float* p_ = W + (size_t)(k0_ + (lane >> 4)) * NPROJ + (n_ < NPROJ ? n_ : NPROJ - 4); \
        _Pragma("unroll") for (int i_ = 0; i_ < 16; ++i_) v_[i_] = __builtin_nontemporal_load((const f32x4*)(p_ + (size_t)(4 * i_) * NPROJ)); } while (0)
#define WIN_STORE(it_, v_) do { const int k0_ = 64 * ((it_) / 89), n0_ = 64 * ((it_) % 89); \
        _Pragma("unroll") for (int i_ = 0; i_ < 16; ++i_) { LAS float* sp_ = scr + (4 * i_ + (lane >> 4)) * 65 + 4 * (lane & 15); sp_[0] = v_[i_][0]; sp_[1] = v_[i_][1]; sp_[2] = v_[i_][2]; sp_[3] = v_[i_][3]; } \
        LDS_WAIT(); asm volatile("" ::: "memory"); const int c_ = lane & 7; \
        _Pragma("unroll") for (int j_ = 0; j_ < 8; ++j_) { const int nn_ = (lane >> 3) + 8 * j_, n_ = n0_ + nn_; const LAS float* sp_ = scr + (8 * c_) * 65 + nn_; \
            u32x4 o_; o_.x = pk2(sp_[0], sp_[65]); o_.y = pk2(sp_[2 * 65], sp_[3 * 65]); o_.z = pk2(sp_[4 * 65], sp_[5 * 65]); o_.w = pk2(sp_[6 * 65], sp_[7 * 65]); \
            if (n_ < NPROJ) *(u32x4*)(WT + (size_t)RmIn{}(n_) * D + k0_ + 8 * c_) = o_; } \
        LDS_WAIT(); asm volatile("" ::: "memory"); } while (0)
    int it = gw;
    if (it < I_IN) WIN_LOAD(it, va);
    while (it < I_IN) {
        const bool hb = it + NGW < I_IN;
        if (hb) WIN_LOAD(it + NGW, vb);
        WIN_STORE(it, va);
        if (!hb) break;
        const bool ha = it + 2 * NGW < I_IN;
        if (ha) WIN_LOAD(it + 2 * NGW, va);
        WIN_STORE(it + NGW, vb);
        if (!ha) break;
        it += 2 * NGW;
    }
#undef WIN_LOAD
#undef WIN_STORE
}
struct TItem { const float* src; bf16_t* dst; int ldw, ldt, gu, n0; };
__device__ __forceinline__ void late_item(const Args& A, int it, TItem& d) {
    unsigned char* ws = A.ws;
    constexpr int I_OUT = 32 * 32, I_E = 32 * 8, I_DN = 8 * 32;
    int r = it;
    if (r < I_OUT) { const int k0 = 64 * (r / 32), n0 = 64 * (r % 32); d.src = (const float*)A.in[I_WOUT] + (size_t)k0 * D + n0; d.dst = (bf16_t*)(ws + WS_WOUTT) + k0; d.ldw = D; d.ldt = D; d.gu = -1; d.n0 = n0; return; }
    r -= I_OUT;
    const int e = r / (2 * I_E + I_DN); r -= e * (2 * I_E + I_DN);
    if (r < 2 * I_E) { const int up = r >= I_E ? 1 : 0; r -= up * I_E; const int k0 = 64 * (r / 8), n0 = 64 * (r % 8);
        d.src = (const float*)A.in[up ? I_WU : I_WG] + (size_t)e * D * EH + (size_t)k0 * EH + n0; d.dst = (bf16_t*)(ws + WS_WGUT) + (size_t)e * 1024 * D + k0; d.ldw = EH; d.ldt = D; d.gu = 4 * up; d.n0 = n0; return; }
    r -= 2 * I_E;
    { const int k0 = 64 * (r / 32), n0 = 64 * (r % 32); d.src = (const float*)A.in[I_WD] + (size_t)e * EH * D + (size_t)k0 * D + n0; d.dst = (bf16_t*)(ws + WS_WDT) + (size_t)e * D * EH + k0; d.ldw = D; d.ldt = EH; d.gu = -1; d.n0 = n0; }
}
__device__ __forceinline__ void titem_load(const TItem& d, f32x4 (&v)[16], int lane) {
    const float* p = d.src + (size_t)(lane >> 4) * d.ldw + 4 * (lane & 15);
#pragma unroll
    for (int i = 0; i < 16; ++i) v[i] = __builtin_nontemporal_load((const f32x4*)(p + (size_t)(4 * i) * d.ldw));
}
__device__ __forceinline__ void titem_store(const TItem& d, const f32x4 (&v)[16], LAS float* scr, int lane) {
#pragma unroll
    for (int i = 0; i < 16; ++i) { LAS float* sp = scr + (4 * i + (lane >> 4)) * 65 + 4 * (lane & 15); sp[0] = v[i][0]; sp[1] = v[i][1]; sp[2] = v[i][2]; sp[3] = v[i][3]; }
    LDS_WAIT(); asm volatile("" ::: "memory");
    const int c = lane & 7;
#pragma unroll
    for (int j = 0; j < 8; ++j) { const int nn = (lane >> 3) + 8 * j, n = d.n0 + nn; const LAS float* sp = scr + (8 * c) * 65 + nn;
        u32x4 o; o.x = pk2(sp[0], sp[65]); o.y = pk2(sp[2 * 65], sp[3 * 65]); o.z = pk2(sp[4 * 65], sp[5 * 65]); o.w = pk2(sp[6 * 65], sp[7 * 65]);
        const int row = d.gu < 0 ? n : (8 * (n >> 2) + d.gu + (n & 3));
        __builtin_nontemporal_store(o, (u32x4*)(d.dst + (size_t)row * d.ldt + 8 * c)); }
    LDS_WAIT(); asm volatile("" ::: "memory");
}
__device__ __forceinline__ int claim_items(unsigned* ctr, unsigned n) { unsigned v = 0; if ((threadIdx.x & 63) == 0) v = __hip_atomic_fetch_add(ctr, n, __ATOMIC_RELAXED, __HIP_MEMORY_SCOPE_AGENT); return (int)__builtin_amdgcn_readfirstlane(v); }
__device__ __forceinline__ void p2_convert_late(const Args& A, LAS unsigned char* lds) {
    const int lane = threadIdx.x & 63, wave = threadIdx.x >> 6;
    LAS float* scr = (LAS float*)(lds) + wave * (64 * 65);
    unsigned* ctr = (unsigned*)(A.ws + WS_CTL) + CW_FLAG + 64;
    constexpr int NITEMS = 32 * 32 + NEXP * (2 * 32 * 8 + 8 * 32), CB = 16;
    int base = claim_items(ctr, CB), pos = 0;
#define CONV_NEXT() ({ if (pos == CB) { base = claim_items(ctr, CB); pos = 0; } const int r_ = base + pos; ++pos; r_; })
#define CONV_PROC(d_, v_, itn_) do { \
        _Pragma("unroll") for (int i = 0; i < 16; ++i) { LAS float* sp = scr + (4 * i + (lane >> 4)) * 65 + 4 * (lane & 15); sp[0] = v_[i][0]; sp[1] = v_[i][1]; sp[2] = v_[i][2]; sp[3] = v_[i][3]; } \
        const TItem dc_ = d_; late_item(A, (itn_) < NITEMS ? (itn_) : NITEMS - 1, d_); titem_load(d_, v_, lane); \
        LDS_WAIT(); asm volatile("" ::: "memory"); \
        const int c = lane & 7; \
        _Pragma("unroll") for (int j = 0; j < 8; ++j) { const int nn = (lane >> 3) + 8 * j, n = dc_.n0 + nn; const LAS float* sp = scr + (8 * c) * 65 + nn; \
            u32x4 o; o.x = pk2(sp[0], sp[65]); o.y = pk2(sp[2 * 65], sp[3 * 65]); o.z = pk2(sp[4 * 65], sp[5 * 65]); o.w = pk2(sp[6 * 65], sp[7 * 65]); \
            const int row = dc_.gu < 0 ? n : (8 * (n >> 2) + dc_.gu + (n & 3)); \
            __builtin_nontemporal_store(o, (u32x4*)(dc_.dst + (size_t)row * dc_.ldt + 8 * c)); } \
        LDS_WAIT(); asm volatile("" ::: "memory"); } while (0)
    TItem da, db; f32x4 va[16], vb[16];
    int ia = CONV_NEXT(), ib = CONV_NEXT();
    late_item(A, ia < NITEMS ? ia : NITEMS - 1, da); titem_load(da, va, lane);
    late_item(A, ib < NITEMS ? ib : NITEMS - 1, db); titem_load(db, vb, lane);
#pragma unroll 1
    for (;;) {
        if (ia >= NITEMS) break;
        { const int in = CONV_NEXT(); CONV_PROC(da, va, in); ia = in; }
        if (ib >= NITEMS) break;
        { const int in = CONV_NEXT(); CONV_PROC(db, vb, in); ib = in; }
    }
#undef CONV_NEXT
#undef CONV_PROC
}

__device__ __forceinline__ void p1_norm1(const Args& A) {
    const int tid = threadIdx.x, lane = tid & 63, wave = tid >> 6;
    const float* x = (const float*)A.in[I_X]; const float* g1 = (const float*)A.in[I_N1G]; const float* mod = (const float*)(A.ws + WS_MOD);
    bf16_t* hb = (bf16_t*)(A.ws + WS_HB);
    const int gw = blockIdx.x * 8 + wave, NGW = gridDim.x * 8, NB = NGW / BATCH, bsel = gw / NB, r0 = gw - bsel * NB;
    if (bsel >= BATCH) return;
    const float* mb = mod + bsel * 12288;
    f32x4 ca[8], cs[8];
#pragma unroll
    for (int j = 0; j < 8; ++j) { const int col = 4 * lane + 256 * j; const f32x4 g = *(const f32x4*)(g1 + col), sc = *(const f32x4*)(mb + D + col); ca[j] = g * (sc + 1.f); cs[j] = *(const f32x4*)(mb + col); }
    f32x4 v[8], vn[8];
    if (r0 < SEQ) { const f32x4* xr = (const f32x4*)(x + (size_t)(bsel * SEQ + r0) * D) + lane;
#pragma unroll
        for (int j = 0; j < 8; ++j) vn[j] = __builtin_nontemporal_load(xr + 64 * j); }
    for (int r = r0; r < SEQ; r += NB) { const int m = bsel * SEQ + r;
#pragma unroll
        for (int j = 0; j < 8; ++j) v[j] = vn[j];
        if (r + NB < SEQ) { const f32x4* xr = (const f32x4*)(x + (size_t)(m + NB) * D) + lane;
#pragma unroll
            for (int j = 0; j < 8; ++j) vn[j] = __builtin_nontemporal_load(xr + 64 * j); }
        float s = 0.f;
#pragma unroll
        for (int j = 0; j < 8; ++j) s += (v[j][0] * v[j][0] + v[j][1] * v[j][1]) + (v[j][2] * v[j][2] + v[j][3] * v[j][3]);
        const float rstd = rsqrtf(wave_sum(s) * (1.f / D) + RMS_EPS);
        u32x2* o = (u32x2*)(hb + (size_t)m * D) + lane;
#pragma unroll
        for (int j = 0; j < 8; ++j) { const f32x4 h = (v[j] * rstd) * ca[j] + cs[j];
            u32x2 w; w.x = pk2(h[0], h[1]); w.y = pk2(h[2], h[3]); o[64 * j] = w; }
    }
}

__device__ __forceinline__ void p3_post(const Args& A, int dryA, int repB) {
    const int tid = threadIdx.x, lane = tid & 63, wave = tid >> 6;
    unsigned char* ws = A.ws;
    bf16_t* proj = (bf16_t*)(ws + WS_PROJ);
    const int gw = blockIdx.x * 8 + wave, NGW = gridDim.x * 8;
    for (int rb = 0; rb < repB; ++rb) { const float* cw = (const float*)A.in[I_CONVW]; const float* cb = (const float*)A.in[I_CONVB]; bf16_t* xc = (bf16_t*)(ws + WS_HB);
      for (int tb = gw; tb < T / 8; tb += NGW) {
          const int t0 = tb * 8, s0 = t0 & (SEQ - 1), sb = t0 - s0;
          u32x4 ra[12]; f32x4 wa[5], wb[5], ba, bb;
#define P3_LOAD(c8_, r_, wa_, wb_, ba_, bb_) do { const bf16_t* pc_ = proj + OFF_XBC + (c8_); \
              _Pragma("unroll") for (int k = 0; k < 12; ++k) { int t_ = t0 + k - 2; t_ = t_ < sb ? sb : t_; t_ = t_ > sb + SEQ - 1 ? sb + SEQ - 1 : t_; r_[k] = *(const u32x4*)(pc_ + (size_t)t_ * NPROJ_PAD); } \
              _Pragma("unroll") for (int k = 0; k < 5; ++k) { wa_[k] = *(const f32x4*)(cw + k * XBCW + (c8_)); wb_[k] = *(const f32x4*)(cw + k * XBCW + (c8_) + 4); } \
              ba_ = *(const f32x4*)(cb + (c8_)); bb_ = *(const f32x4*)(cb + (c8_) + 4); } while (0)
#pragma unroll 1
          for (int st = 0; st < 3; ++st) { const int c8 = 8 * (lane + 64 * st);
              P3_LOAD(c8, ra, wa, wb, ba, bb);
              if (s0 == 0) { ra[0] = (u32x4){0u, 0u, 0u, 0u}; ra[1] = (u32x4){0u, 0u, 0u, 0u}; }
              if (s0 == SEQ - 8) { ra[10] = (u32x4){0u, 0u, 0u, 0u}; ra[11] = (u32x4){0u, 0u, 0u, 0u}; }
#pragma unroll
              for (int j = 0; j < 8; ++j) {
                  f32x4 a0 = ba, a1 = bb;
#pragma unroll
                  for (int k = 0; k < 5; ++k) { const u32x4 w = ra[j + k];
                      a0[0] += lo_f(w.x) * wa[k][0]; a0[1] += hi_f(w.x) * wa[k][1]; a0[2] += lo_f(w.y) * wa[k][2]; a0[3] += hi_f(w.y) * wa[k][3];
                      a1[0] += lo_f(w.z) * wb[k][0]; a1[1] += hi_f(w.z) * wb[k][1]; a1[2] += lo_f(w.w) * wb[k][2]; a1[3] += hi_f(w.w) * wb[k][3]; }
                  u32x4 o; o.x = pk2(silu_f(a0[0]), silu_f(a0[1])); o.y = pk2(silu_f(a0[2]), silu_f(a0[3])); o.z = pk2(silu_f(a1[0]), silu_f(a1[1])); o.w = pk2(silu_f(a1[2]), silu_f(a1[3]));
                  *(u32x4*)(xc + (size_t)(t0 + j) * XBCW + c8) = o; }
          }
#undef P3_LOAD
      } }
    { const float* dtraw = (const float*)(ws + WS_DTRAW); const float* dtbias = (const float*)A.in[I_DTBIAS]; const float* alog = (const float*)A.in[I_ALOG];
      float* dtf = (float*)(ws + WS_DTF); float* dtb = (float*)(ws + WS_DTB); float* acs = (float*)(ws + WS_ACS); float* rcs = (float*)(ws + WS_RCS); float* dec = (float*)(ws + WS_DEC);
      const int h = lane & 15, q = lane >> 4;
      for (int it = gw; it < BATCH * NCHUNK * 2; it += NGW) {
          const int dir = it & 1, bc = it >> 1; const int t0 = bc * CHUNK + 32 * q;
          const float aneg = -__expf(alog[dir * 16 + h]), bias = dtbias[dir * 16 + h];
          float d[32];
#pragma unroll
          for (int i = 0; i < 32; ++i) d[i] = dtraw[(size_t)(t0 + i) * 32 + dir * 16 + h];
          float tot = 0.f;
#pragma unroll
          for (int i = 0; i < 32; ++i) { const float r = d[i] + bias; d[i] = r > 20.f ? r : log1pf(__expf(r)); tot += d[i] * aneg; }
          const float t1 = __shfl_xor(tot, 16), t2 = __shfl_xor(tot, 32), t3 = __shfl_xor(tot, 48);
          float tq[4]; tq[q] = tot; tq[q ^ 1] = t1; tq[q ^ 2] = t2; tq[q ^ 3] = t3;
          float base = 0.f;
          if (dir == 0) { for (int j = 0; j < 4; ++j) if (j < q) base += tq[j]; } else { for (int j = 0; j < 4; ++j) if (j > q) base += tq[j]; }
          float* dd = dir ? dtb : dtf; float* cc = dir ? rcs : acs;
          if (dir == 0) { float run = base;
#pragma unroll
              for (int i = 0; i < 32; ++i) { run += d[i] * aneg; dd[(size_t)(t0 + i) * 16 + h] = d[i]; cc[(size_t)(t0 + i) * 16 + h] = run; } }
          else { float run = base;
#pragma unroll
              for (int i = 31; i >= 0; --i) { run += d[i] * aneg; dd[(size_t)(t0 + i) * 16 + h] = d[i]; cc[(size_t)(t0 + i) * 16 + h] = run; } }
          if (q == 0) dec[bc * 32 + dir * 16 + h] = __expf(tq[0] + tq[1] + tq[2] + tq[3]);
      } }
}

__device__ __forceinline__ bf16x8 mk_frag(u32x4 w) { return __builtin_bit_cast(bf16x8, w); }
__device__ __forceinline__ f32x4 mfma16(bf16x8 a, bf16x8 b, f32x4 c) { return __builtin_amdgcn_mfma_f32_16x16x32_bf16(a, b, c, 0, 0, 0); }

typedef short v4i16_t __attribute__((ext_vector_type(4)));
__device__ __forceinline__ u32x2 lds_tr16(const LAS bf16_t* p) { return __builtin_bit_cast(u32x2, __builtin_amdgcn_ds_read_tr16_b64_v4i16((LAS v4i16_t*)p)); }
__device__ __forceinline__ bf16x8 lds_tr16x2(const LAS bf16_t* p, int rowstep4) { const u32x2 a = lds_tr16(p), b = lds_tr16(p + rowstep4); u32x4 w; w.x = a.x; w.y = a.y; w.z = b.x; w.w = b.y; return mk_frag(w); }

constexpr int SP = 136;
constexpr int XP = 72;
__device__ __forceinline__ void p4_ssd_local(const Args& A, LAS unsigned char* lds, int rep) {
    const int tid = threadIdx.x, lane = tid & 63, w = __builtin_amdgcn_readfirstlane(tid >> 6), fr = lane & 15, fq = lane >> 4;
    unsigned char* ws = A.ws;
    const bf16_t* xc = (const bf16_t*)(ws + WS_HB);
    const float* DTF = (const float*)(ws + WS_DTF); const float* DTB = (const float*)(ws + WS_DTB); const float* ACS = (const float*)(ws + WS_ACS); const float* RCS = (const float*)(ws + WS_RCS);
    bf16_t* YD = (bf16_t*)(ws + WS_YD); bf16_t* ST = (bf16_t*)(ws + WS_ST);
    LAS bf16_t* Cs = (LAS bf16_t*)lds; LAS bf16_t* Bs = (LAS bf16_t*)(lds + 34816);
    LAS bf16_t* Xs = (LAS bf16_t*)(lds + 69632);
    LAS float* VEC = (LAS float*)(lds + 69632 + 36864);
    const int sl = tid >> 2, sq = tid & 3;
    for (int uu = vcu_id(); uu < BATCH * NCHUNK * 2 * rep; uu += gridDim.x) { const int u = uu & 255;
        const int b = u >> 7, c = (u >> 1) & 63, g = u & 1; const int t0 = b * SEQ + c * CHUNK;
        u32x4 xv[2]; float vv[6];
#define P4_XLOAD(h_) do { const bf16_t* src_ = xc + (size_t)(t0 + sl) * XBCW + 64 * (h_) + 16 * sq; xv[0] = *(const u32x4*)src_; xv[1] = *(const u32x4*)(src_ + 8); \
            if (tid < 128) { const size_t o_ = (size_t)(t0 + tid) * 16 + (h_); vv[0] = DTF[o_]; vv[1] = DTB[o_]; vv[2] = ACS[o_]; vv[3] = RCS[o_]; vv[4] = ACS[(size_t)(t0 + 127) * 16 + (h_)]; vv[5] = RCS[(size_t)t0 * 16 + (h_)]; } } while (0)
#define P4_XSTORE(buf_) do { *(LAS u32x4*)(Xs + (buf_) * (128 * XP) + sl * XP + 16 * sq) = xv[0]; *(LAS u32x4*)(Xs + (buf_) * (128 * XP) + sl * XP + 16 * sq + 8) = xv[1]; \
            if (tid < 128) { LAS float* v_ = VEC + (buf_) * 768; v_[tid] = vv[0]; v_[128 + tid] = vv[1]; v_[256 + tid] = vv[2]; v_[384 + tid] = vv[3]; v_[512 + tid] = __expf(vv[4] - vv[2]) * vv[0]; v_[640 + tid] = __expf(vv[5] - vv[3]) * vv[1]; } } while (0)
        { const bf16_t* src = xc + (size_t)(t0 + sl) * XBCW + 1024 + 128 * g + 32 * sq;
#pragma unroll
          for (int i = 0; i < 4; ++i) { *(LAS u32x4*)(Bs + sl * SP + 32 * sq + 8 * i) = *(const u32x4*)(src + 8 * i); *(LAS u32x4*)(Cs + sl * SP + 32 * sq + 8 * i) = *(const u32x4*)(src + 256 + 8 * i); } }
        P4_XLOAD(8 * g);
        __syncthreads();
        { bf16x8 cf[4];
#pragma unroll
          for (int ks = 0; ks < 4; ++ks) cf[ks] = *(const LAS bf16x8*)(Cs + (16 * w + fr) * SP + 32 * ks + 8 * fq);
          u32x2 cbw[8];
#pragma unroll
          for (int st = 0; st < 8; ++st) { f32x4 acc = {0.f, 0.f, 0.f, 0.f};
#pragma unroll
              for (int ks = 0; ks < 4; ++ks) acc = mfma16(*(const LAS bf16x8*)(Bs + (16 * st + fr) * SP + 32 * ks + 8 * fq), cf[ks], acc);
              cbw[st].x = pk2(acc[0], acc[1]); cbw[st].y = pk2(acc[2], acc[3]); }
#pragma unroll
          for (int st = 0; st < 8; ++st) *(LAS u32x2*)(Cs + (16 * w + fr) * SP + 16 * st + 4 * fq) = cbw[st]; }
        bf16x8 btf[4];
#pragma unroll
        for (int ks = 0; ks < 4; ++ks) btf[ks] = lds_tr16x2(Bs + (32 * ks + 8 * fq + (fr >> 2)) * SP + 16 * w + 4 * (fr & 3), 4 * SP);
        P4_XSTORE(0);
        __syncthreads();
        for (int hh = 0; hh < 8; ++hh) {
            const int h = 8 * g + hh, buf = hh & 1;
            P4_XLOAD(hh < 7 ? h + 1 : h);
            const LAS bf16_t* Xb = Xs + buf * (128 * XP); const LAS float* V = VEC + buf * 768;
            { const int l = 16 * w + fr; const float ac_l = V[256 + l], rc_l = V[384 + l];
              f32x4 acc[4], sf[4], sb[4];
#pragma unroll
              for (int pt = 0; pt < 4; ++pt) { acc[pt] = (f32x4){0.f, 0.f, 0.f, 0.f}; sf[pt] = (f32x4){0.f, 0.f, 0.f, 0.f}; sb[pt] = (f32x4){0.f, 0.f, 0.f, 0.f}; }
#pragma unroll
              for (int ks = 0; ks < 4; ++ks) { const int s0 = 32 * ks + 8 * fq;
                  bf16x8 xf[4];
#pragma unroll
                  for (int pt = 0; pt < 4; ++pt) xf[pt] = lds_tr16x2(Xb + (s0 + (fr >> 2)) * XP + 16 * pt + 4 * (fr & 3), 4 * XP);
                  const u32x4 cb = *(const LAS u32x4*)(Cs + l * SP + s0); const unsigned cw[4] = {cb.x, cb.y, cb.z, cb.w};
                  f32x4 vd[6][2];
#pragma unroll
                  for (int a = 0; a < 6; ++a) { vd[a][0] = *(const LAS f32x4*)(V + 128 * a + s0); vd[a][1] = *(const LAS f32x4*)(V + 128 * a + s0 + 4); }
                  float mv[8];
#pragma unroll
                  for (int j = 0; j < 8; ++j) { const int s = s0 + j; const float cbj = (j & 1) ? hi_f(cw[j >> 1]) : lo_f(cw[j >> 1]);
                      const float df = vd[0][j >> 2][j & 3], db = vd[1][j >> 2][j & 3], ac = vd[2][j >> 2][j & 3], rc = vd[3][j >> 2][j & 3];
                      const float arg = (s < l) ? (ac_l - ac) : (rc_l - rc);
                      const float wg = (s < l) ? df : ((s > l) ? db : df + db);
                      mv[j] = cbj * __expf(arg) * wg; }
                  u32x4 mw; mw.x = pk2(mv[0], mv[1]); mw.y = pk2(mv[2], mv[3]); mw.z = pk2(mv[4], mv[5]); mw.w = pk2(mv[6], mv[7]);
                  const bf16x8 mfr = mk_frag(mw);
#pragma unroll
                  for (int pt = 0; pt < 4; ++pt) acc[pt] = mfma16(xf[pt], mfr, acc[pt]);
                  bf16x8 bff, bfb;
                  { const u32x4 bw = __builtin_bit_cast(u32x4, btf[ks]);
                    const float b0 = lo_f(bw.x), b1 = hi_f(bw.x), b2 = lo_f(bw.y), b3 = hi_f(bw.y), b4 = lo_f(bw.z), b5 = hi_f(bw.z), b6 = lo_f(bw.w), b7 = hi_f(bw.w);
                    const f32x4 f0 = vd[4][0], f1 = vd[4][1], g0 = vd[5][0], g1 = vd[5][1];
                    u32x4 aw; aw.x = pk2(b0 * f0[0], b1 * f0[1]); aw.y = pk2(b2 * f0[2], b3 * f0[3]); aw.z = pk2(b4 * f1[0], b5 * f1[1]); aw.w = pk2(b6 * f1[2], b7 * f1[3]); bff = mk_frag(aw);
                    aw.x = pk2(b0 * g0[0], b1 * g0[1]); aw.y = pk2(b2 * g0[2], b3 * g0[3]); aw.z = pk2(b4 * g1[0], b5 * g1[1]); aw.w = pk2(b6 * g1[2], b7 * g1[3]); bfb = mk_frag(aw); }
#pragma unroll
                  for (int pt = 0; pt < 4; ++pt) { sf[pt] = mfma16(bff, xf[pt], sf[pt]); sb[pt] = mfma16(bfb, xf[pt], sb[pt]); } }
              bf16_t* stf = ST + ((size_t)(((b * NCHUNK + c) * 2) * 16 + h)) * 8192; bf16_t* stb = stf + (size_t)16 * 8192;
#pragma unroll
              for (int pt = 0; pt < 4; ++pt) { u32x2 o; o.x = pk2(acc[pt][0], acc[pt][1]); o.y = pk2(acc[pt][2], acc[pt][3]);
                  *(u32x2*)(YD + (size_t)(t0 + l) * 1024 + 64 * h + 16 * pt + 4 * fq) = o;
                  o.x = pk2(sf[pt][0], sf[pt][1]); o.y = pk2(sf[pt][2], sf[pt][3]); *(u32x2*)(stf + (16 * pt + fr) * 128 + 16 * w + 4 * fq) = o;
                  o.x = pk2(sb[pt][0], sb[pt][1]); o.y = pk2(sb[pt][2], sb[pt][3]); *(u32x2*)(stb + (16 * pt + fr) * 128 + 16 * w + 4 * fq) = o; } }
            if (hh < 7) P4_XSTORE(buf ^ 1);
            __syncthreads();
        }
#undef P4_XLOAD
#undef P4_XSTORE
    }
}

__device__ __forceinline__ void p5_scan(const Args& A) {
    bf16_t* ST = (bf16_t*)(A.ws + WS_ST); const float* DEC = (const float*)(A.ws + WS_DEC);
    const int gtid = blockIdx.x * 512 + threadIdx.x, NT = gridDim.x * 512;
    for (int i = gtid; i < BATCH * 2 * 16 * 2048; i += NT) {
        const int e4 = i & 2047, h = (i >> 11) & 15, dir = (i >> 15) & 1, b = i >> 16;
        f32x4 st = {0.f, 0.f, 0.f, 0.f};
        for (int cc = 0; cc < NCHUNK; cc += 16) {
            u32x2 v[16]; float dc[16];
#pragma unroll
            for (int j = 0; j < 16; ++j) { const int c = dir ? (NCHUNK - 1 - (cc + j)) : (cc + j);
                v[j] = *(const u32x2*)(ST + ((size_t)(((b * NCHUNK + c) * 2 + dir) * 16 + h)) * 8192 + 4 * e4); dc[j] = DEC[(b * NCHUNK + c) * 32 + dir * 16 + h]; }
#pragma unroll
            for (int j = 0; j < 16; ++j) { const int c = dir ? (NCHUNK - 1 - (cc + j)) : (cc + j);
                u32x2 o; o.x = pk2(st[0], st[1]); o.y = pk2(st[2], st[3]);
                *(u32x2*)(ST + ((size_t)(((b * NCHUNK + c) * 2 + dir) * 16 + h)) * 8192 + 4 * e4) = o;
                const f32x4 sv = {lo_f(v[j].x), hi_f(v[j].x), lo_f(v[j].y), hi_f(v[j].y)}; st = st * dc[j] + sv; }
        }
    }
}

constexpr int KP = 72;
struct AttnRun { int br, b, h, d, cls, blk0, nblk, n; };
__device__ __forceinline__ void attn_run(int su, int q, AttnRun& a) { const int bh = su >> 3, r8 = su & 7; a.b = bh >> 4; a.h = bh & 15;
    if (q == 0) { a.br = 0; a.cls = 0; a.blk0 = 8 * r8; a.nblk = 8; } else if (q == 1) { a.br = 1; a.cls = r8 >> 1; a.blk0 = 8 * (r8 & 1); a.nblk = 8; } else { a.br = 2; a.cls = 2 * r8 + (q - 2); a.blk0 = 0; a.nblk = 4; }
    a.d = 1 << (2 * a.br); a.n = SEQ >> (2 * a.br); }
template <bool MERGE>
__device__ __forceinline__ void attn_compute(const AttnRun& cur, int blk, int par, bf16x8 (&qf)[2], unsigned qoff, const unsigned char* projb, const LAS bf16_t* Ks, const LAS bf16_t* Vs, bf16_t* AO, float* ML, bf16_t* mix, int w, int fr, int fq) {
    const int qi = 128 * blk + 16 * w + fr; const unsigned tq = (unsigned)(cur.b * SEQ + cur.cls + cur.d * qi); const int n = cur.n;
    const unsigned char* AOb = (const unsigned char*)AO; const unsigned char* MLb = (const unsigned char*)ML; unsigned char* mixb = (unsigned char*)mix; unsigned char* AOw = (unsigned char*)AO; unsigned char* MLw = (unsigned char*)ML;
    f32x4 st[9];
    {
        bf16x8 kf[9][2];
        const LAS bf16_t* kb = Ks + fr * KP + 8 * fq;
#pragma unroll
        for (int kt = 0; kt < 9; ++kt) { const int Tt = w + kt; const int srow = (((par + (Tt >> 3)) & 1) << 7) + ((Tt & 7) << 4);
#pragma unroll
            for (int ks = 0; ks < 2; ++ks) kf[kt][ks] = *(const LAS bf16x8*)(kb + srow * KP + 32 * ks); }
        __builtin_amdgcn_sched_barrier(0);
#pragma unroll
        for (int kt = 0; kt < 9; ++kt) { const f32x4 z = {0.f, 0.f, 0.f, 0.f}; st[kt] = mfma16(kf[kt][0], qf[0], z); }
#pragma unroll
        for (int kt = 0; kt < 9; ++kt) st[kt] = mfma16(kf[kt][1], qf[1], st[kt]);
        __builtin_amdgcn_sched_barrier(0);
    }
#pragma unroll
    for (int ks = 0; ks < 2; ++ks) qf[ks] = *(const bf16x8*)(projb + qoff + 256 * ks);
    f32x2 pm0 = {0.f, 0.f}, pm1 = {0.f, 0.f}; u32x2 po0[4], po1[4];
    if (MERGE) { pm0 = *(const f32x2*)(MLb + (unsigned)((tq * 16 + cur.h) * 8)); pm1 = *(const f32x2*)(MLb + (unsigned)(((T + tq) * 16 + cur.h) * 8));
#pragma unroll
        for (int et = 0; et < 4; ++et) { po0[et] = *(const u32x2*)(AOb + (unsigned)((tq * 1024 + 64 * cur.h + 4 * fq) * 2) + 32 * et); po1[et] = *(const u32x2*)(AOb + (unsigned)(((T + tq) * 1024 + 64 * cur.h + 4 * fq) * 2) + 32 * et); } }
#pragma unroll
    for (int r = 0; r < 4; ++r) { if (4 * fq + r < fr) st[0][r] = -1.0e30f; if (4 * fq + r > fr) st[8][r] = -1.0e30f; }
    if (blk == 0 || 128 * (blk + 1) >= n) {
#pragma unroll
        for (int kt = 0; kt < 9; ++kt)
#pragma unroll
            for (int r = 0; r < 4; ++r) { const int kj = qi + 16 * kt + 4 * fq + r - 64 - fr; if (kj < 0 || kj >= n) st[kt][r] = -1.0e30f; } }
    float mx = fmaxf(fmaxf(st[0][0], st[0][1]), fmaxf(st[0][2], st[0][3]));
#pragma unroll
    for (int kt = 1; kt < 9; ++kt) { mx = __builtin_fmaxf(__builtin_fmaxf(mx, st[kt][0]), st[kt][1]); mx = __builtin_fmaxf(__builtin_fmaxf(mx, st[kt][2]), st[kt][3]); }
    mx = fmaxf(mx, __shfl_xor(mx, 16)); mx = fmaxf(mx, __shfl_xor(mx, 32));
    f32x2 s2 = {0.f, 0.f}; const f32x2 m2 = {mx, mx};
#pragma unroll
    for (int kt = 0; kt < 9; ++kt) { f32x2 a = {st[kt][0], st[kt][1]}, c = {st[kt][2], st[kt][3]}; a -= m2; c -= m2;
        a[0] = __builtin_amdgcn_exp2f(a[0]); a[1] = __builtin_amdgcn_exp2f(a[1]); c[0] = __builtin_amdgcn_exp2f(c[0]); c[1] = __builtin_amdgcn_exp2f(c[1]);
        s2 += a; s2 += c; st[kt][0] = a[0]; st[kt][1] = a[1]; st[kt][2] = c[0]; st[kt][3] = c[1]; }
    float sum = s2[0] + s2[1];
    sum += __shfl_xor(sum, 16); sum += __shfl_xor(sum, 32);
    bf16x8 pf[5];
#pragma unroll
    for (int k2 = 0; k2 < 5; ++k2) { u32x4 pw; pw.x = pk2(st[2 * k2][0], st[2 * k2][1]); pw.y = pk2(st[2 * k2][2], st[2 * k2][3]);
        if (k2 < 4) { pw.z = pk2(st[2 * k2 + 1][0], st[2 * k2 + 1][1]); pw.w = pk2(st[2 * k2 + 1][2], st[2 * k2 + 1][3]); } else { pw.z = 0u; pw.w = 0u; }
        pf[k2] = mk_frag(pw); }
    float inv = 1.f / sum, w0 = 0.f, w1 = 0.f;
    if (MERGE) { const float M = fmaxf(mx, fmaxf(pm0[0], pm1[0])); w0 = pm0[1] * __builtin_amdgcn_exp2f(pm0[0] - M); w1 = pm1[1] * __builtin_amdgcn_exp2f(pm1[0] - M);
        const float e2 = __builtin_amdgcn_exp2f(mx - M); const float iw = 1.f / (w0 + w1 + e2 * sum); inv = e2 * iw; w0 *= iw; w1 *= iw; }
    const LAS bf16_t* vb = Vs + (4 * fq + (fr >> 2)) * KP + 4 * (fr & 3);
    const LAS bf16_t* vp[9];
#pragma unroll
    for (int kt = 0; kt < 9; ++kt) { const int Tt = w + kt; vp[kt] = vb + ((((par + (Tt >> 3)) & 1) << 7) + ((Tt & 7) << 4)) * KP; }
    u32x2 vf[2][9];
#pragma unroll
    for (int kt = 0; kt < 9; ++kt) vf[0][kt] = lds_tr16(vp[kt]);
#pragma unroll
    for (int et = 0; et < 4; ++et) {
        if (et < 3) {
#pragma unroll
            for (int kt = 0; kt < 9; ++kt) vf[(et + 1) & 1][kt] = lds_tr16(vp[kt] + 16 * (et + 1)); }
        __builtin_amdgcn_sched_barrier(0);
        f32x4 acc = {0.f, 0.f, 0.f, 0.f};
#pragma unroll
        for (int k2 = 0; k2 < 5; ++k2) { const u32x2 lo = vf[et & 1][2 * k2]; u32x2 hi = {0u, 0u}; if (k2 < 4) hi = vf[et & 1][2 * k2 + 1];
            u32x4 vw; vw.x = lo.x; vw.y = lo.y; vw.z = hi.x; vw.w = hi.y;
            acc = mfma16(mk_frag(vw), pf[k2], acc); }
        if (MERGE) { u32x2 o; o.x = pk2(acc[0] * inv + w0 * lo_f(po0[et].x) + w1 * lo_f(po1[et].x), acc[1] * inv + w0 * hi_f(po0[et].x) + w1 * hi_f(po1[et].x));
            o.y = pk2(acc[2] * inv + w0 * lo_f(po0[et].y) + w1 * lo_f(po1[et].y), acc[3] * inv + w0 * hi_f(po0[et].y) + w1 * hi_f(po1[et].y));
            *(u32x2*)(mixb + (unsigned)((tq * D + 1024 + 64 * cur.h + 4 * fq) * 2) + 32 * et) = o; }
        else { u32x2 o; o.x = pk2(acc[0] * inv, acc[1] * inv); o.y = pk2(acc[2] * inv, acc[3] * inv);
            *(u32x2*)(AOw + (unsigned)(((cur.br * T + tq) * 1024 + 64 * cur.h + 4 * fq) * 2) + 32 * et) = o; }
        __builtin_amdgcn_sched_barrier(0);
    }
    if (!MERGE && fq == 0) { f32x2 ml = {mx, sum}; *(f32x2*)(MLw + (unsigned)(((cur.br * T + tq) * 16 + cur.h) * 8)) = ml; }
}
template <int Q0, int Q1, bool MERGE>
__device__ __forceinline__ void p4_attn(const Args& A, LAS unsigned char* lds, int rep) {
    const int tid = threadIdx.x, lane = tid & 63, w = __builtin_amdgcn_readfirstlane(tid >> 6), fr = lane & 15, fq = lane >> 4;
    unsigned char* ws = A.ws;
    const unsigned char* projb = (const unsigned char*)(ws + WS_PROJ);
    bf16_t* AO = (bf16_t*)(ws + WS_AO); float* ML = (float*)(ws + WS_ML); bf16_t* mix = (bf16_t*)(ws + WS_MIX);
    LAS bf16_t* Ks = (LAS bf16_t*)lds; LAS bf16_t* Vs = (LAS bf16_t*)(lds + 36864);
    const int sr = tid >> 2, sq4 = tid & 3;
#define ATT_SEG_LOAD(d_, cls_, n_, s_, vk_, vv_) do { int kj_ = 128 * (s_) - 64 + sr; kj_ = kj_ < 0 ? 0 : kj_; kj_ = kj_ >= (n_) ? (n_) - 1 : kj_; \
        const unsigned ro_ = (unsigned)(rowb + (cls_) + (d_) * kj_) * (unsigned)(NPROJ_PAD * 2); \
        _Pragma("unroll") for (int i_ = 0; i_ < 2; ++i_) { vk_[i_] = *(const u32x4*)(projb + ro_ + kcol + 16 * i_); vv_[i_] = *(const u32x4*)(projb + ro_ + vcol + 16 * i_); } } while (0)
#define ATT_SEG_STORE(half_, vk_, vv_) do { _Pragma("unroll") for (int i_ = 0; i_ < 2; ++i_) { *(LAS u32x4*)(Ks + (128 * (half_) + sr) * KP + 16 * sq4 + 8 * i_) = vk_[i_]; *(LAS u32x4*)(Vs + (128 * (half_) + sr) * KP + 16 * sq4 + 8 * i_) = vv_[i_]; } } while (0)
#define ATT_Q_OFF(d_, cls_, n_, blk_) ({ int qi_ = 128 * (blk_) + 16 * w + fr; qi_ = qi_ >= (n_) ? (n_) - 1 : qi_; (unsigned)(rowb + (cls_) + (d_) * qi_) * (unsigned)(NPROJ_PAD * 2) + qcol; })
    u32x4 vk0[2], vv0[2], vk1[2], vv1[2]; bf16x8 qf[2];
#define ATT_STEP(P_, VKL_, VVL_, VKS_, VVS_) do { const int i_s = i + (P_); \
        { const bool in_ = (i_s + 3 <= cur.nblk); const int d_ = in_ ? cur.d : nxt.d, c_ = in_ ? cur.cls : nxt.cls, n_ = in_ ? cur.n : nxt.n, s_ = in_ ? cur.blk0 + i_s + 3 : nxt.blk0 + (P_); ATT_SEG_LOAD(d_, c_, n_, s_, VKL_, VVL_); } \
        const bool qmore_ = (i_s + 1 < cur.nblk); \
        const unsigned qoff_ = ATT_Q_OFF(qmore_ ? cur.d : nxt.d, qmore_ ? cur.cls : nxt.cls, qmore_ ? cur.n : nxt.n, qmore_ ? cur.blk0 + i_s + 1 : nxt.blk0); \
        attn_compute<MERGE>(cur, cur.blk0 + i_s, (P_), qf, qoff_, projb, Ks, Vs, AO, ML, mix, w, fr, fq); \
        __syncthreads(); \
        if (i_s + 2 <= cur.nblk) ATT_SEG_STORE((P_), VKS_, VVS_); \
        else if (hasn) { ATT_SEG_STORE(0, vk1, vv1); ATT_SEG_STORE(1, vk0, vv0); ATT_SEG_LOAD(nxt.d, nxt.cls, nxt.n, nxt.blk0 + 2, vk0, vv0); ATT_SEG_LOAD(nxt.d, nxt.cls, nxt.n, nxt.blk0 + 3, vk1, vv1); } \
        __syncthreads(); } while (0)
    for (int su0 = vcu_id(); su0 < 256 * rep; su0 += gridDim.x) { const int su = su0 & 255;
        AttnRun cur, nxt;
        attn_run(su, Q0, cur); nxt = cur;
        const int rowb = cur.b * SEQ, hq = 256 * (cur.h >> 2) + 32 * (cur.h & 3);
        const unsigned kcol = (unsigned)((OFF_K + hq + 128 * (sq4 >> 1) + 16 * (sq4 & 1)) * 2), vcol = (unsigned)((OFF_V + 64 * cur.h + 16 * sq4) * 2), qcol = (unsigned)((OFF_Q + hq + 8 * fq) * 2);
        ATT_SEG_LOAD(cur.d, cur.cls, cur.n, cur.blk0, vk0, vv0); ATT_SEG_LOAD(cur.d, cur.cls, cur.n, cur.blk0 + 1, vk1, vv1);
        { const unsigned qo = ATT_Q_OFF(cur.d, cur.cls, cur.n, cur.blk0); qf[0] = *(const bf16x8*)(projb + qo); qf[1] = *(const bf16x8*)(projb + qo + 256); }
        ATT_SEG_STORE(0, vk0, vv0); ATT_SEG_STORE(1, vk1, vv1);
        ATT_SEG_LOAD(cur.d, cur.cls, cur.n, cur.blk0 + 2, vk0, vv0); ATT_SEG_LOAD(cur.d, cur.cls, cur.n, cur.blk0 + 3, vk1, vv1);
        __syncthreads();
#pragma unroll 1
        for (int q = Q0; q < Q1; ++q) {
            const bool hasn = q < Q1 - 1;
            if (hasn) attn_run(su, q + 1, nxt);
#pragma unroll 1
            for (int i = 0; i < cur.nblk; i += 2) {
                ATT_STEP(0, vk1, vv1, vk0, vv0);
                ATT_STEP(1, vk0, vv0, vk1, vv1);
            }
            cur = nxt;
        }
    }
#undef ATT_STEP
#undef ATT_SEG_LOAD
#undef ATT_SEG_STORE
#undef ATT_Q_OFF
}

__device__ __forceinline__ void p6_ssd_final(const Args& A, LAS unsigned char* lds, int rep) {
    const int tid = threadIdx.x, lane = tid & 63, w = __builtin_amdgcn_readfirstlane(tid >> 6), fr = lane & 15, fq = lane >> 4;
    unsigned char* ws = A.ws;
    const bf16_t* xc = (const bf16_t*)(ws + WS_HB); const bf16_t* proj = (const bf16_t*)(ws + WS_PROJ);
    const float* ACS = (const float*)(ws + WS_ACS); const float* RCS = (const float*)(ws + WS_RCS);
    const bf16_t* YD = (const bf16_t*)(ws + WS_YD); const bf16_t* ST = (const bf16_t*)(ws + WS_ST);
    const float* dskip = (const float*)A.in[I_DSKIP]; const float* sg = (const float*)A.in[I_SSDG];
    bf16_t* mix = (bf16_t*)(ws + WS_MIX);
    LAS bf16_t* Cs = (LAS bf16_t*)lds;
    LAS float* EF = (LAS float*)(lds + 34816);
    LAS float* RED = (LAS float*)(lds + 34816 + 8192);
    for (int uu = vcu_id(); uu < BATCH * NCHUNK * 2 * rep; uu += gridDim.x) { const int u = uu & 255;
        const int b = u >> 7, c = (u >> 1) & 63, hf = u & 1; const int t0 = b * SEQ + c * CHUNK + 64 * hf;
        { const int row = tid >> 3, part = tid & 7, grp = part >> 2, q = part & 3; const bf16_t* src = xc + (size_t)(t0 + row) * XBCW + 1280 + 128 * grp + 32 * q;
#pragma unroll
          for (int i = 0; i < 4; ++i) *(LAS u32x4*)(Cs + grp * 64 * SP + row * SP + 32 * q + 8 * i) = *(const u32x4*)(src + 8 * i);
#pragma unroll
          for (int k = 0; k < 4; ++k) { const int idx = tid + 512 * k, dir = idx >> 10, hh = (idx >> 6) & 15, row2 = idx & 63;
              EF[idx] = __expf((dir ? RCS : ACS)[(size_t)(t0 + row2) * 16 + hh]); } }
        __syncthreads();
        const int grp = w >> 2;
        float ssr[4] = {0.f, 0.f, 0.f, 0.f};
        u32x2 gpk[4][4];
        LAS bf16_t* GT = (LAS bf16_t*)(lds + 45056) + w * (64 * 68);
#pragma unroll 1
        for (int hx = 0; hx < 2; ++hx) {
            const int h = 2 * w + hx;
            f32x4 y[4][4];
#pragma unroll
            for (int rt = 0; rt < 4; ++rt)
#pragma unroll
                for (int pt = 0; pt < 4; ++pt) y[rt][pt] = (f32x4){0.f, 0.f, 0.f, 0.f};
            const bf16_t* stb = ST + ((size_t)((b * NCHUNK + c) * 2) * 16 + h) * 8192 + (size_t)fr * 128 + 8 * fq;
#define P6_LOAD(dk_, hf_) do { const bf16_t* p_ = stb + (size_t)((dk_) >> 2) * (16 * 8192) + 32 * ((dk_) & 3); \
                _Pragma("unroll") for (int pt = 0; pt < 4; ++pt) hf_[pt] = *(const bf16x8*)(p_ + pt * (16 * 128)); } while (0)
#define P6_COMP(dk_, hf_) do { const int dir_ = (dk_) >> 2, ks_ = (dk_) & 3; \
                _Pragma("unroll") for (int rt = 0; rt < 4; ++rt) { \
                    const u32x4 cw = *(const LAS u32x4*)(Cs + grp * 64 * SP + (16 * rt + fr) * SP + 32 * ks_ + 8 * fq); \
                    const float ev = EF[dir_ * 1024 + h * 64 + 16 * rt + fr]; \
                    u32x4 aw; aw.x = pk2(lo_f(cw.x) * ev, hi_f(cw.x) * ev); aw.y = pk2(lo_f(cw.y) * ev, hi_f(cw.y) * ev); aw.z = pk2(lo_f(cw.z) * ev, hi_f(cw.z) * ev); aw.w = pk2(lo_f(cw.w) * ev, hi_f(cw.w) * ev); \
                    const bf16x8 af = mk_frag(aw); \
                    _Pragma("unroll") for (int pt = 0; pt < 4; ++pt) y[rt][pt] = mfma16(hf_[pt], af, y[rt][pt]); } } while (0)
            { bf16x8 hfa[4], hfb[4];
              P6_LOAD(0, hfa);
#pragma unroll 1
              for (int dk = 0; dk < 8; dk += 2) { P6_LOAD(dk + 1, hfb); P6_COMP(dk, hfa); P6_LOAD(dk + 2 < 8 ? dk + 2 : 7, hfa); P6_COMP(dk + 1, hfb); } }
#undef P6_LOAD
#undef P6_COMP
            asm volatile("" ::: "memory");
            const float dsk = dskip[h];
            u32x2 ea[12], eb[12];
#define P6_ELOAD(rt_, e_) do { const size_t tok_ = (size_t)(t0 + 16 * (rt_) + fr); const int col_ = 64 * h + 4 * fq; \
                _Pragma("unroll") for (int pt = 0; pt < 4; ++pt) { e_[3 * pt] = *(const u32x2*)(YD + tok_ * 1024 + col_ + 16 * pt); e_[3 * pt + 1] = *(const u32x2*)(xc + tok_ * XBCW + col_ + 16 * pt); e_[3 * pt + 2] = *(const u32x2*)(proj + tok_ * NPROJ_PAD + OFF_Z + col_ + 16 * pt); } } while (0)
#define P6_ECOMP(rt_, e_) do { \
                _Pragma("unroll") for (int pt = 0; pt < 4; ++pt) { const f32x4 yy = y[rt_][pt]; const u32x2 yd_ = e_[3 * pt], xv_ = e_[3 * pt + 1], zv_ = e_[3 * pt + 2]; \
                    const float g0 = (yy[0] + lo_f(yd_.x) + dsk * lo_f(xv_.x)) * silu_f(lo_f(zv_.x)), g1 = (yy[1] + hi_f(yd_.x) + dsk * hi_f(xv_.x)) * silu_f(hi_f(zv_.x)); \
                    const float g2 = (yy[2] + lo_f(yd_.y) + dsk * lo_f(xv_.y)) * silu_f(lo_f(zv_.y)), g3 = (yy[3] + hi_f(yd_.y) + dsk * hi_f(xv_.y)) * silu_f(hi_f(zv_.y)); \
                    ssr[rt_] += (g0 * g0 + g1 * g1) + (g2 * g2 + g3 * g3); \
                    u32x2 gp; gp.x = pk2(g0, g1); gp.y = pk2(g2, g3); \
                    if (hx == 0) *(LAS u32x2*)(GT + (16 * (rt_) + fr) * 68 + 16 * pt + 4 * fq) = gp; else gpk[rt_][pt] = gp; } \
                asm volatile("" ::: "memory"); } while (0)
            P6_ELOAD(0, ea);
            P6_ELOAD(1, eb); P6_ECOMP(0, ea);
            P6_ELOAD(2, ea); P6_ECOMP(1, eb);
            P6_ELOAD(3, eb); P6_ECOMP(2, ea);
            P6_ECOMP(3, eb);
#undef P6_ELOAD
#undef P6_ECOMP
        }
#pragma unroll
        for (int rt = 0; rt < 4; ++rt) { float v = ssr[rt]; v += __shfl_xor(v, 16); v += __shfl_xor(v, 32); if (fq == 0) RED[(16 * rt + fr) * 8 + w] = v; }
        f32x4 gnv[2][4];
#pragma unroll
        for (int hx = 0; hx < 2; ++hx)
#pragma unroll
            for (int pt = 0; pt < 4; ++pt) gnv[hx][pt] = *(const f32x4*)(sg + 64 * (2 * w + hx) + 16 * pt + 4 * fq);
        __syncthreads();
#pragma unroll
        for (int rt = 0; rt < 4; ++rt) { const LAS float* rp = RED + (16 * rt + fr) * 8; const f32x4 a = *(const LAS f32x4*)rp, bb = *(const LAS f32x4*)(rp + 4);
            ssr[rt] = rsqrtf(((a[0] + a[1]) + (a[2] + a[3]) + (bb[0] + bb[1]) + (bb[2] + bb[3])) * (1.f / 1024.f) + RMS_EPS); }
#pragma unroll
        for (int hx = 0; hx < 2; ++hx) { const int h = 2 * w + hx;
#pragma unroll
            for (int pt = 0; pt < 4; ++pt) { const int col = 64 * h + 16 * pt + 4 * fq; const f32x4 gn = gnv[hx][pt];
#pragma unroll
                for (int rt = 0; rt < 4; ++rt) { const u32x2 gv = (hx == 0) ? *(const LAS u32x2*)(GT + (16 * rt + fr) * 68 + 16 * pt + 4 * fq) : gpk[rt][pt]; const float rs = ssr[rt];
                    u32x2 o; o.x = pk2(lo_f(gv.x) * rs * gn[0], hi_f(gv.x) * rs * gn[1]); o.y = pk2(lo_f(gv.y) * rs * gn[2], hi_f(gv.y) * rs * gn[3]);
                    *(u32x2*)(mix + (size_t)(t0 + 16 * rt + fr) * D + col) = o; }
                asm volatile("" ::: "memory"); } }
        __syncthreads();
    }
}

__device__ __forceinline__ void p6_attn_merge(const Args& A) {
    unsigned char* ws = A.ws;
    const bf16_t* AO = (const bf16_t*)(ws + WS_AO); const float* ML = (const float*)(ws + WS_ML); bf16_t* mix = (bf16_t*)(ws + WS_MIX);
    const int gtid = blockIdx.x * 512 + threadIdx.x, NT = gridDim.x * 512;
    for (int i = gtid; i < T * 16 * 8; i += NT) {
        const int e8 = i & 7, h = (i >> 3) & 15, t = i >> 7;
        float m[3], l[3];
#pragma unroll
        for (int r = 0; r < 3; ++r) { const f32x2 v = *(const f32x2*)(ML + (((size_t)r * T + t) * 16 + h) * 2); m[r] = v[0]; l[r] = v[1]; }
        const float M = fmaxf(m[0], fmaxf(m[1], m[2]));
        float wgt[3], W = 0.f;
#pragma unroll
        for (int r = 0; r < 3; ++r) { wgt[r] = l[r] * __builtin_amdgcn_exp2f(m[r] - M); W += wgt[r]; }
        const float iw = 1.f / W; float o[8];
#pragma unroll
        for (int j = 0; j < 8; ++j) o[j] = 0.f;
#pragma unroll
        for (int r = 0; r < 3; ++r) { const u32x4 v = *(const u32x4*)(AO + ((size_t)r * T + t) * 1024 + 64 * h + 8 * e8); const float ww = wgt[r] * iw;
            o[0] += ww * lo_f(v.x); o[1] += ww * hi_f(v.x); o[2] += ww * lo_f(v.y); o[3] += ww * hi_f(v.y); o[4] += ww * lo_f(v.z); o[5] += ww * hi_f(v.z); o[6] += ww * lo_f(v.w); o[7] += ww * hi_f(v.w); }
        u32x4 ow; ow.x = pk2(o[0], o[1]); ow.y = pk2(o[2], o[3]); ow.z = pk2(o[4], o[5]); ow.w = pk2(o[6], o[7]);
        *(u32x4*)(mix + (size_t)t * D + 1024 + 64 * h + 8 * e8) = ow;
    }
}

constexpr int RP = 264;
__device__ __forceinline__ void p8_router(const Args& A, LAS unsigned char* lds, int dry) {
    const int tid = threadIdx.x, lane = tid & 63, w = __builtin_amdgcn_readfirstlane(tid >> 6), fr = lane & 15, fq = lane >> 4;
    unsigned char* ws = A.ws;
    const bf16_t* x1 = (const bf16_t*)(ws + WS_X1); const float* mod = (const float*)(ws + WS_MOD); const float* g2 = (const float*)A.in[I_N2G]; const float* rss = (const float*)(ws + WS_RSS);
    const bf16_t* wrt = (const bf16_t*)(ws + WS_WRT);
    const float* brg = (const float*)A.in[I_BRG]; const float* bre = (const float*)A.in[I_BRE];
    bf16_t* h2 = (bf16_t*)(ws + WS_HB);
    unsigned* cnt = (unsigned*)(ws + WS_CTL) + CW_CNT; int* elist = (int*)(ws + WS_ELIST); float* gates = (float*)(ws + WS_GATES);
    LAS float* A2 = (LAS float*)lds; LAS float* SH2 = A2 + D;
    LAS bf16_t* Bs = (LAS bf16_t*)(lds + 16384);
    LAS float* LG = (LAS float*)(lds + 16384 + 2 * 42240);
    if (blockIdx.x == 0 && tid < 256) ((u32x4*)(ws + WS_MIX))[tid] = (u32x4){0u, 0u, 0u, 0u};
    for (int tt0 = vcu_id(); tt0 < (T / 64) * (1 + dry); tt0 += gridDim.x) { const int tt = tt0 & (T / 64 - 1); const bool isdry = tt0 >= T / 64;
        const int b = (tt * 64) >= SEQ ? 1 : 0; const float* mb = mod + b * 12288;
        for (int i = tid; i < D; i += 512) { A2[i] = g2[i] * (1.f + mb[4 * D + i]); SH2[i] = mb[3 * D + i]; }
        const int tk = tt * 64 + 8 * w + (fr & 7); const bf16_t* xr = x1 + (size_t)tk * D + 8 * fq;
        float rstd; { const f32x4* rp = (const f32x4*)(rss + (size_t)tk * 32); float sacc = 0.f;
#pragma unroll
            for (int i = 0; i < 8; ++i) { const f32x4 v = rp[i]; sacc += (v[0] + v[1]) + (v[2] + v[3]); }
            rstd = rsqrtf(sacc * (1.f / D) + RMS_EPS); }
        u32x4 bst[5];
#define P8_BLOAD(c_) do { _Pragma("unroll") for (int i = 0; i < 5; ++i) { const int p = tid + 512 * i, row = p >> 5, c16 = p & 31; \
            bst[i] = *(const u32x4*)(wrt + (size_t)row * D + 256 * (c_) + 8 * c16); } } while (0)
#define P8_BSTORE(buf_) do { _Pragma("unroll") for (int i = 0; i < 5; ++i) { const int p = tid + 512 * i, row = p >> 5, c16 = p & 31; \
            *(LAS u32x4*)(Bs + (buf_) * 21120 + row * RP + 8 * c16) = bst[i]; } } while (0)
        u32x4 xa[8], xna[8];
#define P8_XLOAD(c_, xa_) do { _Pragma("unroll") for (int ks = 0; ks < 8; ++ks) xa_[ks] = *(const u32x4*)(xr + 256 * (c_) + 32 * ks); } while (0)
        P8_BLOAD(0); P8_XLOAD(0, xa);
        P8_BSTORE(0);
        __syncthreads();
        f32x4 acc[5];
#pragma unroll
        for (int ct = 0; ct < 5; ++ct) acc[ct] = (f32x4){0.f, 0.f, 0.f, 0.f};
#pragma unroll 1
        for (int c = 0; c < 8; ++c) {
            { const int cn = c + 1 < 8 ? c + 1 : 7; P8_BLOAD(cn); P8_XLOAD(cn, xna); }
            const LAS bf16_t* bb = Bs + (c & 1) * 21120 + fr * RP + 8 * fq;
#pragma unroll
            for (int ks = 0; ks < 8; ++ks) { const int col = 256 * c + 32 * ks + 8 * fq;
                const f32x4 m0 = *(const LAS f32x4*)(A2 + col), m1 = *(const LAS f32x4*)(A2 + col + 4), s0 = *(const LAS f32x4*)(SH2 + col), s1 = *(const LAS f32x4*)(SH2 + col + 4);
                const f32x4 xf0 = {lo_f(xa[ks].x), hi_f(xa[ks].x), lo_f(xa[ks].y), hi_f(xa[ks].y)}, xf1 = {lo_f(xa[ks].z), hi_f(xa[ks].z), lo_f(xa[ks].w), hi_f(xa[ks].w)};
                const f32x4 v0 = (xf0 * rstd) * m0 + s0, v1 = (xf1 * rstd) * m1 + s1;
                u32x4 hw; hw.x = pk2(v0[0], v0[1]); hw.y = pk2(v0[2], v0[3]); hw.z = pk2(v1[0], v1[1]); hw.w = pk2(v1[2], v1[3]);
                if (fr < 8) *(u32x4*)(h2 + (size_t)tk * D + col) = hw;
                const bf16x8 ah = mk_frag(hw);
#pragma unroll
                for (int ct = 0; ct < 5; ++ct) acc[ct] = mfma16(ah, *(const LAS bf16x8*)(bb + (16 * ct) * RP + 32 * ks), acc[ct]); }
            P8_BSTORE((c + 1) & 1);
#pragma unroll
            for (int ks = 0; ks < 8; ++ks) xa[ks] = xna[ks];
            __syncthreads();
        }
#undef P8_BLOAD
#undef P8_BSTORE
#undef P8_XLOAD
        if (fq < 2) {
#pragma unroll
            for (int ct = 0; ct < 5; ++ct)
#pragma unroll
                for (int r = 0; r < 4; ++r) LG[(8 * w + 4 * fq + r) * NRT + 16 * ct + fr] = acc[ct][r]; }
        __syncthreads();
        LAS int* lcnt = (LAS int*)(lds + 16384); LAS int* lbase = lcnt + 64;
        if (tid < 64) lcnt[tid] = 0;
        __syncthreads();
        int ea = 0, eb = 0, ra = 0, rb = 0; float g1v = 0.f, g2v = 0.f;
        if (lane < 8) {
            const LAS float* lg = LG + (8 * w + lane) * NRT;
            float gmx = -3.0e38f; int gi = 0;
#pragma unroll
            for (int j = 0; j < 8; ++j) { const float v = lg[j] + brg[j]; if (v > gmx) { gmx = v; gi = j; } }
            float gse = 0.f;
#pragma unroll
            for (int j = 0; j < 8; ++j) gse += __expf(lg[j] + brg[j] - gmx);
            const float pgroup = 1.f / gse;
            const LAS float* el = lg + 16 + 8 * gi; const float* be = bre + 8 * gi;
            float emx = -3.0e38f; int i1 = 0;
#pragma unroll
            for (int j = 0; j < 8; ++j) { const float v = el[j] + be[j]; if (v > emx) { emx = v; i1 = j; } }
            float e2 = -3.0e38f; int i2 = 0; float ese = 0.f;
#pragma unroll
            for (int j = 0; j < 8; ++j) { const float v = el[j] + be[j]; ese += __expf(v - emx); if (j != i1 && v > e2) { e2 = v; i2 = j; } }
            const float p1 = 1.f / ese, p2 = __expf(e2 - emx) / ese; const float ps = p1 + p2;
            g1v = pgroup * p1 / ps; g2v = pgroup * p2 / ps;
            ea = 8 * gi + i1; eb = 8 * gi + i2;
            if (!isdry) { ra = __hip_atomic_fetch_add(lcnt + ea, 1, __ATOMIC_RELAXED, __HIP_MEMORY_SCOPE_WORKGROUP); rb = __hip_atomic_fetch_add(lcnt + eb, 1, __ATOMIC_RELAXED, __HIP_MEMORY_SCOPE_WORKGROUP); }
        }
        __syncthreads();
        if (tid < 64 && !isdry) { const int c = lcnt[tid]; if (c > 0) lbase[tid] = (int)atomicAdd(cnt + 32 * tid, (unsigned)c); }
        __syncthreads();
        if (lane < 8 && !isdry) { const int tok = tt * 64 + 8 * w + lane;
            elist[(size_t)ea * ECAP + lbase[ea] + ra] = 2 * tok; elist[(size_t)eb * ECAP + lbase[eb] + rb] = 2 * tok + 1;
            gates[2 * tok] = g1v; gates[2 * tok + 1] = g2v; }
        __syncthreads();
    }
}

__device__ __forceinline__ int moe_tables(const Args& A, LAS unsigned char* lds, int npn, bool down) {
    const int tid = threadIdx.x;
    unsigned char* ws = A.ws;
    const unsigned* cnt = (const unsigned*)(ws + WS_CTL) + CW_CNT; const int* elist = (const int*)(ws + WS_ELIST); const float* gates = (const float*)(ws + WS_GATES);
    LAS int* tb = (LAS int*)(lds + ETAB_OFF); LAS int* cn = tb + 80;
    if (tid < 64) cn[tid] = (int)__hip_atomic_load(cnt + 32 * tid, __ATOMIC_RELAXED, __HIP_MEMORY_SCOPE_AGENT);
    __syncthreads();
    if (tid <= 64) { int s = 0; for (int j = 0; j < tid; ++j) s += (cn[j] + 255) >> 8; tb[tid] = s; }
    __syncthreads();
    const int ntiles = tb[64];
    LAS int* tab = (LAS int*)(lds + TAB_OFF);
    const int cap = down ? 6 : 12;
    for (int li = 0; li < cap; ++li) {
        const long L = (long)li * gridDim.x + vcu_id(); if (L >= (long)ntiles * npn) break;
        const int tau = (int)(L / npn); int e = 0;
        for (int j = 1; j < NEXP; ++j) e += (tb[j] <= tau) ? 1 : 0;
        const int mt = tau - tb[e], ce = cn[e];
        if (tid < 256) { const int pos = 256 * mt + tid; const bool ok = pos < ce; const int a = ok ? elist[(size_t)e * ECAP + pos] : -1;
            if (down) { tab[li * 512 + 2 * tid] = a; tab[li * 512 + 2 * tid + 1] = ok ? __float_as_int(gates[a]) : 0; }
            else tab[li * 256 + tid] = ok ? (a >> 1) * (D * 2) : (int)(unsigned)(WS_MIX - WS_HB); }
    }
    __syncthreads();
    return ntiles;
}

__device__ __forceinline__ void p11_combine(const Args& A) {
    unsigned char* ws = A.ws;
    const bf16_t* x1 = (const bf16_t*)(ws + WS_X1); const float* mod = (const float*)(ws + WS_MOD); const bf16_t* Y = (const bf16_t*)(ws + WS_YSLOT);
    const int gtid = blockIdx.x * 512 + threadIdx.x, NR = (gridDim.x * 512) >> 8, c8 = (gtid & 255) * 8;
    f32x4 gt[2][2];
#pragma unroll
    for (int bb = 0; bb < 2; ++bb) { gt[bb][0] = *(const f32x4*)(mod + bb * 12288 + 5 * D + c8); gt[bb][1] = *(const f32x4*)(mod + bb * 12288 + 5 * D + c8 + 4); }
    for (int t0 = gtid >> 8; t0 < T; t0 += 4 * NR) {
        u32x4 xw[4], ya[4], yb[4];
#pragma unroll
        for (int u = 0; u < 4; ++u) { int t = t0 + u * NR; t = t < T ? t : T - 1;
            xw[u] = *(const u32x4*)(x1 + (size_t)t * D + c8); ya[u] = *(const u32x4*)(Y + (size_t)(2 * t) * D + c8); yb[u] = *(const u32x4*)(Y + (size_t)(2 * t + 1) * D + c8); }
        __builtin_amdgcn_sched_barrier(0);
#pragma unroll
        for (int u = 0; u < 4; ++u) { const int t = t0 + u * NR; if (t < T) { const int bb = t >= SEQ ? 1 : 0;
            const f32x4 g0 = bb ? gt[1][0] : gt[0][0], g1 = bb ? gt[1][1] : gt[0][1];
            const f32x4 a0 = {lo_f(xw[u].x), hi_f(xw[u].x), lo_f(xw[u].y), hi_f(xw[u].y)}, a1 = {lo_f(xw[u].z), hi_f(xw[u].z), lo_f(xw[u].w), hi_f(xw[u].w)};
            f32x4 s0, s1;
            s0[0] = lo_f(ya[u].x) + lo_f(yb[u].x); s0[1] = hi_f(ya[u].x) + hi_f(yb[u].x); s0[2] = lo_f(ya[u].y) + lo_f(yb[u].y); s0[3] = hi_f(ya[u].y) + hi_f(yb[u].y);
            s1[0] = lo_f(ya[u].z) + lo_f(yb[u].z); s1[1] = hi_f(ya[u].z) + hi_f(yb[u].z); s1[2] = lo_f(ya[u].w) + lo_f(yb[u].w); s1[3] = hi_f(ya[u].w) + hi_f(yb[u].w);
            __builtin_nontemporal_store(a0 + g0 * s0, (f32x4*)(A.out + (size_t)t * D + c8)); __builtin_nontemporal_store(a1 + g1 * s1, (f32x4*)(A.out + (size_t)t * D + c8 + 4)); } }
    }
}

constexpr int NPH = 12;
#ifndef DUP_PH
#define DUP_PH -1
#endif
#define REP(k) for (int _rep = 0; _rep < ((DUP_PH) == (k) ? 2 : 1); ++_rep)
__global__ void __launch_bounds__(512, 2) hyb_fwd(Args args) {
    extern __shared__ __attribute__((aligned(16))) unsigned char lds_raw[];
    LAS unsigned char* lds = (LAS unsigned char*)lds_raw;
    const int tid = threadIdx.x;
    volatile LAS unsigned* MISC = (volatile LAS unsigned*)(lds + MISC_OFF);
    for (int u = tid; u < 128; u += 512) MISC[u] = 0u;
    __syncthreads();
    unsigned char* ws = args.ws;
    unsigned* ctl = (unsigned*)(ws + WS_CTL);
    const int lo = args.ph_lo, hi = args.ph_hi;
    XcdBarrier bar; bar.bar = ctl + CW_BAR; bar.x = 0; bar.st = nullptr;
    if (hi - lo > 1) bar = xcd_barrier_post(ctl + CW_BAR, MISC + 8);
#ifndef PH_MASK
#define PH_MASK 0xFFF
#endif
#define IN(k) ((((PH_MASK) >> (k)) & 1) && lo <= (k) && (k) < hi)
#ifndef TPROBE_A
#define TPROBE_A -1
#define TPROBE_B -1
#endif
#define SEAM(k) do { if (IN(k) && IN((k) + 1)) xcd_barrier(bar); if (TPROBE_A >= 0 && blockIdx.x == 0 && tid == 0) ctl[CW_FLAG + 1 + (k)] = (unsigned)wall_clock64(); } while (0)
    if (TPROBE_A >= 0 && blockIdx.x == 0 && tid == 0) ctl[CW_FLAG] = (unsigned)wall_clock64();

    if (IN(0)) { REP(0) { p0_prologue(args, lds); __syncthreads(); } } SEAM(0);
    if (IN(1)) { REP(1) p1_norm1(args); } SEAM(1);
    if (IN(2)) {
        const int G2 = (gridDim.x == 256) ? 164 : (int)gridDim.x;
        if ((int)blockIdx.x < G2) {
            pg8::Gemm g{(const bf16_t*)(ws + WS_HB), (const bf16_t*)(ws + WS_WINT), D, 0};
            pg8::StaticOrder S; S.init(T, NPROJ_PAD, G2, (int)blockIdx.x, (DUP_PH) == 2 ? 2 : 1);
            EpiProj E{(bf16_t*)(ws + WS_PROJ), (float*)(ws + WS_DTRAW), (const float*)args.in[I_QG], (const float*)args.in[I_KG], (const float*)(ws + WS_ROPE)};
            pg8::gemm_phase<EpiProj, pg8::StaticOrder, true, false>(lds, g, S, E);
            p2_convert_late(args, lds);
        } else p2_convert_late(args, lds);
    } SEAM(2);
    if (IN(3)) { p3_post(args, (DUP_PH) == 13 ? 1 : 0, (DUP_PH) == 3 ? 2 : 1); } SEAM(3);
    if (IN(4)) { p4_ssd_local(args, lds, (DUP_PH) == 4 ? 2 : 1); p4_attn<0, 2, false>(args, lds, (DUP_PH) == 14 ? 2 : 1); } SEAM(4);
    if (IN(5)) { p5_scan(args); } SEAM(5);
    if (IN(6)) { p6_ssd_final(args, lds, (DUP_PH) == 6 ? 2 : 1); p4_attn<2, 4, true>(args, lds, (DUP_PH) == 16 ? 2 : 1); } SEAM(6);
    if (IN(7)) {
        pg8::Gemm g{(const bf16_t*)(ws + WS_MIX), (const bf16_t*)(ws + WS_WOUTT), D, 0};
        pg8::StaticOrder S; S.init(T, D, (int)gridDim.x, (int)blockIdx.x, (DUP_PH) == 7 ? 2 : 1);
        EpiOut E{(const float*)args.in[I_X], (const float*)(ws + WS_MOD), (bf16_t*)(ws + WS_X1), (float*)(ws + WS_RSS)};
        pg8::gemm_phase<EpiOut, pg8::StaticOrder, true, false>(lds, g, S, E);
    } SEAM(7);
    if (IN(8)) { p8_router(args, lds, (DUP_PH) == 8 ? 1 : 0); } SEAM(8);
    if (IN(9)) {
        const int ntiles = moe_tables(args, lds, 4, false);
        pg8::Gemm g{(const bf16_t*)(ws + WS_HB), (const bf16_t*)(ws + WS_WGUT), D, (size_t)1024 * D * 2};
        MoeOrder S{(const LAS int*)(lds + ETAB_OFF), ntiles, 4, (int)gridDim.x, vcu_id(), (const LAS unsigned*)(lds + TAB_OFF)};
        EpiGU E{(bf16_t*)(ws + WS_HMOE)};
        _Pragma("unroll 1") REP(9) pg8::gemm_phase<EpiGU, MoeOrder, true, true>(lds, g, S, E);
    } SEAM(9);
    if (IN(10)) {
        const int ntiles = moe_tables(args, lds, 8, true);
        pg8::Gemm g{(const bf16_t*)(ws + WS_HMOE), (const bf16_t*)(ws + WS_WDT), EH, (size_t)D * EH * 2};
        MoeOrder S{(const LAS int*)(lds + ETAB_OFF), ntiles, 8, (int)gridDim.x, vcu_id(), (const LAS unsigned*)(lds + TAB_OFF)};
        EpiDown E{(bf16_t*)(ws + WS_YSLOT), (const LAS int*)(lds + TAB_OFF)};
        _Pragma("unroll 1") REP(10) pg8::gemm_phase<EpiDown, MoeOrder, true, false>(lds, g, S, E);
    } SEAM(10);
    if (IN(11)) { REP(11) p11_combine(args); }
    if (TPROBE_A >= 0) {
        xcd_barrier(bar);
        if (blockIdx.x == 0 && tid == 0) ctl[CW_FLAG + 1 + 11] = (unsigned)wall_clock64();
        __syncthreads();
        const unsigned ea = __hip_atomic_load(ctl + CW_FLAG + 1 + TPROBE_A, __ATOMIC_RELAXED, __HIP_MEMORY_SCOPE_AGENT), sa = __hip_atomic_load(ctl + CW_FLAG + TPROBE_A, __ATOMIC_RELAXED, __HIP_MEMORY_SCOPE_AGENT);
        const unsigned eb = __hip_atomic_load(ctl + CW_FLAG + 1 + TPROBE_B, __ATOMIC_RELAXED, __HIP_MEMORY_SCOPE_AGENT), sb = __hip_atomic_load(ctl + CW_FLAG + TPROBE_B, __ATOMIC_RELAXED, __HIP_MEMORY_SCOPE_AGENT);
        xcd_barrier(bar);
        const float ta = (float)(ea - sa) * 0.01f, tb = (float)(eb - sb) * 0.01f;
        const float sfac = sqrtf(ta * 0.01f); const float* xin = (const float*)args.in[I_X];
        for (size_t i = (size_t)blockIdx.x * 512 + tid; i < (size_t)T * D; i += (size_t)gridDim.x * 512) args.out[i] += xin[i] * sfac + (i == 0 ? tb : 0.f);
    }
#undef IN
#undef SEAM
}

extern "C" void kernel_launch(void* const* d_in, const int* in_sizes, int n_in, void* d_out, int out_size, void* d_ws, size_t ws_size, hipStream_t stream) {
    static int grid = 0;
    if (grid == 0) {
        if (n_in != 24 || in_sizes[0] != T * D || out_size != T * D || ws_size < WS_END) { fprintf(stderr, "kernel_launch: unexpected shapes (n_in %d, in0 %d, out %d, ws %zu < %zu); nothing launched\n", n_in, n_in > 0 ? in_sizes[0] : -1, out_size, ws_size, (size_t)WS_END); grid = -1; return; }
        int dev = 0, cus = 0, per_cu = 0;
        if (hipGetDevice(&dev) != hipSuccess || hipDeviceGetAttribute(&cus, hipDeviceAttributeMultiprocessorCount, dev) != hipSuccess) { grid = -1; return; }
        if (hipFuncSetAttribute((const void*)hyb_fwd, hipFuncAttributeMaxDynamicSharedMemorySize, LDS_BYTES) != hipSuccess) { fprintf(stderr, "kernel_launch: hipFuncSetAttribute failed\n"); grid = -1; return; }
        if (hipOccupancyMaxActiveBlocksPerMultiprocessor(&per_cu, (const void*)hyb_fwd, 512, LDS_BYTES) != hipSuccess || per_cu < 1) fprintf(stderr, "kernel_launch: occupancy query reports %d\n", per_cu);
        (void)hipGetLastError();
        grid = cus;
    }
    if (grid < 0) return;
    (void)hipMemsetAsync((char*)d_ws + WS_CTL, 0, CTL_BYTES, stream);
    Args a{};
    for (int i = 0; i < 24; ++i) a.in[i] = d_in[i];
    a.out = (float*)d_out; a.ws = (unsigned char*)d_ws;
#if MK_ONE_LAUNCH
    a.ph_lo = 0; a.ph_hi = NPH;
    hipLaunchKernelGGL(hyb_fwd, dim3(grid), dim3(512), LDS_BYTES, stream, a);
#else
    for (int p = 0; p < NPH; ++p) { a.ph_lo = p; a.ph_hi = p + 1; hipLaunchKernelGGL(hyb_fwd, dim3(grid), dim3(512), LDS_BYTES, stream, a); }
#endif
}
```
